# Optimizing an MI355X kernel written in HIP

```python
import jax, jax.numpy as jnp
from jax import lax
import numpy as np

D_MODEL = 1024
BATCH = 4
SEQ = 4096
DEPTH = 2

RNN_WIDTH = 512
RNN_BLOCKS = 8
RNN_BLOCK = RNN_WIDTH // RNN_BLOCKS
RNN_CONV = 4
RG_C = 8.0
NSA_HEADS = 8
NSA_KV_HEADS = 2
HEAD_DIM = 64
NSA_GROUP = NSA_HEADS // NSA_KV_HEADS
NSA_WIDTH = NSA_HEADS * HEAD_DIM
KV_WIDTH = NSA_KV_HEADS * HEAD_DIM
N_NSA_BRANCHES = 3
CMP_LEN = 32
CMP_STRIDE = 16
CMP_HIDDEN = 128
SEL_LEN = 64
SEL_TOPK = 16
WINDOW = 512
Q_BLOCK = 128
SC_WIDTH = 512
SC_CONV = 3
N_MIXERS = 3
N_GROUPS = 4
EXPERTS_PER_GROUP = 8
N_EXPERTS = N_GROUPS * EXPERTS_PER_GROUP
EXPERT_HIDDEN = 256
TOPK_IN_GROUP = 2

IN_SPLITS = (RNN_WIDTH, RNN_WIDTH, NSA_WIDTH) + (KV_WIDTH,) * 6 + (NSA_HEADS * N_NSA_BRANCHES,) + (SC_WIDTH,) * 3 + (N_MIXERS * D_MODEL,)
IN_WIDTH = sum(IN_SPLITS)

RMS_EPS = 1e-6
NEG_INF = -1e30
FORCE_SCORE = 1e6

kernel_name = 'hybrid_rglru_nsa_shortconv_hmoe'


def _split_points():
    return [int(v) for v in np.cumsum(IN_SPLITS)[:-1]]


def rms_norm(x, gain):
    xf = x.astype(jnp.float32)
    y = xf * lax.rsqrt(jnp.mean(xf * xf, axis=-1, keepdims=True) + RMS_EPS)
    return (y * gain.astype(jnp.float32)).astype(x.dtype)


def causal_depthwise_conv(x, w):
    k, c = w.shape
    return lax.conv_general_dilated(
        x, w[:, None, :].astype(x.dtype), window_strides=(1,), padding=[(k - 1, 0)],
        dimension_numbers=('NWC', 'WIO', 'NWC'), feature_group_count=c)


def rg_lru(x, wa, ba, wx, bx, lam):
    b, s, _ = x.shape
    xb = x.reshape(b, s, RNN_BLOCKS, RNN_BLOCK)
    r = jax.nn.sigmoid(jnp.einsum('bsni,nij->bsnj', xb, wa) + ba).reshape(b, s, RNN_WIDTH)
    i = jax.nn.sigmoid(jnp.einsum('bsni,nij->bsnj', xb, wx) + bx).reshape(b, s, RNN_WIDTH)
    log_a = -RG_C * r.astype(jnp.float32) * jax.nn.softplus(-lam.astype(jnp.float32))
    a = jnp.exp(log_a)
    mult = jnp.sqrt(-jnp.expm1(2.0 * log_a))
    u = mult * (i * x).astype(jnp.float32)

    def combine(left, right):
        a1, b1 = left
        a2, b2 = right
        return a1 * a2, a2 * b1 + b2

    _, h = lax.associative_scan(combine, (a, u), axis=1)
    return h.astype(x.dtype)


def compress_blocks(k, pe, w1, b1, w2, b2):
    b, s = k.shape[:2]
    n_cmp = (s - CMP_LEN) // CMP_STRIDE + 1
    idx = jnp.arange(n_cmp)[:, None] * CMP_STRIDE + jnp.arange(CMP_LEN)[None, :]
    blocks = k[:, idx] + pe[None, None, :, None, :]
    blocks = blocks.transpose(0, 1, 3, 2, 4).reshape(b, n_cmp, NSA_KV_HEADS, CMP_LEN * HEAD_DIM)
    hid = jax.nn.gelu(blocks @ w1 + b1)
    return hid @ w2 + b2


def native_sparse_attention(q, k_cmp, v_cmp, k_sel, v_sel, k_win, v_win, gates):
    f32 = jnp.float32
    b, s = q.shape[:2]
    n_chunks = s // Q_BLOCK
    n_cmp = k_cmp.shape[1]
    n_sel = s // SEL_LEN
    top_k = min(SEL_TOPK, n_sel)
    scale = HEAD_DIM ** -0.5
    k_cmp = k_cmp.astype(f32)
    v_cmp = v_cmp.astype(f32)
    cmp_start = jnp.arange(n_cmp) * CMP_STRIDE
    cmp_end = cmp_start + CMP_LEN
    sel_start = jnp.arange(n_sel) * SEL_LEN
    overlap = jnp.clip(jnp.minimum(cmp_end[:, None], sel_start[None, :] + SEL_LEN)
                       - jnp.maximum(cmp_start[:, None], sel_start[None, :]), 0).astype(f32) / CMP_LEN
    ks_blk = k_sel.astype(f32).reshape(b, n_sel, SEL_LEN, NSA_KV_HEADS, HEAD_DIM).transpose(0, 3, 1, 2, 4)
    vs_blk = v_sel.astype(f32).reshape(b, n_sel, SEL_LEN, NSA_KV_HEADS, HEAD_DIM).transpose(0, 3, 1, 2, 4)
    pad = jnp.zeros((b, WINDOW, NSA_KV_HEADS, HEAD_DIM), f32)
    kw_pad = jnp.concatenate([pad, k_win.astype(f32)], axis=1)
    vw_pad = jnp.concatenate([pad, v_win.astype(f32)], axis=1)
    bi = jnp.arange(b)[:, None, None, None]
    gi = jnp.arange(NSA_KV_HEADS)[None, :, None, None]
    j = jnp.arange(n_sel)

    def query_block(c):
        t0 = c * Q_BLOCK
        t = t0 + jnp.arange(Q_BLOCK)
        qc = lax.dynamic_slice_in_dim(q, t0, Q_BLOCK, axis=1).astype(f32)
        s_c = jnp.einsum('btghd,bngd->bghtn', qc, k_cmp) * scale
        m_c = cmp_end[None, :] - 1 <= t[:, None]
        p_c = jax.nn.softmax(jnp.where(m_c, s_c, NEG_INF), axis=-1)
        p_c = p_c * jnp.any(m_c, axis=-1)[:, None].astype(f32)
        o_c = jnp.einsum('bghtn,bngd->btghd', p_c, v_cmp)
        imp = jnp.einsum('bghtn,nj->bgtj', p_c, overlap)
        cur = t // SEL_LEN
        causal_j = j[None, :] <= cur[:, None]
        forced = (j[None, :] == 0) | (j[None, :] == cur[:, None]) | (j[None, :] == cur[:, None] - 1)
        imp = jnp.where(forced, FORCE_SCORE, imp)
        imp = jnp.where(causal_j, imp, -1.0)
        top_val, top_idx = lax.top_k(imp, top_k)
        blk_ok = top_val >= 0.0
        kg = ks_blk[bi, gi, top_idx]
        vg = vs_blk[bi, gi, top_idx]
        pos = top_idx[..., None] * SEL_LEN + jnp.arange(SEL_LEN)
        m_s = blk_ok[..., None] & (pos <= t[None, None, :, None, None])
        s_s = jnp.einsum('btghd,bgtkld->bghtkl', qc, kg) * scale
        s_s = jnp.where(m_s[:, :, None], s_s, NEG_INF).reshape(b, NSA_KV_HEADS, NSA_GROUP, Q_BLOCK, top_k * SEL_LEN)
        p_s = jax.nn.softmax(s_s, axis=-1).reshape(b, NSA_KV_HEADS, NSA_GROUP, Q_BLOCK, top_k, SEL_LEN)
        o_s = jnp.einsum('bghtkl,bgtkld->btghd', p_s, vg)
        kwc = lax.dynamic_slice_in_dim(kw_pad, t0, Q_BLOCK + WINDOW, axis=1)
        vwc = lax.dynamic_slice_in_dim(vw_pad, t0, Q_BLOCK + WINDOW, axis=1)
        spos = t0 - WINDOW + jnp.arange(Q_BLOCK + WINDOW)
        diff = t[:, None] - spos[None, :]
        m_w = (diff >= 0) & (diff < WINDOW) & (spos[None, :] >= 0)
        s_w = jnp.einsum('btghd,bsgd->bghts', qc, kwc) * scale
        p_w = jax.nn.softmax(jnp.where(m_w, s_w, NEG_INF), axis=-1)
        o_w = jnp.einsum('bghts,bsgd->btghd', p_w, vwc)
        gc = lax.dynamic_slice_in_dim(gates, t0, Q_BLOCK, axis=1).astype(f32)
        o = gc[..., 0:1] * o_c + gc[..., 1:2] * o_s + gc[..., 2:3] * o_w
        return o.reshape(b, Q_BLOCK, NSA_WIDTH)

    out = lax.map(query_block, jnp.arange(n_chunks))
    return out.transpose(1, 0, 2, 3).reshape(b, s, NSA_WIDTH).astype(q.dtype)


def hierarchical_moe(x, wg, bg, we, be, w_gate, w_up, w_down):
    f32 = jnp.float32
    b, s, d = x.shape
    n = b * s
    xt = x.reshape(n, d)
    g_logits = (xt @ wg).astype(f32) + bg.astype(f32)
    g_prob = jax.nn.softmax(g_logits, axis=-1)
    grp = jnp.argmax(g_logits, axis=-1)
    tok = jnp.arange(n)
    p_grp = g_prob[tok, grp][:, None]
    e_logits = ((xt @ we).astype(f32) + be.astype(f32)).reshape(n, N_GROUPS, EXPERTS_PER_GROUP)
    e_prob = jax.nn.softmax(e_logits[tok, grp], axis=-1)
    top_p, top_i = lax.top_k(e_prob, TOPK_IN_GROUP)
    weights = p_grp * top_p / jnp.sum(top_p, axis=-1, keepdims=True)
    expert_id = grp[:, None] * EXPERTS_PER_GROUP + top_i
    combine = jnp.einsum('nke,nk->ne', jax.nn.one_hot(expert_id, N_EXPERTS, dtype=f32), weights)
    y = jnp.zeros((n, d), f32)
    for g in range(N_GROUPS):
        e0 = g * EXPERTS_PER_GROUP
        e1 = e0 + EXPERTS_PER_GROUP
        h = jax.nn.silu(jnp.einsum('nd,edf->nef', xt, w_gate[e0:e1])) * jnp.einsum('nd,edf->nef', xt, w_up[e0:e1])
        h = h * combine[:, e0:e1, None].astype(h.dtype)
        y = y + jnp.einsum('nef,efd->nd', h, w_down[e0:e1])
    return y.reshape(b, s, d).astype(x.dtype)


def setup_inputs(seed: int = 0) -> dict:
    key = jax.random.key(seed)
    ks = jax.random.split(key, 30)
    L = DEPTH

    def nrm(k, shape, scale):
        return jax.random.normal(k, shape, jnp.float32) * scale

    u = jax.random.uniform(ks[9], (L, RNN_WIDTH), jnp.float32, 0.9, 0.999)
    p = u ** (1.0 / RG_C)
    return {
        'x': nrm(ks[0], (BATCH, SEQ, D_MODEL), 1.0),
        'mix_norm': 1.0 + nrm(ks[1], (L, D_MODEL), 0.05),
        'w_in': nrm(ks[2], (L, D_MODEL, IN_WIDTH), D_MODEL ** -0.5),
        'rnn_conv_w': nrm(ks[3], (L, RNN_CONV, RNN_WIDTH), RNN_CONV ** -0.5),
        'rnn_conv_b': nrm(ks[4], (L, RNN_WIDTH), 0.01),
        'rg_wa': nrm(ks[5], (L, RNN_BLOCKS, RNN_BLOCK, RNN_BLOCK), RNN_BLOCK ** -0.5),
        'rg_ba': nrm(ks[6], (L, RNN_BLOCKS, RNN_BLOCK), 0.01),
        'rg_wx': nrm(ks[7], (L, RNN_BLOCKS, RNN_BLOCK, RNN_BLOCK), RNN_BLOCK ** -0.5),
        'rg_bx': nrm(ks[8], (L, RNN_BLOCKS, RNN_BLOCK), 0.01),
        'rg_lambda': jnp.log(p) - jnp.log1p(-p),
        'cmp_pe': nrm(ks[10], (L, 2, CMP_LEN, HEAD_DIM), 0.1),
        'cmp_w1': nrm(ks[11], (L, 2, CMP_LEN * HEAD_DIM, CMP_HIDDEN), (CMP_LEN * HEAD_DIM) ** -0.5),
        'cmp_b1': nrm(ks[12], (L, 2, CMP_HIDDEN), 0.01),
        'cmp_w2': nrm(ks[13], (L, 2, CMP_HIDDEN, HEAD_DIM), CMP_HIDDEN ** -0.5),
        'cmp_b2': nrm(ks[14], (L, 2, HEAD_DIM), 0.01),
        'q_norm': 1.0 + nrm(ks[15], (L, HEAD_DIM), 0.05),
        'k_norm': 1.0 + nrm(ks[16], (L, N_NSA_BRANCHES, HEAD_DIM), 0.05),
        'sc_conv_w': nrm(ks[17], (L, SC_CONV, SC_WIDTH), SC_CONV ** -0.5),
        'w_rnn_out': nrm(ks[18], (L, RNN_WIDTH, D_MODEL), RNN_WIDTH ** -0.5),
        'w_nsa_out': nrm(ks[19], (L, NSA_WIDTH, D_MODEL), NSA_WIDTH ** -0.5),
        'w_sc_out': nrm(ks[20], (L, SC_WIDTH, D_MODEL), SC_WIDTH ** -0.5),
        'w_out': nrm(ks[21], (L, D_MODEL, D_MODEL), D_MODEL ** -0.5),
        'ffn_norm': 1.0 + nrm(ks[22], (L, D_MODEL), 0.05),
        'router_group_w': nrm(ks[23], (L, D_MODEL, N_GROUPS), D_MODEL ** -0.5),
        'router_group_b': nrm(ks[24], (L, N_GROUPS), 0.01),
        'router_expert_w': nrm(ks[25], (L, D_MODEL, N_EXPERTS), D_MODEL ** -0.5),
        'router_expert_b': nrm(ks[26], (L, N_EXPERTS), 0.01),
        'exp_w_gate': nrm(ks[27], (L, N_EXPERTS, D_MODEL, EXPERT_HIDDEN), D_MODEL ** -0.5),
        'exp_w_up': nrm(ks[28], (L, N_EXPERTS, D_MODEL, EXPERT_HIDDEN), D_MODEL ** -0.5),
        'exp_w_down': nrm(ks[29], (L, N_EXPERTS, EXPERT_HIDDEN, D_MODEL), EXPERT_HIDDEN ** -0.5),
    }


def reference(x, mix_norm, w_in, rnn_conv_w, rnn_conv_b, rg_wa, rg_ba, rg_wx, rg_bx, rg_lambda,
              cmp_pe, cmp_w1, cmp_b1, cmp_w2, cmp_b2, q_norm, k_norm, sc_conv_w,
              w_rnn_out, w_nsa_out, w_sc_out, w_out, ffn_norm,
              router_group_w, router_group_b, router_expert_w, router_expert_b,
              exp_w_gate, exp_w_up, exp_w_down):
    b, s, _ = x.shape
    split_points = _split_points()
    for l in range(DEPTH):
        xn = rms_norm(x, mix_norm[l])
        (rnn_x, rnn_y, q, kc, vc, ksl, vsl, kwn, vwn, nsa_g,
         sc_b, sc_c, sc_h, merge_g) = jnp.split(xn @ w_in[l], split_points, axis=-1)

        u = causal_depthwise_conv(rnn_x, rnn_conv_w[l]) + rnn_conv_b[l]
        y_rnn = jax.nn.gelu(rnn_y) * rg_lru(u, rg_wa[l], rg_ba[l], rg_wx[l], rg_bx[l], rg_lambda[l])

        qh = rms_norm(q.reshape(b, s, NSA_HEADS, HEAD_DIM), q_norm[l])
        qh = qh.reshape(b, s, NSA_KV_HEADS, NSA_GROUP, HEAD_DIM)
        kv_shape = (b, s, NSA_KV_HEADS, HEAD_DIM)
        k_cmp = rms_norm(compress_blocks(kc.reshape(kv_shape), cmp_pe[l, 0], cmp_w1[l, 0], cmp_b1[l, 0],
                                         cmp_w2[l, 0], cmp_b2[l, 0]), k_norm[l, 0])
        v_cmp = compress_blocks(vc.reshape(kv_shape), cmp_pe[l, 1], cmp_w1[l, 1], cmp_b1[l, 1],
                                cmp_w2[l, 1], cmp_b2[l, 1])
        k_sel = rms_norm(ksl.reshape(kv_shape), k_norm[l, 1])
        k_win = rms_norm(kwn.reshape(kv_shape), k_norm[l, 2])
        nsa_gates = jax.nn.sigmoid(nsa_g).reshape(b, s, NSA_KV_HEADS, NSA_GROUP, N_NSA_BRANCHES)
        y_nsa = native_sparse_attention(qh, k_cmp, v_cmp, k_sel, vsl.reshape(kv_shape),
                                        k_win, vwn.reshape(kv_shape), nsa_gates)

        y_sc = sc_b * causal_depthwise_conv(sc_c * sc_h, sc_conv_w[l])

        gates = jax.nn.sigmoid(merge_g).reshape(b, s, N_MIXERS, D_MODEL)
        merged = (gates[:, :, 0] * (y_rnn @ w_rnn_out[l])
                  + gates[:, :, 1] * (y_nsa @ w_nsa_out[l])
                  + gates[:, :, 2] * (y_sc @ w_sc_out[l]))
        x = x + merged @ w_out[l]

        x = x + hierarchical_moe(rms_norm(x, ffn_norm[l]), router_group_w[l], router_group_b[l],
                                 router_expert_w[l], router_expert_b[l],
                                 exp_w_gate[l], exp_w_up[l], exp_w_down[l])
    return x
```

```cpp
#include <hip/hip_runtime.h>
#include <hip/hip_cooperative_groups.h>
#include <cstdio>
#include <cstdint>
namespace cg = cooperative_groups;

typedef unsigned short bf16_t;
typedef short bf16x8 __attribute__((ext_vector_type(8)));
typedef float f32x4 __attribute__((ext_vector_type(4)));
#define DEVI __device__ __forceinline__

constexpr int DM = 1024, NB = 4, SEQ = 4096, MTOK = NB * SEQ, DEPTH = 2;
constexpr int INW = 6936;
constexpr int LDY = 7168;
constexpr int OFF_RX = 0, OFF_RY = 512, OFF_Q = 1024, OFF_KC = 1536, OFF_VC = 1664, OFF_KS = 1792, OFF_VS = 1920,
              OFF_KW = 2048, OFF_VW = 2176, OFF_SB = 2304, OFF_SC = 2816, OFF_SH = 3328, OFF_MG = 3840, OFF_NG = 6912, OFF_END = 6936;
constexpr int NCMP = 255;
constexpr float RMS_EPS = 1e-6f;
constexpr int NEXP = 32;

constexpr size_t KiB = 1024, MiB = 1024 * 1024;
constexpr size_t WS_CNT = 0;
constexpr size_t WS_BAR = 16 * KiB;
constexpr size_t WS_ZERO_BYTES = 32 * KiB;
constexpr size_t WS_SS = 13 * MiB;
constexpr size_t WS_RSTD = 192 * KiB;
constexpr size_t WS_PA = 512 * KiB;
constexpr size_t WS_PH = 1024 * KiB;
constexpr size_t WS_KCMP = 2 * MiB;
constexpr size_t WS_VCMP = 2 * MiB + 512 * KiB;
constexpr size_t WS_HID = 3 * MiB;
constexpr size_t WS_RW = 5 * MiB;
constexpr size_t WS_LIST = 6 * MiB;
constexpr size_t WS_KCB = 8 * MiB;
constexpr size_t WS_VCB = 8 * MiB + 256 * KiB;
constexpr size_t WS_LOG = 9 * MiB;
constexpr size_t WS_WIN = 16 * MiB;
constexpr size_t WS_WBR = 44 * MiB;
constexpr size_t WS_WO = 50 * MiB;
constexpr size_t WS_W1T = 54 * MiB;
constexpr size_t WS_W2T = 320 * KiB;
constexpr size_t WS_BPE = 256 * KiB;
constexpr size_t WS_WRT = 15 * MiB;
constexpr size_t WS_Y = 56 * MiB;
constexpr size_t WS_LA = 280 * MiB;
constexpr size_t WS_VV = 312 * MiB;
constexpr size_t WS_XB = 280 * MiB;
constexpr size_t WS_WGU = WS_Y;
constexpr size_t WS_WD = WS_Y + 32 * MiB;
constexpr size_t WS_XG = WS_Y + 48 * MiB;
constexpr size_t WS_HM = WS_Y + 128 * MiB;
constexpr size_t WS_TOKS = WS_Y + 148 * MiB;
constexpr size_t WS_RWS = WS_Y + 148 * MiB + 256 * KiB;
constexpr size_t WS_YS = WS_Y + 152 * MiB;
constexpr size_t WS_TOTAL = 328 * MiB;
constexpr int MOE_ROWS = 40960;

struct Params {
    const float* in[30];
    float* out;
    unsigned char* ws;
};

DEVI float bf2f(bf16_t v) { return __uint_as_float(((unsigned)v) << 16); }
DEVI bf16_t f2bf(float f) { unsigned u = __float_as_uint(f); return (bf16_t)((u + 0x7fffu + ((u >> 16) & 1u)) >> 16); }
DEVI unsigned pk2(float lo, float hi) { return (unsigned)f2bf(lo) | ((unsigned)f2bf(hi) << 16); }
DEVI int launder_v0(int v) { asm volatile("" : "+v"(v)); return v; }
DEVI float shx(float v, int o) { const int lane = launder_v0((int)threadIdx.x) & 63; return __int_as_float(__builtin_amdgcn_ds_bpermute((lane ^ o) << 2, __float_as_int(v))); }
DEVI unsigned shxu(unsigned v, int o) { const int lane = launder_v0((int)threadIdx.x) & 63; return (unsigned)__builtin_amdgcn_ds_bpermute((lane ^ o) << 2, (int)v); }
DEVI float wave_sum(float v) {
#pragma unroll
    for (int o = 1; o < 64; o <<= 1) v += shx(v, o);
    return v;
}
DEVI float wave_max(float v) {
#pragma unroll
    for (int o = 1; o < 64; o <<= 1) v = fmaxf(v, shx(v, o));
    return v;
}
DEVI float sigmoidf_(float x) { return __builtin_amdgcn_rcpf(1.f + __builtin_amdgcn_exp2f(-1.4426950408889634f * x)); }
DEVI float gelu_tanh(float x) { const float u = 0.7978845608028654f * (x + 0.044715f * x * x * x); return x * __builtin_amdgcn_rcpf(1.f + __builtin_amdgcn_exp2f(-2.8853900817779268f * u)); }
DEVI int launder_v(int v) { asm volatile("" : "+v"(v)); return v; }
DEVI int launder_s(int v) { asm volatile("" : "+s"(v)); return v; }
#define TIDX launder_v((int)threadIdx.x)
#define BIDX launder_s((int)blockIdx.x)
DEVI f32x4 zero4() { float z = 0.f; asm volatile("" : "+v"(z)); return (f32x4){z, z, z, z}; }
#define LDS_FENCE() asm volatile("s_waitcnt lgkmcnt(0)" ::: "memory")

constexpr int GLD = 40;
template <class LA, class LB>
DEVI void gemm_tile(const int tid, f32x4 (&acc)[2][4], int K, bf16_t* As, bf16_t* Bs, LA la, LB lb) {
    const int lane = tid & 63, wave = tid >> 6, wm = wave >> 1, wn = wave & 1;
    const int ar = tid >> 2, ak = (tid & 3) * 8;
    const int bk = tid >> 4, bn = (tid & 15) * 8;
    for (int k0 = 0; k0 < K; k0 += 32) {
        float av[8], bv[8];
        la(k0 + ak, av);
        lb(k0 + bk, bv);
        __syncthreads();
        uint4 pa; pa.x = pk2(av[0], av[1]); pa.y = pk2(av[2], av[3]); pa.z = pk2(av[4], av[5]); pa.w = pk2(av[6], av[7]);
        *(uint4*)(As + ar * GLD + ak) = pa;
#pragma unroll
        for (int j = 0; j < 8; ++j) Bs[(bn + j) * GLD + bk] = f2bf(bv[j]);
        __syncthreads();
        bf16x8 af[2], bfr[4];
#pragma unroll
        for (int i = 0; i < 2; ++i) af[i] = *(const bf16x8*)(As + (wm * 32 + i * 16 + (lane & 15)) * GLD + (lane >> 4) * 8);
#pragma unroll
        for (int j = 0; j < 4; ++j) bfr[j] = *(const bf16x8*)(Bs + (wn * 64 + j * 16 + (lane & 15)) * GLD + (lane >> 4) * 8);
#pragma unroll
        for (int i = 0; i < 2; ++i)
#pragma unroll
            for (int j = 0; j < 4; ++j) acc[i][j] = __builtin_amdgcn_mfma_f32_16x16x32_bf16(bfr[j], af[i], acc[i][j], 0, 0, 0);
    }
    __syncthreads();
}
DEVI void acc_zero(f32x4 (&acc)[2][4]) {
#pragma unroll
    for (int i = 0; i < 2; ++i)
#pragma unroll
        for (int j = 0; j < 4; ++j) acc[i][j] = zero4();
}
#define ACC_ROW(i) (((tid >> 7) * 32) + (i) * 16 + (tid & 15))
#define ACC_COL(j) ((((tid >> 6) & 1) * 64) + (j) * 16 + (((tid & 63) >> 4) * 4))

DEVI void load8f(const float* p, float (&v)[8]) {
    const f32x4 a = *(const f32x4*)p, b = *(const f32x4*)(p + 4);
    v[0] = a[0]; v[1] = a[1]; v[2] = a[2]; v[3] = a[3]; v[4] = b[0]; v[5] = b[1]; v[6] = b[2]; v[7] = b[3];
}
DEVI void load8b(const bf16_t* p, float (&v)[8]) {
    const uint4 a = *(const uint4*)p;
    v[0] = __uint_as_float(a.x << 16); v[1] = __uint_as_float(a.x & 0xffff0000u);
    v[2] = __uint_as_float(a.y << 16); v[3] = __uint_as_float(a.y & 0xffff0000u);
    v[4] = __uint_as_float(a.z << 16); v[5] = __uint_as_float(a.z & 0xffff0000u);
    v[6] = __uint_as_float(a.w << 16); v[7] = __uint_as_float(a.w & 0xffff0000u);
}
DEVI void unpack8(const uint4 a, float (&v)[8]) {
    v[0] = __uint_as_float(a.x << 16); v[1] = __uint_as_float(a.x & 0xffff0000u);
    v[2] = __uint_as_float(a.y << 16); v[3] = __uint_as_float(a.y & 0xffff0000u);
    v[4] = __uint_as_float(a.z << 16); v[5] = __uint_as_float(a.z & 0xffff0000u);
    v[6] = __uint_as_float(a.w << 16); v[7] = __uint_as_float(a.w & 0xffff0000u);
}
DEVI void zero8(float (&v)[8]) {
#pragma unroll
    for (int j = 0; j < 8; ++j) v[j] = 0.f;
}

#define LAS3 __attribute__((address_space(3)))
DEVI int orig_col(int c) { return c < 2304 ? c : (c < OFF_NG ? c + 24 : (c < OFF_END ? c - 4608 : -1)); }
DEVI bool head_tile(int pn) { return pn == 4 || pn == 5 || pn == 7 || pn == 8; }
DEVI int phys2logical(int c) {
    const int pn = c >> 8;
    if (!head_tile(pn)) return c;
    const int p = c & 255, bj = p >> 7, wc = (p >> 5) & 3, i = p & 31;
    return (pn << 8) + wc * 64 + bj * 32 + i;
}
namespace pg8 {
#define PG8_LAS __attribute__((address_space(3)))
typedef unsigned u32x4 __attribute__((ext_vector_type(4)));
constexpr int BM = 256, BK = 64, HALF = 128, HTB = HALF * BK * 2, STAGE_BYTES = 8 * HTB, NXCD = 8, WGM = 8;
DEVI int lds_byte(int r, int c) { const int st = (r >> 4) * 2 + (c >> 5), rr = r & 15, cc = c & 31, ob = rr * 64 + cc * 2; return st * 1024 + (ob ^ (((ob >> 9) & 1) << 5)); }
DEVI void stage_rc(int b, int& R, int& C) { const int st = b / 1024, sb = b % 1024, swz = sb ^ (((sb >> 9) & 1) << 5); R = (st >> 1) * 16 + swz / 64; C = (st & 1) * 32 + (swz % 64) / 2; }
DEVI int perm32(int rho) { const int n = rho >> 4, i = rho & 15; return 8 * (i >> 2) + 4 * n + (i & 3); }
struct Unit { int pm, pn, ao = 0, aux = 0; };
struct Gemm { const bf16_t* A; const bf16_t* Bt; int K, lda, ldb; int kstepA = BK * 2, kstepB = BK * 2; };
struct StaticOrder {
    int nM, nN, nwg, G, c;
    DEVI void init(int M, int N, int G_, int c_) { nM = M / BM; nN = N / BM; nwg = nM * nN; G = G_; c = c_; }
    DEVI bool next(int i, Unit& u) const {
        const long L = (long)i * G + c; if (L >= nwg) return false;
        int wgid = (int)L; { const int q = nwg / NXCD, r = nwg % NXCD, xcd = wgid % NXCD, off = wgid / NXCD; wgid = (xcd < r ? xcd * (q + 1) : r * (q + 1) + (xcd - r) * q) + off; }
        const int nig = WGM * nN, gid = wgid / nig, fm = gid * WGM, gsz = (nM - fm) < WGM ? (nM - fm) : WGM;
        u.pm = fm + ((wgid % nig) % gsz); u.pn = (wgid % nig) / gsz; return true;
    }
};
DEVI unsigned cvt_pk_bf16(float lo, float hi) { unsigned r; asm volatile("v_cvt_pk_bf16_f32 %0, %1, %2" : "=v"(r) : "v"(lo), "v"(hi)); return r; }

template <class Epi, class Sched, bool GATHER = false, bool ALIGN_EPI = true, bool SP2 = true>
DEVI void gemm_phase(PG8_LAS unsigned char* lds, const Gemm g, const Sched& S, const Epi& E) {
    const int tid = TIDX; const int wid = __builtin_amdgcn_readfirstlane(tid >> 6), lane = tid & 63, wr = wid >> 2, wc = wid & 3, fr = lane & 15, fq = lane >> 4;
    const int K = launder_s(g.K), nt = K / BK;
    unsigned voffA[2][2], voffAn[2][2], voffB[2];
    const size_t kstepA = (size_t)g.kstepA, kstepB = (size_t)g.kstepB;
    const size_t hstepA = (size_t)HALF * g.lda * 2, hstepB = (size_t)HALF * g.ldb * 2;
    const size_t tstepA = 2 * hstepA, tstepB = 2 * hstepB;
#pragma unroll
    for (int i = 0; i < 2; ++i) { int R, C; stage_rc(tid * 16 + i * 8192, R, C); const int Rb = Epi::PERM ? ((R & ~31) + perm32(R & 31)) : R;
        voffB[i] = (unsigned)(Rb * g.ldb + C) * 2u;
        if constexpr (GATHER) {
#pragma unroll
            for (int h = 0; h < 2; ++h) { voffA[h][i] = (unsigned)(S.a_row(0, h * HALF + R) * g.lda + C) * 2u; voffAn[h][i] = (unsigned)(S.a_row(1, h * HALF + R) * g.lda + C) * 2u; }
        } else {
#pragma unroll
            for (int h = 0; h < 2; ++h) { voffA[h][i] = (unsigned)(R * g.lda + C) * 2u + (unsigned)(h * hstepA); voffAn[h][i] = voffA[h][i]; }
        } }
    const unsigned ldsw = (unsigned)wid * 1024u;
    const int aoff = lds_byte(wr * 64 + fr, fq * 8), boff = lds_byte(wc * 32 + fr, fq * 8);
#define PG8_SA(b, h) (((b) * 2 + (h)) * HTB)
#define PG8_SB(b, h) ((4 + (b) * 2 + (h)) * HTB)
#define PG8_STAGE(bufoff, gbase, voff) do { _Pragma("unroll") for (int _i = 0; _i < 2; ++_i) \
        __builtin_amdgcn_global_load_lds((const unsigned*)((const char*)(gbase) + (voff)[_i]), (PG8_LAS unsigned*)(lds + (bufoff) + ldsw + _i * 8192), 16, 0, 0); } while (0)
#define PG8_LDA(dst, b, h) do { _Pragma("unroll") for (int m = 0; m < 4; ++m) _Pragma("unroll") for (int k = 0; k < 2; ++k) dst[m][k] = *(const PG8_LAS bf16x8*)(lds + PG8_SA(b, h) + aoff + m * 2048 + k * 1024); } while (0)
#define PG8_LDB(dst, b, h) do { _Pragma("unroll") for (int n = 0; n < 2; ++n) _Pragma("unroll") for (int k = 0; k < 2; ++k) dst[n][k] = *(const PG8_LAS bf16x8*)(lds + PG8_SB(b, h) + boff + n * 2048 + k * 1024); } while (0)
#define PG8_MMA(ai, bj, At, Bt) do { __builtin_amdgcn_s_setprio(1); _Pragma("unroll") for (int m = 0; m < 4; ++m) _Pragma("unroll") for (int n = 0; n < 2; ++n) _Pragma("unroll") for (int k = 0; k < 2; ++k) \
        acc[ai][bj][m][n] = __builtin_amdgcn_mfma_f32_16x16x32_bf16(Bt[n][k], At[m][k], acc[ai][bj][m][n], 0, 0, 0); __builtin_amdgcn_s_setprio(0); } while (0)
#define PG8_WAIT_V(n) asm volatile("s_waitcnt vmcnt(" #n ")" ::: "memory")
#define PG8_WAIT_L(n) asm volatile("s_waitcnt lgkmcnt(" #n ")" ::: "memory")
#define PG8_BAR __builtin_amdgcn_s_barrier()
#define PG8_SCHED __builtin_amdgcn_sched_barrier(0)
    Unit cur, nxt; int ui = 0;
    if (!S.next(0, cur)) return;
    f32x4 acc[2][2][4][2];
#pragma unroll
    for (int a = 0; a < 2; ++a)
#pragma unroll
        for (int b = 0; b < 2; ++b)
#pragma unroll
            for (int m = 0; m < 4; ++m)
#pragma unroll
                for (int n = 0; n < 2; ++n) acc[a][b][m][n] = zero4();
    bf16x8 At[4][2], B0[2][2], B1[2][2];
    const char* cA = GATHER ? (const char*)g.A : (const char*)g.A + (size_t)cur.pm * tstepA + (size_t)cur.ao * 2; const char* cB = (const char*)g.Bt + (size_t)cur.pn * tstepB;
    if constexpr (SP2) {
        PG8_STAGE(PG8_SB(0, 0), cB, voffB); PG8_STAGE(PG8_SB(0, 1), cB + hstepB, voffB); PG8_STAGE(PG8_SA(0, 0), cA, voffA[0]); PG8_STAGE(PG8_SA(0, 1), cA, voffA[1]);
        if (wr == 1) PG8_BAR;
        PG8_WAIT_V(2); PG8_BAR;
        PG8_STAGE(PG8_SB(1, 0), cB + kstepB, voffB); PG8_STAGE(PG8_SA(1, 0), cA + kstepA, voffA[0]); PG8_STAGE(PG8_SB(1, 1), cB + hstepB + kstepB, voffB);
        PG8_WAIT_V(6); PG8_BAR;
    } else {
        PG8_STAGE(PG8_SB(0, 0), cB, voffB); PG8_STAGE(PG8_SA(0, 0), cA, voffA[0]); PG8_STAGE(PG8_SB(0, 1), cB + hstepB, voffB); PG8_STAGE(PG8_SA(0, 1), cA, voffA[1]);
        if (wr == 1) PG8_BAR;
        PG8_WAIT_V(4); PG8_BAR;
        PG8_STAGE(PG8_SB(1, 0), cB + kstepB, voffB); PG8_STAGE(PG8_SA(1, 0), cA + kstepA, voffA[0]); PG8_STAGE(PG8_SB(1, 1), cB + hstepB + kstepB, voffB);
        PG8_WAIT_V(6); PG8_BAR;
    }
    for (;;) {
        const bool has_next = S.next(ui + 1, nxt);
        const char* nA = GATHER ? (const char*)g.A : (has_next ? (const char*)g.A + (size_t)nxt.pm * tstepA + (size_t)nxt.ao * 2 : cA); const char* nB = has_next ? (const char*)g.Bt + (size_t)nxt.pn * tstepB : cB;
        for (int t = 0; t < nt; t += 2) {
            const bool last = (t == nt - 2);
            const char* a1 = cA + (size_t)(t + 1) * kstepA;
            const char* a2 = last ? nA : cA + (size_t)(t + 2) * kstepA; const char* b2 = last ? nB : cB + (size_t)(t + 2) * kstepB;
            const char* a3 = a2 + kstepA; const char* b3 = b2 + kstepB;
            unsigned vA2[2][2];
#pragma unroll
            for (int h = 0; h < 2; ++h)
#pragma unroll
                for (int i = 0; i < 2; ++i) vA2[h][i] = last ? voffAn[h][i] : voffA[h][i];
            if constexpr (SP2) {
            PG8_LDB(B0, 0, 0); PG8_LDB(B1, 0, 1); PG8_SCHED; PG8_LDA(At, 0, 0); PG8_STAGE(PG8_SA(1, 1), a1, voffA[1]);
            PG8_WAIT_V(8); PG8_WAIT_L(0); PG8_BAR; PG8_MMA(0, 0, At, B0); PG8_MMA(0, 1, At, B1); PG8_BAR; PG8_SCHED;
            PG8_LDA(At, 0, 1); PG8_STAGE(PG8_SB(0, 0), b2, voffB); PG8_STAGE(PG8_SB(0, 1), b2 + hstepB, voffB); PG8_STAGE(PG8_SA(0, 0), a2, vA2[0]);
            PG8_WAIT_V(8); PG8_WAIT_L(0); PG8_BAR; PG8_MMA(1, 0, At, B0); PG8_MMA(1, 1, At, B1); PG8_BAR; PG8_SCHED;
            PG8_LDB(B0, 1, 0); PG8_LDB(B1, 1, 1); PG8_SCHED; PG8_LDA(At, 1, 0); PG8_STAGE(PG8_SA(0, 1), a2, vA2[1]);
            PG8_WAIT_V(8); PG8_WAIT_L(0); PG8_BAR; PG8_MMA(0, 0, At, B0); PG8_MMA(0, 1, At, B1); PG8_BAR; PG8_SCHED;
            PG8_LDA(At, 1, 1); PG8_STAGE(PG8_SB(1, 0), b3, voffB); PG8_STAGE(PG8_SB(1, 1), b3 + hstepB, voffB); PG8_STAGE(PG8_SA(1, 0), a3, vA2[0]);
            PG8_WAIT_V(8); PG8_WAIT_L(0); PG8_BAR; PG8_MMA(1, 0, At, B0); PG8_MMA(1, 1, At, B1); PG8_BAR; PG8_SCHED;
            } else {
            PG8_LDB(B0, 0, 0); PG8_SCHED; PG8_LDA(At, 0, 0); PG8_STAGE(PG8_SA(1, 1), a1, voffA[1]);
            PG8_WAIT_L(8); PG8_BAR; PG8_WAIT_L(0); PG8_MMA(0, 0, At, B0); PG8_BAR; PG8_SCHED;
            PG8_LDB(B1, 0, 1); PG8_STAGE(PG8_SB(0, 0), b2, voffB);
            PG8_BAR; PG8_WAIT_L(0); PG8_MMA(0, 1, At, B1); PG8_BAR;
            PG8_LDA(At, 0, 1); PG8_STAGE(PG8_SA(0, 0), a2, vA2[0]);
            PG8_BAR; PG8_WAIT_L(0); PG8_MMA(1, 0, At, B0); PG8_BAR; PG8_SCHED;
            PG8_STAGE(PG8_SB(0, 1), b2 + hstepB, voffB);
            PG8_WAIT_V(6); PG8_BAR; PG8_MMA(1, 1, At, B1); PG8_BAR;
            PG8_LDB(B0, 1, 0); PG8_SCHED; PG8_LDA(At, 1, 0); PG8_STAGE(PG8_SA(0, 1), a2, vA2[1]);
            PG8_WAIT_L(8); PG8_BAR; PG8_WAIT_L(0); PG8_MMA(0, 0, At, B0); PG8_BAR; PG8_SCHED;
            PG8_LDB(B1, 1, 1); PG8_STAGE(PG8_SB(1, 0), b3, voffB);
            PG8_BAR; PG8_WAIT_L(0); PG8_MMA(0, 1, At, B1); PG8_BAR;
            PG8_LDA(At, 1, 1); PG8_STAGE(PG8_SA(1, 0), a3, vA2[0]);
            PG8_BAR; PG8_WAIT_L(0); PG8_MMA(1, 0, At, B0); PG8_BAR; PG8_SCHED;
            PG8_STAGE(PG8_SB(1, 1), b3 + hstepB, voffB);
            PG8_WAIT_V(6); PG8_BAR; PG8_MMA(1, 1, At, B1); PG8_BAR;
            }
        }
        if constexpr (ALIGN_EPI) { if (wr == 0) PG8_BAR; }
        bool keep = false;
        if constexpr (Epi::CHAIN) keep = E.chain(acc, cur, wr, wc, fr, fq);
        else E(acc, cur, wr, wc, fr, fq);
        if (!has_next) break;
        if (!keep) {
#pragma unroll
        for (int a = 0; a < 2; ++a)
#pragma unroll
            for (int b = 0; b < 2; ++b)
#pragma unroll
                for (int m = 0; m < 4; ++m)
#pragma unroll
                    for (int n = 0; n < 2; ++n) acc[a][b][m][n] = zero4();
        }
        cur = nxt; cA = nA; cB = nB; ++ui;
        if constexpr (GATHER) {
#pragma unroll
            for (int h = 0; h < 2; ++h)
#pragma unroll
                for (int i = 0; i < 2; ++i) voffA[h][i] = voffAn[h][i]; }
        if constexpr (ALIGN_EPI) { if (wr == 1) PG8_BAR; }
    }
    PG8_WAIT_V(0);
    if constexpr (!ALIGN_EPI) { if (wr == 0) PG8_BAR; }
    PG8_BAR;
#undef PG8_SA
#undef PG8_SB
#undef PG8_STAGE
#undef PG8_LDA
#undef PG8_LDB
#undef PG8_MMA
#undef PG8_WAIT_V
#undef PG8_WAIT_L
#undef PG8_BAR
#undef PG8_SCHED
}
}

typedef float f32x16 __attribute__((ext_vector_type(16)));
typedef unsigned u32x4v __attribute__((ext_vector_type(4)));
typedef short s16x4 __attribute__((ext_vector_type(4)));
constexpr int NSA_MISC = 49152, NSA_OUT = 53248, NSA_QF = 118784;
constexpr float NSA_NEG = -1e30f, NSA_M0 = -1e20f;
DEVI int crow16(int r, int hi) { return (r & 3) + 8 * (r >> 2) + 4 * hi; }
DEVI float half_max(float v) { auto rr = __builtin_amdgcn_permlane32_swap(__float_as_uint(v), __float_as_uint(v), false, false); return fmaxf(__uint_as_float(rr[0]), __uint_as_float(rr[1])); }
DEVI float half_sum(float v) { auto rr = __builtin_amdgcn_permlane32_swap(__float_as_uint(v), __float_as_uint(v), false, false); return __uint_as_float(rr[0]) + __uint_as_float(rr[1]); }
DEVI unsigned half_or(unsigned v) { auto rr = __builtin_amdgcn_permlane32_swap(v, v, false, false); return rr[0] | rr[1]; }
DEVI int half_addi(int v) { auto rr = __builtin_amdgcn_permlane32_swap((unsigned)v, (unsigned)v, false, false); return (int)(rr[0] + rr[1]); }

template <class LD>
DEVI void tr_item_f(LD ld, bf16_t* dst, int ldd, float* scr, int lane) {
#pragma unroll 8
    for (int i = 0; i < 32; ++i) { const int kk = 2 * i + (lane >> 5); scr[kk * 33 + (lane & 31)] = ld(kk); }
    LDS_FENCE();
    const int c = lane & 7;
#pragma unroll
    for (int j = 0; j < 4; ++j) {
        const int n = (lane >> 3) + 8 * j; const float* s = scr + (8 * c) * 33 + n;
        uint4 o; o.x = pk2(s[0], s[33]); o.y = pk2(s[66], s[99]); o.z = pk2(s[132], s[165]); o.w = pk2(s[198], s[231]);
        *(uint4*)(dst + (size_t)n * ldd + 8 * c) = o;
    }
    LDS_FENCE();
}
DEVI void tr_item(const float* srck0, int ldsrc, int col0, int nvalid, const float* ks, bf16_t* dst, int ldd, float* scr, int lane) {
    const int r8 = lane >> 3, c4 = (lane & 7) * 4;
    const bool ok = (col0 >= 0 && c4 < nvalid);
    const int col = ok ? col0 + c4 : 0;
    const float msk = ok ? 1.f : 0.f;
    f32x4 v[8];
#pragma unroll
    for (int i = 0; i < 8; ++i) v[i] = *(const f32x4*)(srck0 + (size_t)(8 * i + r8) * ldsrc + col);
#pragma unroll
    for (int i = 0; i < 8; ++i) {
        const int kk = 8 * i + r8;
        const float s = ks ? ks[kk] * msk : msk;
        *(f32x4*)(scr + kk * 36 + c4) = v[i] * s;
    }
    LDS_FENCE();
    const int c = lane & 7;
#pragma unroll
    for (int j = 0; j < 4; ++j) {
        const int n = (lane >> 3) + 8 * j; const float* s = scr + (8 * c) * 36 + n;
        uint4 o; o.x = pk2(s[0], s[36]); o.y = pk2(s[72], s[108]); o.z = pk2(s[144], s[180]); o.w = pk2(s[216], s[252]);
        *(uint4*)(dst + (size_t)n * ldd + 8 * c) = o;
    }
    LDS_FENCE();
}
DEVI void phase_prep(const Params& p, bf16_t* WIN, bf16_t* WBR, bf16_t* WO, bf16_t* WRT, bf16_t* W1T, bf16_t* W2T, float* BPE, float* ldsf) {
    const int tid = TIDX; const int bid = BIDX; const int lane = tid & 63, wv = tid >> 6, gw = bid * 8 + wv, ngw = gridDim.x * 8;
    float* scr = ldsf + wv * 2304;
    for (int e = gw * 64 + lane; e < 2 * 2 * 64 * 128; e += ngw * 64) {
        const int lz = e >> 13, d = (e >> 7) & 63, j = e & 127;
        W2T[e] = f2bf(p.in[13][(size_t)lz * 8192 + j * 64 + d]);
    }
    for (int it = gw; it < 2 * 2 * 128; it += ngw) {
        const int lz = it >> 7, j = it & 127;
        const float* pe = p.in[10] + (size_t)lz * 2048; const float* w1 = p.in[11] + (size_t)lz * 2048 * 128 + j;
        float s = 0.f;
#pragma unroll 8
        for (int i = 0; i < 32; ++i) { const int k = lane + 64 * i; s += pe[k] * w1[(size_t)k * 128]; }
        s = wave_sum(s);
        if (lane == 0) BPE[it] = s + p.in[12][it];
    }
    for (int it = gw; it < 2 * 2 * 128; it += ngw) {
        const int lz = it >> 7, r = it & 127, kb = r >> 2, nb = r & 3, k0 = kb * 64, n0 = nb * 32;
        tr_item(p.in[11] + (size_t)lz * 2048 * 128 + (size_t)k0 * 128, 128, n0, 32, nullptr, W1T + ((size_t)lz * 128 + n0) * 2048 + k0, 2048, scr, lane);
    }
    constexpr int I_IN = 16 * 224, I_BR = 8 * 32, I_O = 16 * 32, I_R = 16 * 8, I_L = I_IN + 3 * I_BR + I_O + I_R;
    for (int it = gw; it < 2 * I_L; it += ngw) {
        const int l = it / I_L; int r = it % I_L;
        if (r >= I_L - I_R) {
            r -= I_L - I_R; const int kb = r / 8, nb = r % 8, k0 = kb * 64, n0 = nb * 32, n = n0 + (lane & 31);
            const float* wg = p.in[23] + (size_t)l * DM * 4 + (size_t)k0 * 4; const float* we = p.in[25] + (size_t)l * DM * 32 + (size_t)k0 * 32; const float* gn = p.in[22] + l * DM + k0;
            tr_item_f([&](int kk) { return (n < 4 ? wg[kk * 4 + n] : (n < 36 ? we[kk * 32 + n - 4] : 0.f)) * gn[kk]; }, WRT + ((size_t)l * 256 + n0) * DM + k0, DM, scr, lane);
        } else if (r < I_IN) {
            const int kb = r / 224, nb = r % 224, k0 = kb * 64, n0 = nb * 32;
            tr_item(p.in[2] + (size_t)l * DM * INW + (size_t)k0 * INW, INW, orig_col(phys2logical(n0)), n0 == OFF_NG ? 24 : 32, p.in[1] + l * DM + k0, WIN + ((size_t)l * LDY + n0) * DM + k0, DM, scr, lane);
        } else if (r < I_IN + 3 * I_BR) {
            r -= I_IN; const int br = r / I_BR, rr = r % I_BR, kb = rr / 32, nb = rr % 32, k0 = kb * 64, n0 = nb * 32;
            const float* W = (br == 0 ? p.in[18] : (br == 1 ? p.in[19] : p.in[20])) + (size_t)l * 512 * DM;
            tr_item(W + (size_t)k0 * DM, DM, n0, 32, nullptr, WBR + ((size_t)(l * 3 + br) * DM + n0) * 512 + k0, 512, scr, lane);
        } else {
            r -= I_IN + 3 * I_BR; const int kb = r / 32, nb = r % 32, k0 = kb * 64, n0 = nb * 32;
            tr_item(p.in[21] + (size_t)l * DM * DM + (size_t)k0 * DM, DM, n0, 32, nullptr, WO + ((size_t)l * DM + n0) * DM + k0, DM, scr, lane);
        }
    }
}
DEVI void phase_moe_prep(const float* Wg, const float* Wu, const float* Wd, const float* gain, bf16_t* WGU, bf16_t* WD, float* ldsf) {
    const int tid = TIDX; const int bid = BIDX; const int lane = tid & 63, wv = tid >> 6, gw = bid * 8 + wv, ngw = gridDim.x * 8;
    float* scr = ldsf + wv * 2304;
    constexpr int I_GU = 16 * 16, I_D = 4 * 32, I_E = I_GU + I_D;
    int it0, it1;
    if (gridDim.x == 256) { if (bid >= 64) { const int v = (bid - 64) * 8 + wv; it0 = 7 * v; it1 = it0 + 7; } else { const int v = bid * 8 + wv; it0 = 10752 + 3 * v; it1 = it0 + 3; } }
    else { it0 = gw; it1 = NEXP * I_E; }
    const int istep = (gridDim.x == 256) ? 1 : ngw;
    for (int it = it0; it < it1; it += istep) {
        const int e = it / I_E; int r = it % I_E;
        if (r < I_GU) {
            const int kb = r / 16, nb = r % 16, k0 = kb * 64, n0 = nb * 32;
            const int half = n0 >> 8, isup = (n0 >> 7) & 1, i0 = n0 & 127;
            const float* W = (isup ? Wu : Wg) + (size_t)e * DM * 256 + (size_t)k0 * 256;
            tr_item(W, 256, half * 128 + i0, 32, gain + k0, WGU + ((size_t)e * 512 + n0) * DM + k0, DM, scr, lane);
        } else {
            r -= I_GU; const int kb = r / 32, nb = r % 32, k0 = kb * 64, n0 = nb * 32;
            tr_item(Wd + (size_t)e * 256 * DM + (size_t)k0 * DM, DM, n0, 32, nullptr, WD + ((size_t)e * DM + n0) * 256 + k0, 256, scr, lane);
        }
    }
}

DEVI void phase_xb(const float* x, float* rstd, bf16_t* XB) {
    const int tid = TIDX; const int bid = BIDX; const int lane = tid & 63, gw = bid * 8 + (tid >> 6), ngw = gridDim.x * 8;
    for (int m = gw; m < MTOK; m += ngw) {
        const f32x4* xr = (const f32x4*)(x + (size_t)m * DM) + lane;
        uint2* xo = (uint2*)(XB + (size_t)m * DM) + lane;
        float s = 0.f;
#pragma unroll
        for (int j = 0; j < 4; ++j) { const f32x4 v = xr[64 * j]; s += v[0] * v[0] + v[1] * v[1] + v[2] * v[2] + v[3] * v[3];
            uint2 o; o.x = pk2(v[0], v[1]); o.y = pk2(v[2], v[3]); xo[64 * j] = o; }
        s = wave_sum(s);
        if (lane == 0) rstd[m] = rsqrtf(s * (1.f / DM) + RMS_EPS);
    }
}

struct EpiInproj {
    static constexpr bool PERM = true, CHAIN = false;
    bf16_t* Y; const float* rstd; const float* qn; const float* kn;
    DEVI void operator()(const f32x4 (&acc)[2][2][4][2], const pg8::Unit& u, int wr, int wc, int fr, int fq) const {
        const int row0 = u.pm * 256 + wr * 64 + fr;
        if (head_tile(u.pn)) {
            const bool isq = u.pn < 6, normed = isq || wc < 2;
            const float* gp = isq ? qn : kn + (u.pn == 7 ? 64 : 128);
            float gn[2][8];
#pragma unroll
            for (int bj = 0; bj < 2; ++bj)
#pragma unroll
                for (int e = 0; e < 8; ++e) gn[bj][e] = normed ? gp[32 * bj + 8 * fq + e] * (isq ? 0.125f * 1.4426950408889634f : 1.f) : 1.f;
#pragma unroll
            for (int ai = 0; ai < 2; ++ai)
#pragma unroll
                for (int m = 0; m < 4; ++m) {
                    const int row = row0 + ai * 128 + m * 16; const float rs = rstd[row];
                    f32x4 v[2][2]; float ss = 0.f;
#pragma unroll
                    for (int bj = 0; bj < 2; ++bj)
#pragma unroll
                        for (int n = 0; n < 2; ++n) { v[bj][n] = acc[ai][bj][m][n] * rs; ss += v[bj][n][0] * v[bj][n][0] + v[bj][n][1] * v[bj][n][1] + v[bj][n][2] * v[bj][n][2] + v[bj][n][3] * v[bj][n][3]; }
                    ss += shx(ss, 16); ss += shx(ss, 32);
                    const float hs = normed ? rsqrtf(ss * (1.f / 64.f) + RMS_EPS) : 1.f;
#pragma unroll
                    for (int bj = 0; bj < 2; ++bj) {
                        uint4 w;
                        w.x = pk2(v[bj][0][0] * hs * gn[bj][0], v[bj][0][1] * hs * gn[bj][1]); w.y = pk2(v[bj][0][2] * hs * gn[bj][2], v[bj][0][3] * hs * gn[bj][3]);
                        w.z = pk2(v[bj][1][0] * hs * gn[bj][4], v[bj][1][1] * hs * gn[bj][5]); w.w = pk2(v[bj][1][2] * hs * gn[bj][6], v[bj][1][3] * hs * gn[bj][7]);
                        *(uint4*)(Y + (size_t)row * LDY + u.pn * 256 + wc * 64 + 32 * bj + 8 * fq) = w;
                    }
                }
            return;
        }
        const int col0 = u.pn * 256 + wc * 32 + 8 * fq;
#pragma unroll
        for (int ai = 0; ai < 2; ++ai)
#pragma unroll
            for (int m = 0; m < 4; ++m) {
                const int row = row0 + ai * 128 + m * 16; const float rs = rstd[row];
#pragma unroll
                for (int bj = 0; bj < 2; ++bj) {
                    const int col = col0 + bj * 128;
                    if (col >= OFF_END) continue;
                    f32x4 v0 = acc[ai][bj][m][0] * rs, v1 = acc[ai][bj][m][1] * rs;
                    if (col >= OFF_RY && col < OFF_Q) {
#pragma unroll
                        for (int e = 0; e < 4; ++e) { v0[e] = gelu_tanh(v0[e]); v1[e] = gelu_tanh(v1[e]); }
                    } else if (col >= OFF_MG) {
#pragma unroll
                        for (int e = 0; e < 4; ++e) { v0[e] = sigmoidf_(v0[e]); v1[e] = sigmoidf_(v1[e]); }
                    }
                    uint4 w; w.x = pk2(v0[0], v0[1]); w.y = pk2(v0[2], v0[3]); w.z = pk2(v1[0], v1[1]); w.w = pk2(v1[2], v1[3]);
                    *(uint4*)(Y + (size_t)row * LDY + col) = w;
                }
            }
    }
};
struct MergeOrder {
    pg8::StaticOrder so;
    DEVI bool next(int i, pg8::Unit& u) const {
        pg8::Unit t; if (!so.next(i / 3, t)) return false;
        const int br = i % 3;
        u.pm = t.pm; u.pn = br * 4 + t.pn; u.ao = br == 0 ? OFF_RY : (br == 1 ? OFF_RX : OFF_SB); return true;
    }
};
struct EpiMerge {
    static constexpr bool PERM = true, CHAIN = true;
    bf16_t* Y;
    DEVI void operator()(const f32x4 (&)[2][2][4][2], const pg8::Unit&, int, int, int, int) const {}
    DEVI bool chain(f32x4 (&acc)[2][2][4][2], const pg8::Unit& u, int wr, int wc, int fr, int fq) const {
        const int br = u.pn >> 2;
        const int row0 = u.pm * 256 + wr * 64 + fr, col0 = (u.pn & 3) * 256 + wc * 32 + 8 * fq;
#pragma unroll
        for (int ai = 0; ai < 2; ++ai)
#pragma unroll
            for (int m = 0; m < 4; ++m) {
                const int row = row0 + ai * 128 + m * 16;
#pragma unroll
                for (int bj = 0; bj < 2; ++bj) {
                    const bf16_t* gp = Y + (size_t)row * LDY + OFF_MG + col0 + bj * 128;
                    float g[8]; unpack8(*(const uint4*)(gp + br * 1024), g);
#pragma unroll
                    for (int e = 0; e < 8; ++e) g[e] = fmaxf(g[e], 9.5367431640625e-7f);
                    if (br < 2) {
                        float gnx[8]; unpack8(*(const uint4*)(gp + (br + 1) * 1024), gnx);
#pragma unroll
                        for (int e = 0; e < 8; ++e) { const float r = g[e] * __builtin_amdgcn_rcpf(fmaxf(gnx[e], 9.5367431640625e-7f)); acc[ai][bj][m][e >> 2][e & 3] *= r; }
                    } else {
                        uint4 w;
                        w.x = pk2(g[0] * acc[ai][bj][m][0][0], g[1] * acc[ai][bj][m][0][1]); w.y = pk2(g[2] * acc[ai][bj][m][0][2], g[3] * acc[ai][bj][m][0][3]);
                        w.z = pk2(g[4] * acc[ai][bj][m][1][0], g[5] * acc[ai][bj][m][1][1]); w.w = pk2(g[6] * acc[ai][bj][m][1][2], g[7] * acc[ai][bj][m][1][3]);
                        *(uint4*)(Y + (size_t)row * LDY + OFF_SC + col0 + bj * 128) = w;
                    }
                }
            }
        return br < 2;
    }
};
DEVI float row_rstd16(const float* ssp) {
    const f32x4 a = *(const f32x4*)ssp, b = *(const f32x4*)(ssp + 4), c = *(const f32x4*)(ssp + 8), d = *(const f32x4*)(ssp + 12);
    const float s = ((a[0] + a[1]) + (a[2] + a[3])) + ((b[0] + b[1]) + (b[2] + b[3])) + ((c[0] + c[1]) + (c[2] + c[3])) + ((d[0] + d[1]) + (d[2] + d[3]));
    return rsqrtf(s * (1.f / DM) + RMS_EPS);
}
struct EpiOut {
    static constexpr bool PERM = false, CHAIN = false;
    bf16_t* XB; float* SS;
    DEVI void operator()(const f32x4 (&acc)[2][2][4][2], const pg8::Unit& u, int wr, int wc, int fr, int fq) const {
        const int row0 = u.pm * 256 + wr * 64 + fr, col0 = u.pn * 256 + wc * 32 + 4 * fq;
#pragma unroll
        for (int ai = 0; ai < 2; ++ai)
#pragma unroll
            for (int m = 0; m < 4; ++m) {
                const int row = row0 + ai * 128 + m * 16;
                const size_t ro = (size_t)row * DM + col0;
                float s = 0.f;
#pragma unroll
                for (int bj = 0; bj < 2; ++bj)
#pragma unroll
                    for (int n = 0; n < 2; ++n) {
                        const size_t off = ro + bj * 128 + n * 16;
                        const uint2 xr = *(const uint2*)(XB + off);
                        f32x4 v = acc[ai][bj][m][n];
                        v[0] += __uint_as_float(xr.x << 16); v[1] += __uint_as_float(xr.x & 0xffff0000u); v[2] += __uint_as_float(xr.y << 16); v[3] += __uint_as_float(xr.y & 0xffff0000u);
                        uint2 w; w.x = pk2(v[0], v[1]); w.y = pk2(v[2], v[3]);
                        *(uint2*)(XB + off) = w;
                        const float r0 = __uint_as_float(w.x << 16), r1 = __uint_as_float(w.x & 0xffff0000u), r2 = __uint_as_float(w.y << 16), r3 = __uint_as_float(w.y & 0xffff0000u);
                        s += r0 * r0 + r1 * r1 + r2 * r2 + r3 * r3;
                    }
                s += shx(s, 16); s += shx(s, 32);
                if (fq == 0) SS[(size_t)row * 16 + u.pn * 4 + wc] = s;
            }
    }
};
struct CmpOrder {
    int G, c;
    DEVI bool next(int i, pg8::Unit& u) const {
        const int L = i * G + c; if (L >= 16) return false;
        const int z = L >> 3, g = (L >> 2) & 1, b = L & 3;
        u.pm = b; u.pn = 0; u.ao = (z ? OFF_VC : OFF_KC) + g * 64; return true;
    }
};
struct EpiCmp1 {
    static constexpr bool PERM = false, CHAIN = false;
    bf16_t* HID; const float* BPE;
    DEVI void operator()(const f32x4 (&acc)[2][2][4][2], const pg8::Unit& u, int wr, int wc, int fr, int fq) const {
        const int z = (u.ao >= OFF_VC) ? 1 : 0, g = ((u.ao - (z ? OFF_VC : OFF_KC)) >> 6) & 1, b = u.pm;
        const int col0 = wc * 32 + 4 * fq;
#pragma unroll
        for (int ai = 0; ai < 2; ++ai)
#pragma unroll
            for (int m = 0; m < 4; ++m) {
                const int n = ai * 128 + wr * 64 + m * 16 + fr;
                if (n >= NCMP) continue;
                bf16_t* dst = HID + ((size_t)z * 2048 + (size_t)(b * NCMP + n) * 2 + g) * 128 + col0;
#pragma unroll
                for (int nn = 0; nn < 2; ++nn) {
                    const f32x4 a = z ? acc[ai][1][m][nn] : acc[ai][0][m][nn];
                    const f32x4 bb = *(const f32x4*)(BPE + z * 128 + col0 + nn * 16);
                    uint2 o; o.x = pk2(gelu_tanh(a[0] + bb[0]), gelu_tanh(a[1] + bb[1])); o.y = pk2(gelu_tanh(a[2] + bb[2]), gelu_tanh(a[3] + bb[3]));
                    *(uint2*)(dst + nn * 16) = o;
                }
            }
    }
};
DEVI void cmp2_unit(const bf16_t* HID, const bf16_t* W2T  , const float* b2  , const float* kn0  , bf16_t* KCB, bf16_t* VCB, int z, int g, int b) {
    const int tid = TIDX; const int lane = tid & 63, w = tid >> 6, r32 = lane & 31, hi = lane >> 5;
    const int n = 32 * w + r32;
    const bf16_t* hrow = HID + ((size_t)z * 2048 + (size_t)(b * NCMP + (n < NCMP ? n : 0)) * 2 + g) * 128;
    f32x16 acc[2];
#pragma unroll
    for (int blk = 0; blk < 2; ++blk)
#pragma unroll
        for (int r = 0; r < 16; ++r) acc[blk][r] = 0.f;
#pragma unroll
    for (int s = 0; s < 8; ++s) {
        const bf16x8 hf = *(const bf16x8*)(hrow + 16 * s + 8 * hi);
#pragma unroll
        for (int blk = 0; blk < 2; ++blk) {
            const bf16x8 wf = *(const bf16x8*)(W2T + ((size_t)z * 64 + 32 * blk + r32) * 128 + 16 * s + 8 * hi);
            acc[blk] = __builtin_amdgcn_mfma_f32_32x32x16_bf16(wf, hf, acc[blk], 0, 0, 0);
        }
    }
    float ss = 0.f;
#pragma unroll
    for (int blk = 0; blk < 2; ++blk)
#pragma unroll
        for (int r = 0; r < 16; ++r) { acc[blk][r] += b2[z * 64 + 32 * blk + crow16(r, hi)]; ss += acc[blk][r] * acc[blk][r]; }
    ss = half_sum(ss);
    const float rs = (z == 0) ? rsqrtf(ss * (1.f / 64.f) + RMS_EPS) : 1.f;
    bf16_t* dst = (z ? VCB : KCB) + ((size_t)((b * 2 + g) * 256) + n) * 64;
#pragma unroll
    for (int blk = 0; blk < 2; ++blk)
#pragma unroll
        for (int gi = 0; gi < 4; ++gi) {
            const int d0 = 32 * blk + 8 * gi + 4 * hi;
            float o[4];
#pragma unroll
            for (int e = 0; e < 4; ++e) o[e] = (n < NCMP) ? acc[blk][4 * gi + e] * rs * (z == 0 ? kn0[d0 + e] : 1.f) : 0.f;
            uint2 wv; wv.x = pk2(o[0], o[1]); wv.y = pk2(o[2], o[3]);
            *(uint2*)(dst + d0) = wv;
        }
}
struct EpiRouter {
    static constexpr bool PERM = false, CHAIN = false;
    float* LOG; const float* SS;
    DEVI void operator()(const f32x4 (&acc)[2][2][4][2], const pg8::Unit& u, int wr, int wc, int fr, int fq) const {
        if (wc >= 2) return;
        const int row0 = u.pm * 256 + wr * 64 + fr, col0 = wc * 32 + 4 * fq;
#pragma unroll
        for (int ai = 0; ai < 2; ++ai)
#pragma unroll
            for (int m = 0; m < 4; ++m) {
                const int row = row0 + ai * 128 + m * 16;
                const float rs = row_rstd16(SS + (size_t)row * 16);
#pragma unroll
                for (int n = 0; n < 2; ++n) *(f32x4*)(LOG + (size_t)row * 64 + col0 + n * 16) = acc[ai][0][m][n] * rs;
            }
    }
};
constexpr int LDS_ROWT = 132096;
struct EpiMoeUp {
    static constexpr bool PERM = true, CHAIN = false;
    bf16_t* HM; const float* wl; const float* rsl;
    DEVI void operator()(const f32x4 (&acc)[2][2][4][2], const pg8::Unit& u, int wr, int wc, int fr, int fq) const {
        const int rl0 = wr * 64 + fr, col0 = (u.pn & 1) * 128 + wc * 32 + 8 * fq;
#pragma unroll
        for (int ai = 0; ai < 2; ++ai)
#pragma unroll
            for (int m = 0; m < 4; ++m) {
                const int rl = rl0 + ai * 128 + m * 16; const float w = wl[u.aux * 256 + rl], rs = rsl[u.aux * 256 + rl];
                float h[8];
#pragma unroll
                for (int n = 0; n < 2; ++n)
#pragma unroll
                    for (int q = 0; q < 4; ++q) { const float g = acc[ai][0][m][n][q] * rs; h[n * 4 + q] = g * sigmoidf_(g) * (acc[ai][1][m][n][q] * rs) * w; }
                uint4 o; o.x = pk2(h[0], h[1]); o.y = pk2(h[2], h[3]); o.z = pk2(h[4], h[5]); o.w = pk2(h[6], h[7]);
                *(uint4*)(HM + (size_t)(u.pm * 256 + rl) * 256 + col0) = o;
            }
    }
};
struct MoeUpOrder {
    const int* tb; int G, c; const int* tokl;
    DEVI bool next(int i, pg8::Unit& u) const {
        const int L = i * G + c, total = tb[NEXP] * 2;
        if (i >= 2 || L >= total) return false;
        const int rt = L >> 1;
        u.pm = rt; u.pn = tb[40 + rt] * 2 + (L & 1); u.aux = i; return true;
    }
    DEVI int a_row(int ord, int r) const { return tokl[ord * 256 + r]; }
};
DEVI void moe_up_setup(const int* cnt, const int* LIST, const float* RW, const float* SS, int* TOKS, int* tb, int* tokl, float* wl, float* rsl, int bid, int G) {
    const int tid = TIDX;
    if (tid == 0) { int a = 0; for (int e = 0; e < NEXP; ++e) { tb[e] = a; a += (cnt[e] + 255) >> 8; } tb[NEXP] = a; }
    __syncthreads();
    if (tid < 192) { int e = 0; for (int q = 1; q < NEXP; ++q) e += (tb[q] <= tid) ? 1 : 0; tb[40 + tid] = e; }
    __syncthreads();
    const int ord = tid >> 8, rl = tid & 255, L = ord * G + bid;
    int tok = 0; float w = 0.f, rs = 0.f;
    if (L < tb[NEXP] * 2) {
        const int rt = L >> 1, e = tb[40 + rt], r = (rt - tb[e]) * 256 + rl;
        int slot = -1;
        if (r < cnt[e]) { slot = LIST[e * MTOK + r]; tok = slot >> 1; w = RW[slot]; rs = row_rstd16(SS + (size_t)tok * 16); }
        TOKS[rt * 256 + rl] = slot;
    }
    tokl[tid] = tok; wl[tid] = w; rsl[tid] = rs;
    __syncthreads();
}
struct EpiMoeDown {
    static constexpr bool PERM = true, CHAIN = false;
    bf16_t* YS; const int* SLOTS;
    DEVI void operator()(const f32x4 (&acc)[2][2][4][2], const pg8::Unit& u, int wr, int wc, int fr, int fq) const {
        const int row0 = u.pm * 256 + wr * 64 + fr, col0 = (u.pn & 3) * 256 + wc * 32 + 8 * fq;
#pragma unroll
        for (int ai = 0; ai < 2; ++ai)
#pragma unroll
            for (int m = 0; m < 4; ++m) {
                const int slot = SLOTS[row0 + ai * 128 + m * 16];
                if (slot >= 0) {
                    bf16_t* dst = YS + (size_t)slot * DM + col0;
#pragma unroll
                    for (int bj = 0; bj < 2; ++bj) {
                        uint4 w; w.x = pk2(acc[ai][bj][m][0][0], acc[ai][bj][m][0][1]); w.y = pk2(acc[ai][bj][m][0][2], acc[ai][bj][m][0][3]);
                        w.z = pk2(acc[ai][bj][m][1][0], acc[ai][bj][m][1][1]); w.w = pk2(acc[ai][bj][m][1][2], acc[ai][bj][m][1][3]);
                        *(uint4*)(dst + bj * 128) = w;
                    }
                }
                asm volatile("" ::: "memory");
            }
    }
};
DEVI void phase_combine(bf16_t* XB, const bf16_t* YS, float* rstd, float* xout, bool next) {
    const int tid = TIDX; const int bid = BIDX; const int lane = tid & 63, gw = bid * 8 + (tid >> 6), ngw = gridDim.x * 8;
    for (int m0 = gw * 2; m0 < MTOK; m0 += ngw * 2) {
        uint2 xv[2][4], a[2][4], b[2][4];
#pragma unroll
        for (int u = 0; u < 2; ++u) {
            const int m = m0 + u;
            const uint2* xr = (const uint2*)(XB + (size_t)m * DM) + lane;
            const uint2* y0 = (const uint2*)(YS + (size_t)(2 * m) * DM) + lane; const uint2* y1 = (const uint2*)(YS + (size_t)(2 * m + 1) * DM) + lane;
#pragma unroll
            for (int j = 0; j < 4; ++j) { xv[u][j] = xr[64 * j]; a[u][j] = y0[64 * j]; b[u][j] = y1[64 * j]; }
        }
#pragma unroll
        for (int u = 0; u < 2; ++u) {
            const int m = m0 + u;
            f32x4* xr = (f32x4*)(xout + (size_t)m * DM) + lane; uint2* xo = (uint2*)(XB + (size_t)m * DM) + lane;
            float s = 0.f;
#pragma unroll
            for (int j = 0; j < 4; ++j) {
                const uint2 xx = xv[u][j], aa = a[u][j], bb = b[u][j];
                f32x4 w;
                w[0] = __uint_as_float(xx.x << 16) + __uint_as_float(aa.x << 16) + __uint_as_float(bb.x << 16); w[1] = __uint_as_float(xx.x & 0xffff0000u) + __uint_as_float(aa.x & 0xffff0000u) + __uint_as_float(bb.x & 0xffff0000u);
                w[2] = __uint_as_float(xx.y << 16) + __uint_as_float(aa.y << 16) + __uint_as_float(bb.y << 16); w[3] = __uint_as_float(xx.y & 0xffff0000u) + __uint_as_float(aa.y & 0xffff0000u) + __uint_as_float(bb.y & 0xffff0000u);
                if (next) {
                    uint2 o; o.x = pk2(w[0], w[1]); o.y = pk2(w[2], w[3]); xo[64 * j] = o;
                    const float r0 = __uint_as_float(o.x << 16), r1 = __uint_as_float(o.x & 0xffff0000u), r2 = __uint_as_float(o.y << 16), r3 = __uint_as_float(o.y & 0xffff0000u);
                    s += r0 * r0 + r1 * r1 + r2 * r2 + r3 * r3;
                } else xr[64 * j] = w;
            }
            if (next) { s = wave_sum(s); if (lane == 0) rstd[m] = rsqrtf(s * (1.f / DM) + RMS_EPS); }
        }
    }
}
struct MoeOrder {
    const int* tb; int nsplit, G, c;
    DEVI bool next(int i, pg8::Unit& u) const {
        const int L = i * G + c, total = tb[NEXP] * nsplit;
        if (L >= total) return false;
        const int rt = L / nsplit, part = L % nsplit;
        u.pm = rt; u.pn = tb[40 + rt] * nsplit + part; return true;
    }
};

DEVI void phase_gather(const bf16_t* XB, const float* SS, const int* cnt, const int* LIST, const float* RW, bf16_t* XG, int* TOKS, float* RWS, int* tb) {
    const int tid = TIDX; const int bid = BIDX; const int lane = tid & 63, gw = bid * 8 + (tid >> 6), ngw = gridDim.x * 8;
    if (tid == 0) { int a = 0; for (int e = 0; e < NEXP; ++e) { tb[e] = a; a += (cnt[e] + 255) >> 8; } tb[NEXP] = a; }
    __syncthreads();
    if (tid < 192) { int e = 0; for (int q = 1; q < NEXP; ++q) e += (tb[q] <= tid) ? 1 : 0; tb[40 + tid] = e; }
    __syncthreads();
    const int total = tb[NEXP] * 256;
    for (int rp0 = gw * 4; rp0 < total; rp0 += ngw * 4) {
        int slot[4]; bool ok[4];
#pragma unroll
        for (int q = 0; q < 4; ++q) {
            const int rp = rp0 + q, rt = rp >> 8;
            const int e = tb[40 + rt];
            const int r = rp - tb[e] * 256;
            ok[q] = r < cnt[e];
            slot[q] = ok[q] ? LIST[e * MTOK + r] : 0;
        }
        uint4 xr[4][2]; float rs[4], rw[4];
#pragma unroll
        for (int q = 0; q < 4; ++q) {
            const int tok = slot[q] >> 1;
            rs[q] = row_rstd16(SS + (size_t)tok * 16); rw[q] = RW[slot[q]];
            const uint4* xp = (const uint4*)(XB + (size_t)tok * DM) + lane;
            xr[q][0] = xp[0]; xr[q][1] = xp[64];
        }
#pragma unroll
        for (int q = 0; q < 4; ++q) {
            const int rp = rp0 + q;
            if (ok[q]) {
                uint4* xo = (uint4*)(XG + (size_t)rp * DM) + lane;
#pragma unroll
                for (int j = 0; j < 2; ++j) { float v[8]; unpack8(xr[q][j], v); const float s = rs[q]; uint4 o; o.x = pk2(v[0] * s, v[1] * s); o.y = pk2(v[2] * s, v[3] * s); o.z = pk2(v[4] * s, v[5] * s); o.w = pk2(v[6] * s, v[7] * s); xo[64 * j] = o; }
            }
            if (lane == 0) { TOKS[rp] = ok[q] ? slot[q] : -1; RWS[rp] = ok[q] ? rw[q] : 0.f; }
        }
    }
}

#ifndef NSA_FAST
#define NSA_FAST 1
#endif
DEVI void phase_qknorm(bf16_t* Y, const float* qn  , const float* kn  , int vb, int vg) {
    const int tid = TIDX; const int bid = vb; const int lane = tid & 63, gw = bid * 8 + (tid >> 6), ngw = vg * 8;
    const int sl = lane >> 4, e0 = (lane & 15) * 4;
    const int col2 = (sl < 2 ? OFF_KS + sl * 64 : OFF_KW + (sl - 2) * 64);
    const float* gn2 = kn + (sl < 2 ? 64 : 128);
    float g[3][4];
#pragma unroll
    for (int e = 0; e < 4; ++e) { g[0][e] = qn[e0 + e]; g[1][e] = g[0][e]; g[2][e] = gn2[e0 + e]; }
#if NSA_FAST
#pragma unroll
    for (int e = 0; e < 4; ++e) { g[0][e] *= 0.125f * 1.4426950408889634f; g[1][e] *= 0.125f * 1.4426950408889634f; }
#endif
    for (int m0 = gw * 2; m0 < MTOK; m0 += ngw * 2) {
        uint2 raw[2][3];
#pragma unroll
        for (int u = 0; u < 2; ++u) {
            bf16_t* row = Y + (size_t)(m0 + u) * LDY;
            raw[u][0] = *(const uint2*)(row + OFF_Q + sl * 64 + e0); raw[u][1] = *(const uint2*)(row + OFF_Q + (4 + sl) * 64 + e0); raw[u][2] = *(const uint2*)(row + col2 + e0);
        }
#pragma unroll
        for (int u = 0; u < 2; ++u) {
            bf16_t* row = Y + (size_t)(m0 + u) * LDY;
#pragma unroll
            for (int part = 0; part < 3; ++part) {
                const uint2 r = raw[u][part];
                const float v0 = __uint_as_float(r.x << 16), v1 = __uint_as_float(r.x & 0xffff0000u), v2 = __uint_as_float(r.y << 16), v3 = __uint_as_float(r.y & 0xffff0000u);
                float s = v0 * v0 + v1 * v1 + v2 * v2 + v3 * v3;
                s += shx(s, 1); s += shx(s, 2); s += shx(s, 4); s += shx(s, 8);
                const float rs = rsqrtf(s * (1.f / 64.f) + RMS_EPS);
                uint2 o; o.x = pk2(v0 * rs * g[part][0], v1 * rs * g[part][1]); o.y = pk2(v2 * rs * g[part][2], v3 * rs * g[part][3]);
                *(uint2*)(row + (part == 0 ? OFF_Q + sl * 64 : (part == 1 ? OFF_Q + (4 + sl) * 64 : col2)) + e0) = o;
            }
        }
    }
}

DEVI void phase_rglru1(const bf16_t* Y, const float* convw  , const float* convb, const float* wa  , const float* ba,
                       const float* wx, const float* bx, const float* lam, float* LA, bf16_t* VV, float* PA, float* PH, float* lds, int vb, int vg) {
    bf16_t* UB = (bf16_t*)lds;
    bf16_t* WT = UB + 64 * 72;
    float* SEG = (float*)(WT + 128 * 72);
    const int tid = TIDX;
    const int n = vb & 7;
    const int nper = vg >> 3;
    if ((vb >> 3) >= nper) return;
    __syncthreads();
    for (int e = tid; e < 8192; e += 512) {
        const int o = e & 127, i = e >> 7;
        WT[o * 72 + i] = f2bf(o < 64 ? wa[n * 4096 + i * 64 + o] : wx[n * 4096 + i * 64 + o - 64]);
    }
    const int j = tid & 63, tg = tid >> 6;
    const int lane = tid & 63, w = tid >> 6, mt = w & 3, cgp = w >> 2;
    const int chj = n * 64 + j;
    const float cw0 = convw[chj], cw1 = convw[512 + chj], cw2 = convw[1024 + chj], cw3 = convw[1536 + chj], cb = convb[chj];
    float bav[2], bxv[2], sp[2];
#pragma unroll
    for (int q = 0; q < 2; ++q) {
        const int ch = n * 64 + 16 * (cgp * 2 + q) + (lane & 15);
        bav[q] = ba[ch]; bxv[q] = bx[ch];
        const float ex = __expf(-lam[ch]);
        sp[q] = (ex < 0.03f) ? ex * (1.f - ex * (0.5f - ex * (0.33333334f - 0.25f * ex))) : __logf(1.f + ex);
    }
    float xin[11];
    {   const int c = vb >> 3; const int tl0 = (c & 63) * 64; const size_t m0 = (size_t)c * 64;
#pragma unroll
        for (int i = 0; i < 11; ++i) { const int t = tg * 8 + i - 3; xin[i] = (tl0 + t >= 0) ? bf2f(Y[(m0 + t) * LDY + OFF_RX + chj]) : 0.f; }
    }
    for (int c = vb >> 3; c < 256; c += nper) {
        const size_t m0 = (size_t)c * 64;
        __syncthreads();
#pragma unroll
        for (int q = 0; q < 8; ++q) UB[(tg * 8 + q) * 72 + j] = f2bf(cb + cw0 * xin[q] + cw1 * xin[q + 1] + cw2 * xin[q + 2] + cw3 * xin[q + 3]);
        if (c + nper < 256) {
            const int cn = c + nper; const int tl0 = (cn & 63) * 64; const size_t mn = (size_t)cn * 64;
#pragma unroll
            for (int i = 0; i < 11; ++i) { const int t = tg * 8 + i - 3; xin[i] = (tl0 + t >= 0) ? bf2f(Y[(mn + t) * LDY + OFF_RX + chj]) : 0.f; }
        }
        __syncthreads();
        f32x4 accr[2], acci[2];
#pragma unroll
        for (int q = 0; q < 2; ++q) { accr[q] = zero4(); acci[q] = zero4(); }
#pragma unroll
        for (int ks = 0; ks < 2; ++ks) {
            const bf16x8 af = *(const bf16x8*)(UB + (16 * mt + (lane & 15)) * 72 + 8 * (lane >> 4) + 32 * ks);
#pragma unroll
            for (int q = 0; q < 2; ++q) {
                const int o = 16 * (cgp * 2 + q) + (lane & 15);
                const bf16x8 br_ = *(const bf16x8*)(WT + o * 72 + 8 * (lane >> 4) + 32 * ks);
                const bf16x8 bi_ = *(const bf16x8*)(WT + (64 + o) * 72 + 8 * (lane >> 4) + 32 * ks);
                accr[q] = __builtin_amdgcn_mfma_f32_16x16x32_bf16(af, br_, accr[q], 0, 0, 0);
                acci[q] = __builtin_amdgcn_mfma_f32_16x16x32_bf16(af, bi_, acci[q], 0, 0, 0);
            }
        }
#pragma unroll
        for (int q = 0; q < 2; ++q) {
            const int cl = 16 * (cgp * 2 + q) + (lane & 15), ch = n * 64 + cl;
            float hseg = 0.f, aseg = 1.f;
#pragma unroll
            for (int r = 0; r < 4; ++r) {
                const int t = 16 * mt + 4 * (lane >> 4) + r;
                const float rg = sigmoidf_(accr[q][r] + bav[q]), ig = sigmoidf_(acci[q][r] + bxv[q]);
                const float la = -8.0f * rg * sp[q];
                const float y2 = 2.f * la;
                const float om = (y2 > -0.01f) ? -y2 * (1.f + y2 * (0.5f + y2 * 0.16666667f)) : 1.f - __expf(y2);
                const bf16_t vb16 = f2bf(sqrtf(om) * ig * bf2f(UB[t * 72 + cl]));
                LA[(m0 + t) * 512 + ch] = la; VV[(m0 + t) * 512 + ch] = vb16;
                const float a = __expf(la);
                hseg = a * hseg + bf2f(vb16); aseg *= a;
            }
            const int seg = 4 * mt + (lane >> 4);
            SEG[(seg * 64 + cl) * 2] = aseg; SEG[(seg * 64 + cl) * 2 + 1] = hseg;
        }
        __syncthreads();
        if (tid < 64) {
            float h = 0.f, A = 1.f;
#pragma unroll
            for (int s = 0; s < 16; ++s) { const float a = SEG[(s * 64 + tid) * 2]; h = a * h + SEG[(s * 64 + tid) * 2 + 1]; A *= a; }
            PA[c * 512 + n * 64 + tid] = A; PH[c * 512 + n * 64 + tid] = h;
        }
    }
    __syncthreads();
}

DEVI void phase_shortconv(bf16_t* Y, const float* w  , int vb, int vg) {
    const int tid = TIDX; const int bid = vb; const int gt = bid * 512 + tid, ngt = vg * 512;
    for (int it = gt; it < (MTOK / 8) * 64; it += ngt) {
        const int cg8 = (it & 63) * 8, m0 = (it >> 6) * 8, tl0 = m0 & (SEQ - 1);
        float wk[3][8];
#pragma unroll
        for (int k = 0; k < 3; ++k) load8f(w + k * 512 + cg8, wk[k]);
        uint4 rc[10], rh[10], rb[8];
#pragma unroll
        for (int i = 0; i < 10; ++i) {
            const int d = i - 2;
            if (tl0 + d >= 0) { const bf16_t* r = Y + (size_t)(m0 + d) * LDY; rc[i] = *(const uint4*)(r + OFF_SC + cg8); rh[i] = *(const uint4*)(r + OFF_SH + cg8); }
            else { rc[i] = make_uint4(0, 0, 0, 0); rh[i] = make_uint4(0, 0, 0, 0); }
        }
#pragma unroll
        for (int i = 0; i < 8; ++i) rb[i] = *(const uint4*)(Y + (size_t)(m0 + i) * LDY + OFF_SB + cg8);
        float p[10][8];
#pragma unroll
        for (int i = 0; i < 10; ++i) { float a[8], b2[8]; unpack8(rc[i], a); unpack8(rh[i], b2);
#pragma unroll
            for (int e = 0; e < 8; ++e) p[i][e] = a[e] * b2[e]; }
#pragma unroll
        for (int i = 0; i < 8; ++i) {
            float sb[8]; unpack8(rb[i], sb);
            float o[8];
#pragma unroll
            for (int e = 0; e < 8; ++e) o[e] = sb[e] * (wk[0][e] * p[i][e] + wk[1][e] * p[i + 1][e] + wk[2][e] * p[i + 2][e]);
            uint4 ow; ow.x = pk2(o[0], o[1]); ow.y = pk2(o[2], o[3]); ow.z = pk2(o[4], o[5]); ow.w = pk2(o[6], o[7]);
            *(uint4*)(Y + (size_t)(m0 + i) * LDY + OFF_SB + cg8) = ow;
        }
    }
}

DEVI void phase_cmp1(const bf16_t* Y, const float* pe  , const float* w1  , const float* b1  , float* HID, bf16_t* As, bf16_t* Bs) {
    const int tid = TIDX; const int bid = BIDX;
    for (int t = bid; t < 32; t += gridDim.x) {
        const int z = t >> 4, rt = t & 15;
        const int r = rt * 128 + (tid >> 2);
        const bool rv = r < NB * NCMP * 2;
        const int g = r & 1, bn_ = r >> 1, b = bn_ / NCMP, n = bn_ % NCMP;
        const bf16_t* abase = Y + (size_t)(b * SEQ + 16 * n) * LDY + (z ? OFF_VC : OFF_KC) + g * 64;
        const float* pez = pe + z * 2048;
        const float* wz = w1 + (size_t)z * 2048 * 128 + (tid & 15) * 8;
        f32x4 acc[2][4]; acc_zero(acc);
        gemm_tile(tid, acc, 2048, As, Bs,
                  [&](int k, float (&v)[8]) {
                      if (rv) { const int lp = k >> 6, d = k & 63; load8b(abase + (size_t)lp * LDY + d, v);
#pragma unroll
                          for (int j = 0; j < 8; ++j) v[j] += pez[k + j]; }
                      else zero8(v); },
                  [&](int k, float (&v)[8]) { load8f(wz + (size_t)k * 128, v); });
#pragma unroll
        for (int i = 0; i < 2; ++i) {
            const int rr = rt * 128 + ACC_ROW(i);
#pragma unroll
            for (int j = 0; j < 4; ++j) {
                const int c = ACC_COL(j);
                f32x4 o;
#pragma unroll
                for (int e = 0; e < 4; ++e) o[e] = gelu_tanh(acc[i][j][e] + b1[z * 128 + c + e]);
                *(f32x4*)(HID + ((size_t)z * 2048 + rr) * 128 + c) = o;
            }
        }
    }
}

DEVI void phase_cmp2_carry(const float* HID, const float* w2  , const float* b2  , const float* kn0  , float* KCMP, float* VCMP,
                           bf16_t* KCB, bf16_t* VCB) {
    const int tid = TIDX; const int bid = BIDX; const int lane = tid & 63, gw = bid * 8 + (tid >> 6), ngw = gridDim.x * 8;
    for (int it = gw; it < 2 * NB * NCMP * 2; it += ngw) {
        const int z = it / (NB * NCMP * 2), r = it % (NB * NCMP * 2);
        const float* h = HID + ((size_t)z * 2048 + r) * 128;
        const float* w = w2 + z * 8192 + lane;
        float acc = b2[z * 64 + lane];
        for (int j = 0; j < 128; ++j) acc += h[j] * w[j * 64];
        const int g = r & 1, bn_ = r >> 1, b = bn_ / NCMP, n = bn_ % NCMP;
        float* dst = (z ? VCMP : KCMP) + ((size_t)(b * 256 + n) * 2 + g) * 64 + lane;
        if (z == 0) { const float s = wave_sum(acc * acc); acc = acc * rsqrtf(s * (1.f / 64.f) + RMS_EPS) * kn0[lane]; }
        *dst = acc;
        (z ? VCB : KCB)[((size_t)((b * 2 + g) * 256) + n) * 64 + lane] = f2bf(acc);
    }
    if (gw < 16) { const int z = gw >> 3, bg = gw & 7; (z ? VCB : KCB)[((size_t)(bg * 256) + 255) * 64 + lane] = 0; }
}

DEVI void phase_rglru2(bf16_t* __restrict__ Y, const float* __restrict__ LA, const bf16_t* __restrict__ VV, const float* __restrict__ PA, const float* __restrict__ PH) {
    const int tid = TIDX; const int bid = BIDX; const int gt = bid * 512 + tid, ngt = gridDim.x * 512;
    for (int e = gt; e < 256 * 512; e += ngt) {
        const int c = e >> 9, ch = e & 511, cl = c & 63;
        const float* pa = PA + (size_t)(c - cl) * 512 + ch; const float* ph = PH + (size_t)(c - cl) * 512 + ch;
        float h = 0.f;
#pragma unroll 8
        for (int cc = 0; cc < cl; ++cc) h = pa[cc * 512] * h + ph[cc * 512];
        const size_t m0 = (size_t)c * 64;
#pragma unroll 1
        for (int t0 = 0; t0 < 64; t0 += 8) {
            float la[8], vv[8], ry[8];
#pragma unroll
            for (int i = 0; i < 8; ++i) { const size_t m = m0 + t0 + i; la[i] = LA[m * 512 + ch]; vv[i] = bf2f(VV[m * 512 + ch]); ry[i] = bf2f(Y[m * LDY + OFF_RY + ch]); }
#pragma unroll
            for (int i = 0; i < 8; ++i) { h = __expf(la[i]) * h + vv[i]; ry[i] *= h; }
#pragma unroll
            for (int i = 0; i < 8; ++i) Y[(m0 + t0 + i) * LDY + OFF_RY + ch] = f2bf(ry[i]);
        }
    }
}

DEVI void attend_block(const bf16_t* Y, int b, int g, int j, int t, int lo, int offk, int offv, const float* qs, float* ps, float (&mx)[4], float (&l)[4], float (&o)[4], int lane) {
    const int pos = 64 * j + lane;
    const bool valid = (pos <= t) && (pos >= lo);
    const bf16_t* kr = Y + (size_t)(b * SEQ + pos) * LDY + offk + g * 64;
    float s[4] = {0.f, 0.f, 0.f, 0.f};
#pragma unroll 2
    for (int d8 = 0; d8 < 8; ++d8) {
        float kv[8]; load8b(kr + d8 * 8, kv);
#pragma unroll
        for (int h = 0; h < 4; ++h) {
            const f32x4 qa = *(const f32x4*)(qs + h * 64 + d8 * 8), qb = *(const f32x4*)(qs + h * 64 + d8 * 8 + 4);
            s[h] += qa[0] * kv[0] + qa[1] * kv[1] + qa[2] * kv[2] + qa[3] * kv[3] + qb[0] * kv[4] + qb[1] * kv[5] + qb[2] * kv[6] + qb[3] * kv[7];
        }
    }
    LDS_FENCE();
#pragma unroll
    for (int h = 0; h < 4; ++h) {
        const float sv = valid ? s[h] : -1e30f;
        const float mn = fmaxf(mx[h], wave_max(sv));
        const float corr = __expf(mx[h] - mn);
        const float p = valid ? __expf(sv - mn) : 0.f;
        l[h] = l[h] * corr + wave_sum(p);
        o[h] *= corr; mx[h] = mn;
        ps[h * 64 + lane] = p;
    }
    LDS_FENCE();
    const bf16_t* vr = Y + (size_t)(b * SEQ + 64 * j) * LDY + offv + g * 64 + lane;
    for (int k = 0; k < 64; ++k) {
        const float v = bf2f(vr[(size_t)k * LDY]);
#pragma unroll
        for (int h = 0; h < 4; ++h) o[h] += ps[h * 64 + k] * v;
    }
    LDS_FENCE();
}

DEVI void phase_nsa(bf16_t* Y, const float* KCMP, const float* VCMP, float* lds) {
    const int tid = TIDX; const int bid = BIDX; const int lane = tid & 63, wv = tid >> 6, gw = bid * 8 + wv, ngw = gridDim.x * 8;
    float* qs = lds + wv * 1536;
    float* ps = qs + 256;
    float* pss = ps + 1024;
    for (int it = gw; it < MTOK * 2; it += ngw) {
        const int g = it & 1, m = it >> 1, b = m >> 12, t = m & (SEQ - 1);
        bf16_t* qrow = Y + (size_t)m * LDY + OFF_Q + g * 256;
        LDS_FENCE();
#pragma unroll
        for (int h = 0; h < 4; ++h) qs[h * 64 + lane] = bf2f(qrow[h * 64 + lane]) * 0.125f;
        LDS_FENCE();
        const int nvalid = (t >= 31) ? ((t - 31) / 16 + 1) : 0;
        float sc[4][4];
#pragma unroll
        for (int i = 0; i < 4; ++i) {
            const int n = lane + 64 * i;
#pragma unroll
            for (int h = 0; h < 4; ++h) sc[i][h] = -1e30f;
            if (n < nvalid) {
                const float* kp = KCMP + ((size_t)(b * 256 + n) * 2 + g) * 64;
                float s[4] = {0.f, 0.f, 0.f, 0.f};
#pragma unroll 4
                for (int d4 = 0; d4 < 16; ++d4) {
                    const f32x4 kv = *(const f32x4*)(kp + d4 * 4);
#pragma unroll
                    for (int h = 0; h < 4; ++h) { const f32x4 qa = *(const f32x4*)(qs + h * 64 + d4 * 4); s[h] += qa[0] * kv[0] + qa[1] * kv[1] + qa[2] * kv[2] + qa[3] * kv[3]; }
                }
#pragma unroll
                for (int h = 0; h < 4; ++h) sc[i][h] = s[h];
            }
        }
        float psum[4] = {0.f, 0.f, 0.f, 0.f};
#pragma unroll
        for (int h = 0; h < 4; ++h) {
            const float mxv = wave_max(fmaxf(fmaxf(sc[0][h], sc[1][h]), fmaxf(sc[2][h], sc[3][h])));
            float p[4], su = 0.f;
#pragma unroll
            for (int i = 0; i < 4; ++i) { p[i] = (lane + 64 * i < nvalid) ? __expf(sc[i][h] - mxv) : 0.f; su += p[i]; }
            su = wave_sum(su);
            const float inv = nvalid > 0 ? 1.f / su : 0.f;
#pragma unroll
            for (int i = 0; i < 4; ++i) { p[i] *= inv; ps[h * 256 + lane + 64 * i] = p[i]; psum[i] += p[i]; }
        }
#pragma unroll
        for (int i = 0; i < 4; ++i) pss[lane + 64 * i] = psum[i];
        LDS_FENCE();
        float oc[4] = {0.f, 0.f, 0.f, 0.f};
        for (int n = 0; n < nvalid; ++n) {
            const float v = VCMP[((size_t)(b * 256 + n) * 2 + g) * 64 + lane];
#pragma unroll
            for (int h = 0; h < 4; ++h) oc[h] += ps[h * 256 + n] * v;
        }
        const int j = lane, cur = t >> 6;
        float imp = pss[4 * j] + pss[4 * j + 1] + pss[4 * j + 2] + 0.5f * pss[4 * j + 3];
        if (j >= 1) imp += 0.5f * pss[4 * j - 1];
        LDS_FENCE();
        const bool forced = (j == 0) || (j == cur) || (j + 1 == cur);
        const bool cand = (j >= 1) && (j + 2 <= cur);
        const int nforced = cur == 0 ? 1 : (cur == 1 ? 2 : 3), quota = 16 - nforced;
        bool sel;
        if (cur - 2 <= quota) sel = forced || cand;
        else {
            int rank = 0;
            for (int jj = 1; jj <= cur - 2; ++jj) { const float v = __shfl(imp, jj); rank += ((v > imp) || (v == imp && jj < j)) ? 1 : 0; }
            sel = forced || (cand && rank < quota);
        }
        unsigned long long mask = __ballot(sel);
        float ms[4], ls[4], os[4];
#pragma unroll
        for (int h = 0; h < 4; ++h) { ms[h] = -1e30f; ls[h] = 0.f; os[h] = 0.f; }
        while (mask) {
            const int jb = __builtin_ctzll(mask); mask &= mask - 1;
            attend_block(Y, b, g, jb, t, 0, OFF_KS, OFF_VS, qs, ps, ms, ls, os, lane);
        }
        float mw[4], lw[4], ow[4];
#pragma unroll
        for (int h = 0; h < 4; ++h) { mw[h] = -1e30f; lw[h] = 0.f; ow[h] = 0.f; }
        const int lo = t - 511 > 0 ? t - 511 : 0;
        for (int jb = lo >> 6; jb <= cur; ++jb) attend_block(Y, b, g, jb, t, lo, OFF_KW, OFF_VW, qs, ps, mw, lw, ow, lane);
        const bf16_t* gp = Y + (size_t)m * LDY + OFF_NG + g * 12;
#pragma unroll
        for (int h = 0; h < 4; ++h) {
            const float gc = bf2f(gp[h * 3]), gs = bf2f(gp[h * 3 + 1]), gwn = bf2f(gp[h * 3 + 2]);
            const float o = gc * oc[h] + gs * os[h] / ls[h] + gwn * ow[h] / lw[h];
            qrow[h * 64 + lane] = f2bf(o);
        }
    }
}

DEVI float ld_sc1(const float* p) { return __hip_atomic_load(p, __ATOMIC_RELAXED, __HIP_MEMORY_SCOPE_AGENT); }
DEVI void router_finalize(int m, const float* LOG, const float* bg, const float* be, int* cnt  , int* LIST, float* RW) {
    const float* lg = LOG + (size_t)m * 64;
    float gl[4];
#pragma unroll
    for (int o = 0; o < 4; ++o) gl[o] = ld_sc1(lg + o) + bg[o];
    int grp = 0; float gmax = gl[0];
#pragma unroll
    for (int o = 1; o < 4; ++o) if (gl[o] > gmax) { gmax = gl[o]; grp = o; }
    float gs = 0.f;
#pragma unroll
    for (int o = 0; o < 4; ++o) gs += __expf(gl[o] - gmax);
    const float pgrp = 1.f / gs;
    float el[8];
#pragma unroll
    for (int i = 0; i < 8; ++i) el[i] = ld_sc1(lg + 4 + grp * 8 + i) + be[grp * 8 + i];
    int i0 = 0; float m0 = el[0];
#pragma unroll
    for (int i = 1; i < 8; ++i) if (el[i] > m0) { m0 = el[i]; i0 = i; }
    int i1 = -1; float m1 = -3.0e38f;
#pragma unroll
    for (int i = 0; i < 8; ++i) if (i != i0 && el[i] > m1) { m1 = el[i]; i1 = i; }
    const float e1 = __expf(m1 - m0);
    const float w0 = pgrp / (1.f + e1), w1 = pgrp * e1 / (1.f + e1);
    const int ea = grp * 8 + i0, eb = grp * 8 + i1;
    const int pa = atomicAdd(cnt + ea, 1); LIST[ea * MTOK + pa] = m * 2;
    const int pb = atomicAdd(cnt + eb, 1); LIST[eb * MTOK + pb] = m * 2 + 1;
    RW[m * 2] = w0; RW[m * 2 + 1] = w1;
}


struct NsaCtx {
    LAS3 unsigned char* lds;
    int tid, lane, r32, hi, w;
    unsigned okY, ovY, okC, ovC;
};
DEVI void nsa_dma(const NsaCtx& c, int slot, const bf16_t* kbase, const bf16_t* vbase, unsigned ok, unsigned ov) {
    __builtin_amdgcn_global_load_lds((const unsigned*)((const char*)kbase + ok), (LAS3 unsigned*)(c.lds + slot * 16384 + c.w * 1024), 16, 0, 0);
    __builtin_amdgcn_global_load_lds((const unsigned*)((const char*)vbase + ov), (LAS3 unsigned*)(c.lds + slot * 16384 + 8192 + c.w * 1024), 16, 0, 0);
}
#define NSA_WAIT_BAR(N) do { asm volatile("s_waitcnt vmcnt(" #N ")" ::: "memory"); __builtin_amdgcn_s_barrier(); asm volatile("" ::: "memory"); } while (0)
template <class NextFn, class SrcFn, class BodyFn>
DEVI void nsa_run(const NsaCtx& c, int& slot, int first, unsigned ok, unsigned ov, NextFn next, SrcFn srcf, BodyFn body) {
    int t0 = first, t1 = next(t0);
    { const bf16_t* kb; const bf16_t* vb; srcf(t0, kb, vb); nsa_dma(c, slot, kb, vb, ok, ov); }
    if (t1 >= 0) { const bf16_t* kb; const bf16_t* vb; srcf(t1, kb, vb); nsa_dma(c, slot == 2 ? 0 : slot + 1, kb, vb, ok, ov); }
#pragma unroll 1
    while (t0 >= 0) {
        if (t1 >= 0) NSA_WAIT_BAR(2); else NSA_WAIT_BAR(0);
        const int t2 = (t1 >= 0) ? next(t1) : -1;
        if (t2 >= 0) { const bf16_t* kb; const bf16_t* vb; srcf(t2, kb, vb); nsa_dma(c, slot == 0 ? 2 : slot - 1, kb, vb, ok, ov); }
        body(t0, slot);
        t0 = t1; t1 = t2; slot = slot == 2 ? 0 : slot + 1;
    }
}
DEVI void nsa_scores(const NsaCtx& c, int buf, const f32x16& z, f32x16& p0, f32x16& p1) {
    const LAS3 bf16x8* qfl = (const LAS3 bf16x8*)(c.lds + NSA_QF) + c.tid;
    const LAS3 unsigned char* kb = c.lds + buf * 16384 + c.r32 * 128;
    const int sw = (c.r32 >> 1) & 7;
#pragma unroll
    for (int s = 0; s < 4; ++s) {
        const bf16x8 k0 = *(const LAS3 bf16x8*)(kb + (((2 * s + c.hi) ^ sw) * 16));
        const bf16x8 k1 = *(const LAS3 bf16x8*)(kb + 4096 + (((2 * s + c.hi) ^ sw) * 16));
        if (s == 0) {
            const bf16x8 q = qfl[0]; p0 = __builtin_amdgcn_mfma_f32_32x32x16_bf16(k0, q, z, 0, 0, 0); p1 = __builtin_amdgcn_mfma_f32_32x32x16_bf16(k1, q, z, 0, 0, 0); }
        else { const bf16x8 q = qfl[s * 512]; p0 = __builtin_amdgcn_mfma_f32_32x32x16_bf16(k0, q, p0, 0, 0, 0); p1 = __builtin_amdgcn_mfma_f32_32x32x16_bf16(k1, q, p1, 0, 0, 0); }
    }
}
DEVI unsigned nsa_pk(float lo, float hi) { return pg8::cvt_pk_bf16(lo, hi); }
DEVI void nsa_pack(const f32x16& p0, const f32x16& p1, bf16x8 (&pa)[4]) {
#pragma unroll
    for (int s = 0; s < 4; ++s) {
        const f32x16& p = (s < 2) ? p0 : p1; const int b = (s & 1) * 8;
        uint4 w; w.x = nsa_pk(p[b], p[b + 1]); w.y = nsa_pk(p[b + 2], p[b + 3]); w.z = nsa_pk(p[b + 4], p[b + 5]); w.w = nsa_pk(p[b + 6], p[b + 7]);
        pa[s] = __builtin_bit_cast(bf16x8, w);
    }
}
DEVI void nsa_pv(const NsaCtx& c, int buf, const bf16x8 (&pa)[4], f32x16 (&o)[2]) {
    const unsigned vb = (unsigned)(uintptr_t)(c.lds + buf * 16384 + 8192 + (4 * c.hi + ((c.lane & 15) >> 2)) * 64 + ((c.lane >> 4) & 1) * 32 + (c.lane & 3) * 8);
#pragma unroll
    for (int d0 = 0; d0 < 2; ++d0) {
        s16x4 lo[4], hi[4];
#pragma unroll
        for (int s = 0; s < 4; ++s) {
            asm volatile("ds_read_b64_tr_b16 %0, %1 offset:%c2" : "=&v"(lo[s]) : "v"(vb), "i"(d0 * 4096 + s * 1024) : "memory");
            asm volatile("ds_read_b64_tr_b16 %0, %1 offset:%c2" : "=&v"(hi[s]) : "v"(vb), "i"(d0 * 4096 + s * 1024 + 512) : "memory");
        }
        asm volatile("s_waitcnt lgkmcnt(0)" ::: "memory");
        __builtin_amdgcn_sched_barrier(0);
#pragma unroll
        for (int s = 0; s < 4; ++s)
            o[d0] = __builtin_amdgcn_mfma_f32_32x32x16_bf16((bf16x8){lo[s][0], lo[s][1], lo[s][2], lo[s][3], hi[s][0], hi[s][1], hi[s][2], hi[s][3]}, pa[s], o[d0], 0, 0, 0);
    }
}
typedef float f32x2v __attribute__((ext_vector_type(2)));
DEVI void nsa_exp_all(f32x16& p0, f32x16& p1) {
#pragma unroll
    for (int r = 0; r < 16; ++r) { p0[r] = __builtin_amdgcn_exp2f(p0[r]); p1[r] = __builtin_amdgcn_exp2f(p1[r]); }
}
DEVI float nsa_rowsum(const f32x16& p0, const f32x16& p1) {
    f32x2v a = {p0[0], p0[1]}, b = {p1[0], p1[1]};
#pragma unroll
    for (int r = 2; r < 16; r += 2) { a += (f32x2v){p0[r], p0[r + 1]}; b += (f32x2v){p1[r], p1[r + 1]}; }
    a += b; return a[0] + a[1];
}
DEVI void nsa_fill(f32x16& z, float v) {
#pragma unroll
    for (int r = 0; r < 16; ++r) z[r] = v;
    asm volatile("" : "+v"(z));
}
DEVI float nsa_msel(bool dead, float e) { return __uint_as_float(__float_as_uint(e) & (dead ? 0u : 0xffffffffu)); }
DEVI void nsa_unit(bf16_t* Y, const bf16_t* KCB, const bf16_t* VCB, int b, int g, int qt, const NsaCtx& c, const float (&bnd)[3], int& slot) {
    const int w = c.w, tq = 8 * w + (c.r32 >> 2), head = c.r32 & 3, t = 64 * qt + tq;
    const size_t m = (size_t)b * SEQ + t;
    bf16_t* qrow = Y + m * LDY + OFF_Q + (g * 4 + head) * 64;
    {   LAS3 bf16x8* qfl = (LAS3 bf16x8*)(c.lds + NSA_QF) + c.tid;
#pragma unroll
        for (int s = 0; s < 4; ++s) qfl[s * 512] = *(const bf16x8*)(qrow + 16 * s + 8 * c.hi);
    }
    const bf16_t* gp = Y + m * LDY + OFF_NG + (g * 4 + head) * 3;
    const float gate_c = bf2f(gp[0]), gate_s = bf2f(gp[1]), gate_w = bf2f(gp[2]);
    LAS3 float* outl = (LAS3 float*)(c.lds + NSA_OUT) + c.tid;
    f32x16 p0, p1, o[2]; bf16x8 pa[4];

    const int nmax = (t - 31) >> 4;
    const int ntc = (((64 * qt + 32) >> 4) >> 6) + 1;
    const bf16_t* kc = KCB + (size_t)((b * 2 + g) * 256) * 64; const bf16_t* vc = VCB + (size_t)((b * 2 + g) * 256) * 64;
    auto cmp_next = [&](int ct) { return ct + 1 < ntc ? ct + 1 : -1; };
    auto cmp_src = [&](int ct, const bf16_t*& kb, const bf16_t*& vb) { kb = kc + (size_t)ct * 4096; vb = vc + (size_t)ct * 4096; };
    float lc = 0.f;
#pragma unroll
    for (int d0 = 0; d0 < 2; ++d0)
#pragma unroll
        for (int r = 0; r < 16; ++r) o[d0][r] = 0.f;
    f32x16 zb; nsa_fill(zb, -bnd[0]);
    nsa_run(c, slot, 0, c.okC, c.ovC, cmp_next, cmp_src, [&](int ct, int buf) {
        nsa_scores(c, buf, zb, p0, p1);
        nsa_exp_all(p0, p1);
        if (!__all(64 * ct + 63 <= nmax)) {
#pragma unroll
            for (int r = 0; r < 16; ++r) { const int n0 = 64 * ct + crow16(r, c.hi); p0[r] = nsa_msel(n0 > nmax, p0[r]); p1[r] = nsa_msel(n0 + 32 > nmax, p1[r]); }
        }
        lc += nsa_rowsum(p0, p1);
        nsa_pack(p0, p1, pa);
        nsa_pv(c, buf, pa, o);
    });
    lc = half_sum(lc);
    const float invc = lc > 0.f ? 1.f / lc : 0.f;
    {   const float sc_ = gate_c * invc;
#pragma unroll
        for (int d0 = 0; d0 < 2; ++d0)
#pragma unroll
            for (int r = 0; r < 16; ++r) outl[(d0 * 16 + r) * 512] = o[d0][r] * sc_;
    }
    unsigned msk0, msk1;
    if (qt < 16) { msk0 = (2u << qt) - 1u; msk1 = 0u; }
    else {
#pragma unroll
        for (int d0 = 0; d0 < 2; ++d0)
#pragma unroll
            for (int r = 0; r < 16; ++r) o[d0][r] = 0.f;
        nsa_run(c, slot, 0, c.okC, c.ovC, cmp_next, cmp_src, [&](int ct, int buf) {
            nsa_scores(c, buf, zb, p0, p1);
            nsa_exp_all(p0, p1);
            if (!__all(64 * ct + 63 <= nmax)) {
#pragma unroll
                for (int r = 0; r < 16; ++r) { const int n0 = 64 * ct + crow16(r, c.hi); p0[r] = nsa_msel(n0 > nmax, p0[r]); p1[r] = nsa_msel(n0 + 32 > nmax, p1[r]); }
            }
            nsa_pack(p0, p1, pa);
#pragma unroll
            for (int s = 0; s < 4; ++s)
#pragma unroll
                for (int jb = 0; jb < 2; ++jb) {
                    if (!(jb == (ct >> 1) || (s == 3 && (ct & 1) && jb == (ct >> 1) + 1))) continue;
                    const int j = 32 * jb + c.r32, jn0 = 16 * ct + 4 * s + c.hi, jn1 = jn0 + 2;
                    uint4 wv;
                    wv.x = (jn0 == j) ? 0x3F803F80u : 0u; wv.y = (jn0 == j) ? 0x3F003F80u : ((jn0 + 1 == j) ? 0x3F000000u : 0u);
                    wv.z = (jn1 == j) ? 0x3F803F80u : 0u; wv.w = (jn1 == j) ? 0x3F003F80u : ((jn1 + 1 == j) ? 0x3F000000u : 0u);
                    o[jb] = __builtin_amdgcn_mfma_f32_32x32x16_bf16(__builtin_bit_cast(bf16x8, wv), pa[s], o[jb], 0, 0, 0);
                }
        });
        unsigned key[2][16];
#pragma unroll
        for (int jb = 0; jb < 2; ++jb)
#pragma unroll
            for (int r = 0; r < 16; ++r) {
                float v = o[jb][r] * invc;
                v += shx(v, 1); v += shx(v, 2);
                const int j = 32 * jb + crow16(r, c.hi);
                const bool cand = (j >= 1) && (j + 2 <= qt);
                key[jb][r] = cand ? ((__float_as_uint(fmaxf(v, 0.f)) & ~63u) | (unsigned)(63 - j)) : 0u;
            }
        unsigned thr = 0u;
#pragma unroll 1
        for (int bit = 30; bit >= 0; --bit) {
            const unsigned tt = thr | (1u << bit);
            int cnt = 0;
#pragma unroll
            for (int jb = 0; jb < 2; ++jb)
#pragma unroll
                for (int r = 0; r < 16; ++r) cnt += (key[jb][r] >= tt) ? 1 : 0;
            cnt = half_addi(cnt);
            thr = (cnt >= 13) ? tt : thr;
        }
        unsigned w0 = 0u, w1 = 0u;
#pragma unroll
        for (int r = 0; r < 16; ++r) {
            const int bitpos = (r & 3) + 8 * (r >> 2);
            w0 |= ((key[0][r] != 0u && key[0][r] >= thr) ? 1u : 0u) << bitpos;
            w1 |= ((key[1][r] != 0u && key[1][r] >= thr) ? 1u : 0u) << bitpos;
        }
        w0 <<= 4 * c.hi; w1 <<= 4 * c.hi;
        msk0 = half_or(w0); msk1 = half_or(w1);
        msk0 |= 1u;
        if (qt < 32) msk0 |= (3u << (qt - 1)); else if (qt == 32) { msk0 |= 0x80000000u; msk1 |= 1u; } else msk1 |= (3u << (qt - 33));
    }
    unsigned u0 = msk0, u1 = msk1;
    u0 |= shxu(u0, 4); u1 |= shxu(u1, 4); u0 |= shxu(u0, 8); u1 |= shxu(u1, 8); u0 |= shxu(u0, 16); u1 |= shxu(u1, 16);
    LAS3 unsigned* misc = (LAS3 unsigned*)(c.lds + NSA_MISC);
    if (c.lane == 0) { misc[2 * w] = u0; misc[2 * w + 1] = u1; }
    asm volatile("s_waitcnt lgkmcnt(0)" ::: "memory"); __builtin_amdgcn_s_barrier(); asm volatile("" ::: "memory");
    u0 = 0u; u1 = 0u;
#pragma unroll
    for (int i = 0; i < 8; ++i) { u0 |= misc[2 * i]; u1 |= misc[2 * i + 1]; }
    const unsigned long long um = ((unsigned long long)(unsigned)__builtin_amdgcn_readfirstlane(u1) << 32) | (unsigned)__builtin_amdgcn_readfirstlane(u0);
    const unsigned long long mym = ((unsigned long long)msk1 << 32) | msk0;

    {
        const bf16_t* kb0 = Y + (size_t)b * SEQ * LDY + OFF_KS + g * 64; const bf16_t* vb0 = Y + (size_t)b * SEQ * LDY + OFF_VS + g * 64;
        float ls = 0.f;
#pragma unroll
        for (int d0 = 0; d0 < 2; ++d0)
#pragma unroll
            for (int r = 0; r < 16; ++r) o[d0][r] = 0.f;
        nsa_fill(zb, -bnd[1]);
        nsa_run(c, slot, 0, c.okY, c.ovY,
                [&](int j) { const unsigned long long rest = (j >= 63) ? 0ull : (um >> (j + 1)); return rest ? j + 1 + (int)__builtin_ctzll(rest) : -1; },
                [&](int j, const bf16_t*& kb, const bf16_t*& vb) { kb = kb0 + (size_t)j * 64 * LDY; vb = vb0 + (size_t)j * 64 * LDY; },
                [&](int j, int buf) {
            nsa_scores(c, buf, zb, p0, p1);
            nsa_exp_all(p0, p1);
            const bool keep = (mym >> j) & 1ull;
            if (j == qt) {
#pragma unroll
                for (int r = 0; r < 16; ++r) { const int kv = crow16(r, c.hi); p0[r] = nsa_msel(kv > tq, p0[r]); p1[r] = nsa_msel(kv + 32 > tq, p1[r]); }
            }
            ls += keep ? nsa_rowsum(p0, p1) : 0.f;
            nsa_pack(p0, p1, pa);
            {   const unsigned km = keep ? 0xffffffffu : 0u;
#pragma unroll
                for (int s = 0; s < 4; ++s) { uint4 w = __builtin_bit_cast(uint4, pa[s]); w.x &= km; w.y &= km; w.z &= km; w.w &= km; pa[s] = __builtin_bit_cast(bf16x8, w); }
            }
            nsa_pv(c, buf, pa, o);
        });
        ls = half_sum(ls);
        const float sc_ = ls > 0.f ? gate_s / ls : 0.f;
#pragma unroll
        for (int d0 = 0; d0 < 2; ++d0)
#pragma unroll
            for (int r = 0; r < 16; ++r) outl[(d0 * 16 + r) * 512] += o[d0][r] * sc_;
    }
    {
        const bf16_t* kb0 = Y + (size_t)b * SEQ * LDY + OFF_KW + g * 64; const bf16_t* vb0 = Y + (size_t)b * SEQ * LDY + OFF_VW + g * 64;
        float lw = 0.f;
#pragma unroll
        for (int d0 = 0; d0 < 2; ++d0)
#pragma unroll
            for (int r = 0; r < 16; ++r) o[d0][r] = 0.f;
        const int jlo = qt - 8 > 0 ? qt - 8 : 0;
        nsa_fill(zb, -bnd[2]);
        nsa_run(c, slot, qt, c.okY, c.ovY,
                [&](int j) { return j > jlo ? j - 1 : -1; },
                [&](int j, const bf16_t*& kb, const bf16_t*& vb) { kb = kb0 + (size_t)j * 64 * LDY; vb = vb0 + (size_t)j * 64 * LDY; },
                [&](int j, int buf) {
            nsa_scores(c, buf, zb, p0, p1);
            nsa_exp_all(p0, p1);
            if (j == qt || j == qt - 8) {
                const int hi_lim = (j == qt) ? tq : 64, lo_lim = (j == qt - 8) ? tq + 1 : 0;
#pragma unroll
                for (int r = 0; r < 16; ++r) { const int kv = crow16(r, c.hi); p0[r] = nsa_msel((kv > hi_lim) || (kv < lo_lim), p0[r]); p1[r] = nsa_msel((kv + 32 > hi_lim) || (kv + 32 < lo_lim), p1[r]); }
            }
            lw += nsa_rowsum(p0, p1);
            nsa_pack(p0, p1, pa);
            nsa_pv(c, buf, pa, o);
        });
        lw = half_sum(lw);
        const float sc_ = lw > 0.f ? gate_w / lw : 0.f;
#pragma unroll
        for (int d0 = 0; d0 < 2; ++d0)
#pragma unroll
            for (int r = 0; r < 16; ++r) o[d0][r] = outl[(d0 * 16 + r) * 512] + o[d0][r] * sc_;
    }
#pragma unroll
    for (int d0 = 0; d0 < 2; ++d0)
#pragma unroll
        for (int gi = 0; gi < 4; ++gi) {
            uint2 wv; wv.x = pk2(o[d0][4 * gi], o[d0][4 * gi + 1]); wv.y = pk2(o[d0][4 * gi + 2], o[d0][4 * gi + 3]);
            *(uint2*)(qrow + (OFF_RX - OFF_Q) + 32 * d0 + 8 * gi + 4 * c.hi) = wv;
        }
}

DEVI void phase_nsa_fast(bf16_t* Y, const bf16_t* KCB, const bf16_t* VCB, const float* qn  , const float* kn  , LAS3 unsigned char* lds) {
    float bnd[3];
    {   const int l0 = TIDX & 63;
        const float gq = wave_max(fabsf(qn[l0]));
#pragma unroll
        for (int i = 0; i < 3; ++i) bnd[i] = __uint_as_float(__builtin_amdgcn_readfirstlane(__float_as_uint(64.f * 1.02f * 0.125f * 1.4426950408889634f * gq * wave_max(fabsf(kn[i * 64 + l0])))));
    }
    NsaCtx c; c.lds = lds; c.tid = TIDX; c.lane = c.tid & 63; c.r32 = c.lane & 31; c.hi = c.lane >> 5; c.w = __builtin_amdgcn_readfirstlane(c.tid >> 6);
    {   const int l = c.lane, w = c.w;
        const int rk = 8 * w + (l >> 3), ck = (l & 7) ^ ((rk >> 1) & 7);
        const int rv = 16 * (w & 3) + (l >> 2), cv = (w >> 2) * 4 + (l & 3);
        c.okY = (unsigned)(rk * LDY + ck * 8) * 2u; c.ovY = (unsigned)(rv * LDY + cv * 8) * 2u;
        c.okC = (unsigned)(rk * 64 + ck * 8) * 2u;  c.ovC = (unsigned)(rv * 64 + cv * 8) * 2u;
    }
    const int bid = BIDX;
    int slot = 0;
    for (int u0 = bid; u0 < 256; u0 += gridDim.x) {
        const int u = (gridDim.x == 256) ? ((u0 & 7) * 32 + (u0 >> 3)) : u0;
        const int bg = u >> 5, k = u & 31;
#pragma unroll 1
        for (int h2 = 0; h2 < 2; ++h2) nsa_unit(Y, KCB, VCB, bg >> 1, bg & 1, h2 ? k : 63 - k, c, bnd, slot);
    }
    asm volatile("s_waitcnt vmcnt(0) lgkmcnt(0)" ::: "memory"); __builtin_amdgcn_s_barrier();
}

#define XB_TMO      128
#define XB_XCNT(j)  (256  + 64 * (j))
#define XB_XSUB(j)  (1280 + 64 * (j))
#define XB_XGEN(j)  (2304 + 64 * (j))
#define XB_TOP      3328
#define XB_TOPGEN   3392
#define XCD_BAR_WORDS 3456
#define XB_SPIN_CAP (1u << 18)
DEVI unsigned xb_ld(unsigned* p)              { return __hip_atomic_load(p, __ATOMIC_RELAXED, __HIP_MEMORY_SCOPE_AGENT); }
DEVI unsigned xb_add(unsigned* p, unsigned v) { return __hip_atomic_fetch_add(p, v, __ATOMIC_RELAXED, __HIP_MEMORY_SCOPE_AGENT); }
DEVI unsigned xb_xcc_id() { return (unsigned)__builtin_amdgcn_s_getreg((3 << 11) | 20) & 0xFu; }
#define XB_SPIN(cond, bar) do { unsigned _sp = 0; while (cond) { __builtin_amdgcn_s_sleep(1); \
    if ((++_sp & 255u) == 0u) { if (xb_ld(&(bar)[XB_TMO])) break; if (_sp > XB_SPIN_CAP) { atomicAdd(&(bar)[XB_TMO], 1u); break; } } } } while (0)
struct XcdBarrier { unsigned* bar; unsigned x; volatile LAS3 unsigned* st; };
DEVI XcdBarrier xcd_barrier_post(unsigned* bar, volatile LAS3 unsigned* st) {
    XcdBarrier b; b.bar = bar; b.x = xb_xcc_id(); b.st = st;
    if (threadIdx.x == 0) (void)xb_add(&bar[XB_XCNT(b.x)], 1u);
    return b;
}
DEVI void xcd_barrier_complete(unsigned* bar, unsigned x, unsigned& nloc, unsigned& nx) {
    const unsigned G = gridDim.x * gridDim.y * gridDim.z;
    unsigned sum, cnt, mine, sp = 0u;
    for (;;) {
        sum = 0u; cnt = 0u; mine = 0u;
#pragma unroll
        for (unsigned j = 0; j < 16; ++j) { const unsigned c = xb_ld(&bar[XB_XCNT(j)]); sum += c; cnt += (c > 0u) ? 1u : 0u; mine = (j == x) ? c : mine; }
        if (sum == G) break;
        __builtin_amdgcn_s_sleep(1);
        if ((++sp & 255u) == 0u) { if (xb_ld(&bar[XB_TMO])) break; if (sp > XB_SPIN_CAP) { atomicAdd(&bar[XB_TMO], 1u); break; } }
    }
    nloc = mine > 0u ? mine : 1u; nx = cnt > 0u ? cnt : 1u;
}
DEVI void xcd_barrier(const XcdBarrier& b) {
    asm volatile("s_waitcnt vmcnt(0)" ::: "memory");
    __syncthreads();
    if (threadIdx.x == 0) {
        unsigned* bar = b.bar;
        __builtin_amdgcn_s_waitcnt(0);
        unsigned nloc = b.st[0], nx = b.st[1];
        if (nloc == 0u) { xcd_barrier_complete(bar, b.x, nloc, nx); b.st[0] = nloc; b.st[1] = nx; }
        const unsigned old = xb_add(&bar[XB_XSUB(b.x)], 1u);
        const unsigned gen = old / nloc;
        if (old + 1u == (gen + 1u) * nloc) {
            __builtin_amdgcn_fence(__ATOMIC_RELEASE, "agent");
            asm volatile("s_waitcnt vmcnt(0)" ::: "memory");
            const unsigned og = xb_add(&bar[XB_TOP], 1u);
            const unsigned tg = og / nx;
            if (og + 1u == (tg + 1u) * nx) xb_add(&bar[XB_TOPGEN], 1u);
            else XB_SPIN(xb_ld(&bar[XB_TOPGEN]) == tg, bar);
            __builtin_amdgcn_fence(__ATOMIC_ACQUIRE, "agent");
            xb_add(&bar[XB_XGEN(b.x)], 1u);
            asm volatile("s_waitcnt vmcnt(0)" ::: "memory");
        } else {
            XB_SPIN(xb_ld(&bar[XB_XGEN(b.x)]) == gen, bar);
            __builtin_amdgcn_fence(__ATOMIC_ACQUIRE, "agent");
            asm volatile("s_waitcnt vmcnt(0)" ::: "memory");
        }
    }
    __syncthreads();
}

constexpr int LDS_BYTES = 160 * 1024;
constexpr int LDS_PTRS = 151552;
DEVI const void* lds_ptr(const LAS3 unsigned char* lds, int i) {
    const unsigned long long v = ((const LAS3 unsigned long long*)(lds + LDS_PTRS))[i];
    const unsigned lo = __builtin_amdgcn_readfirstlane((unsigned)v), hi = __builtin_amdgcn_readfirstlane((unsigned)(v >> 32));
    return (const void*)(((unsigned long long)hi << 32) | lo);
}
#ifndef PHMASK
#define PHMASK 0xffffffffu
#endif
__global__ void __launch_bounds__(512, 2) fwd_kernel(Params p) {
    extern __shared__ __attribute__((aligned(16))) unsigned char lds[];
    cg::grid_group grid = cg::this_grid();
    unsigned char* ws = p.ws;
    int* CNT = (int*)(ws + WS_CNT);
    float* RSTD = (float*)(ws + WS_RSTD); float* SS = (float*)(ws + WS_SS); float* LOG = (float*)(ws + WS_LOG); bf16_t* WRT = (bf16_t*)(ws + WS_WRT); bf16_t* W1T = (bf16_t*)(ws + WS_W1T); bf16_t* W2T = (bf16_t*)(ws + WS_W2T); float* BPE = (float*)(ws + WS_BPE);
    float* PA = (float*)(ws + WS_PA); float* PH = (float*)(ws + WS_PH);
    float* KCMP = (float*)(ws + WS_KCMP); float* VCMP = (float*)(ws + WS_VCMP); float* HID = (float*)(ws + WS_HID);
    float* RW = (float*)(ws + WS_RW); int* LIST = (int*)(ws + WS_LIST);
    bf16_t* KCB = (bf16_t*)(ws + WS_KCB); bf16_t* VCB = (bf16_t*)(ws + WS_VCB);
    bf16_t* WIN = (bf16_t*)(ws + WS_WIN); bf16_t* WBR = (bf16_t*)(ws + WS_WBR); bf16_t* WO = (bf16_t*)(ws + WS_WO);
    bf16_t* Y = (bf16_t*)(ws + WS_Y); float* LA = (float*)p.out; bf16_t* VV = (bf16_t*)((unsigned char*)p.out + 32 * MiB);
    bf16_t* XB = (bf16_t*)(ws + WS_XB);
    bf16_t* WGU = (bf16_t*)(ws + WS_WGU); bf16_t* WD = (bf16_t*)(ws + WS_WD); bf16_t* XG = (bf16_t*)(ws + WS_XG); bf16_t* HM = (bf16_t*)(ws + WS_HM);
    int* TOKS = (int*)(ws + WS_TOKS); float* RWS = (float*)(ws + WS_RWS); bf16_t* YS = (bf16_t*)(ws + WS_YS);
    bf16_t* As = (bf16_t*)lds; bf16_t* Bs = As + 128 * GLD;
    float* ldsf = (float*)lds;
    int* tb = (int*)(lds + 131072);
    LAS3 unsigned char* lds3 = (LAS3 unsigned char*)lds;
    const int G = gridDim.x;
    {   LAS3 unsigned long long* ptab = (LAS3 unsigned long long*)(lds3 + LDS_PTRS);
        if (threadIdx.x == 0) {
#pragma unroll
            for (int i = 0; i < 30; ++i) ptab[i] = (unsigned long long)p.in[i];
            ptab[30] = (unsigned long long)p.out;
        }
        if (threadIdx.x == 0) { ((volatile LAS3 unsigned*)(lds3 + LDS_PTRS + 256))[0] = 0u; ((volatile LAS3 unsigned*)(lds3 + LDS_PTRS + 256))[1] = 0u; }
        __syncthreads();
    }
    const XcdBarrier xbar = xcd_barrier_post((unsigned*)(ws + WS_BAR), (volatile LAS3 unsigned*)(lds3 + LDS_PTRS + 256));
#define INP(i) ((const float*)lds_ptr(lds3, (i)))
#define OUTP ((float*)lds_ptr(lds3, 30))

    if (PHMASK & (1u << 0)) phase_prep(p, WIN, WBR, WO, WRT, W1T, W2T, BPE, ldsf);

    for (int l = 0; l < DEPTH; ++l) {
        if (l == 0) { if (PHMASK & (1u << 1)) phase_xb(INP(0), RSTD, XB); }
        if (l == 0) grid.sync();
        if (PHMASK & (1u << 2)) { pg8::Gemm g{XB, WIN + (size_t)l * LDY * DM, DM, DM, DM}; pg8::StaticOrder S; S.init(MTOK, LDY, G, BIDX); EpiInproj E{Y, RSTD, INP(15) + l * 64, INP(16) + l * 192};
          pg8::gemm_phase<EpiInproj, pg8::StaticOrder>(lds3, g, S, E);
        }
        xcd_barrier(xbar);
        {
            const int bid_ = BIDX;
            if (bid_ < 16) {
                pg8::Gemm g{Y, W1T + (size_t)l * 256 * 2048, 2048, 16 * LDY, 2048, LDY * 2, 128}; CmpOrder S{G, bid_}; EpiCmp1 E{(bf16_t*)HID, BPE + l * 256};
                pg8::gemm_phase<EpiCmp1, CmpOrder>(lds3, g, S, E);
                asm volatile("s_waitcnt vmcnt(0)" ::: "memory"); __syncthreads();
                cmp2_unit((const bf16_t*)HID, W2T + (size_t)l * 2 * 64 * 128, INP(14) + l * 128, INP(16) + l * 192, KCB, VCB, bid_ >> 3, (bid_ >> 2) & 1, bid_ & 3);
            } else {
                phase_rglru1(Y, INP(3) + l * 2048, INP(4) + l * 512, INP(5) + l * 32768, INP(6) + l * 512, INP(7) + l * 32768, INP(8) + l * 512, INP(9) + l * 512,
                             LA, VV, PA, PH, ldsf, bid_ - 16, G - 16);
                phase_shortconv(Y, INP(17) + l * 1536, bid_ - 16, G - 16);
            }
        }
        xcd_barrier(xbar);
        if (PHMASK & (1u << 8)) phase_rglru2(Y, LA, VV, PA, PH);
#if NSA_FAST
        if (PHMASK & (1u << 9)) phase_nsa_fast(Y, KCB, VCB, INP(15) + l * 64, INP(16) + l * 192, lds3);
#else
        if (PHMASK & (1u << 9)) phase_nsa(Y, KCMP, VCMP, ldsf);
#endif
        xcd_barrier(xbar);
        if (PHMASK & (1u << 10)) {
            pg8::Gemm g{Y, WBR + (size_t)l * 3 * DM * 512, 512, LDY, 512}; MergeOrder S; S.so.init(MTOK, DM, G, BIDX); EpiMerge E{Y};
            pg8::gemm_phase<EpiMerge, MergeOrder>(lds3, g, S, E);
        }
        xcd_barrier(xbar);
        if (PHMASK & (1u << 11)) { pg8::Gemm g{Y + OFF_SC, WO + (size_t)l * DM * DM, DM, LDY, DM}; pg8::StaticOrder S; S.init(MTOK, DM, G, BIDX); EpiOut E{XB, SS + (size_t)l * MTOK * 16};
          pg8::gemm_phase<EpiOut, pg8::StaticOrder>(lds3, g, S, E); }
        xcd_barrier(xbar);
        if (PHMASK & (1u << 12)) {
            pg8::Gemm g{XB, WRT + (size_t)l * 256 * DM, DM, DM, DM}; pg8::StaticOrder S; S.init(MTOK, 256, G, BIDX); EpiRouter E{LOG, SS + (size_t)l * MTOK * 16};
            pg8::gemm_phase<EpiRouter, pg8::StaticOrder>(lds3, g, S, E);
            pg8::Unit u;
            if (S.next(0, u)) {
                asm volatile("s_waitcnt vmcnt(0)" ::: "memory"); __syncthreads();
                const int t_ = TIDX;
                if (t_ < 256) router_finalize(u.pm * 256 + t_, LOG, INP(24) + l * 4, INP(26) + l * 32, CNT + l * 32, LIST, RW);
            }
        }
        if (PHMASK & (1u << 13)) phase_moe_prep(INP(27) + (size_t)l * NEXP * DM * 256, INP(28) + (size_t)l * NEXP * DM * 256, INP(29) + (size_t)l * NEXP * 256 * DM, INP(22) + l * DM, WGU, WD, ldsf);
        xcd_barrier(xbar);
        if (PHMASK & (1u << 15)) {
            int* tokl = (int*)(lds + LDS_ROWT); float* wl = (float*)(lds + LDS_ROWT + 2048); float* rsl = (float*)(lds + LDS_ROWT + 4096);
            const int bid_ = BIDX;
            moe_up_setup(CNT + l * 32, LIST, RW, SS + (size_t)l * MTOK * 16, TOKS, tb, tokl, wl, rsl, bid_, G);
            pg8::Gemm g{XB, WGU, DM, DM, DM}; MoeUpOrder S{tb, G, bid_, tokl}; EpiMoeUp E{HM, wl, rsl};
            pg8::gemm_phase<EpiMoeUp, MoeUpOrder, true>(lds3, g, S, E);
        }
        xcd_barrier(xbar);
        if (PHMASK & (1u << 16)) { pg8::Gemm g{HM, WD, 256, 256, 256}; MoeOrder S{tb, 4, G, BIDX}; EpiMoeDown E{YS, TOKS};
          pg8::gemm_phase<EpiMoeDown, MoeOrder>(lds3, g, S, E); }
        xcd_barrier(xbar);
        if (PHMASK & (1u << 17)) phase_combine(XB, YS, RSTD, OUTP, l + 1 < DEPTH);
        if (l + 1 < DEPTH) xcd_barrier(xbar);
    }
}

extern "C" void kernel_launch(void* const* d_in, const int* in_sizes, int n_in, void* d_out, int out_size, void* d_ws, size_t ws_size, hipStream_t stream) {
    static int grid = 0;
    if (grid == 0) {
        if (n_in != 30 || out_size != MTOK * DM || ws_size < WS_TOTAL) { fprintf(stderr, "kernel_launch: unexpected sizes n_in=%d out=%d ws=%zu\n", n_in, out_size, ws_size); grid = -1; return; }
        int dev = 0, cus = 0, per_cu = 0;
        hipGetDevice(&dev);
        hipDeviceGetAttribute(&cus, hipDeviceAttributeMultiprocessorCount, dev);
        hipFuncSetAttribute((const void*)fwd_kernel, hipFuncAttributeMaxDynamicSharedMemorySize, LDS_BYTES);
        hipOccupancyMaxActiveBlocksPerMultiprocessor(&per_cu, (const void*)fwd_kernel, 512, LDS_BYTES);
        (void)hipGetLastError();
        if (per_cu < 1) { fprintf(stderr, "kernel_launch: occupancy query says %d blocks/CU\n", per_cu); grid = -1; return; }
        grid = cus;
    }
    if (grid < 0) return;
    hipMemsetAsync(d_ws, 0, WS_ZERO_BYTES, stream);
    Params p{};
    for (int i = 0; i < 30; ++i) p.in[i] = (const float*)d_in[i];
    p.out = (float*)d_out; p.ws = (unsigned char*)d_ws;
    void* args[] = {&p};
    hipError_t e = hipLaunchCooperativeKernel((const void*)fwd_kernel, dim3(grid), dim3(512), args, LDS_BYTES, stream);
    if (e != hipSuccess) fprintf(stderr, "cooperative launch failed: %s (grid %d)\n", hipGetErrorString(e), grid);
}
```

```cpp
#include <hip/hip_runtime.h>
#include <hip/hip_cooperative_groups.h>
#include <cstdio>
#include <cstdint>
namespace cg = cooperative_groups;

typedef unsigned short bf16_t;
typedef short bf16x8 __attribute__((ext_vector_type(8)));
typedef float f32x4 __attribute__((ext_vector_type(4)));
#define DEVI __device__ __forceinline__

constexpr int DM = 1024, NB = 4, SEQ = 4096, MTOK = NB * SEQ, DEPTH = 2;
constexpr int INW = 6936;
constexpr int LDY = 7168;
constexpr int OFF_RX = 0, OFF_RY = 512, OFF_Q = 1024, OFF_KC = 1536, OFF_VC = 1664, OFF_KS = 1792, OFF_VS = 1920,
              OFF_KW = 2048, OFF_VW = 2176, OFF_SB = 2304, OFF_SC = 2816, OFF_SH = 3328, OFF_MG = 3840, OFF_NG = 6912, OFF_END = 6936;
constexpr int NCMP = 255;
constexpr float RMS_EPS = 1e-6f;
constexpr int NEXP = 32;

constexpr size_t KiB = 1024, MiB = 1024 * 1024;
constexpr size_t WS_CNT = 0;
constexpr size_t WS_BAR = 16 * KiB;
constexpr size_t WS_ZERO_BYTES = 32 * KiB;
constexpr size_t WS_SS = 13 * MiB;
constexpr size_t WS_RSTD = 192 * KiB;
constexpr size_t WS_PA = 512 * KiB;
constexpr size_t WS_PH = 1024 * KiB;
constexpr size_t WS_KCMP = 2 * MiB;
constexpr size_t WS_VCMP = 2 * MiB + 512 * KiB;
constexpr size_t WS_HID = 3 * MiB;
constexpr size_t WS_RW = 5 * MiB;
constexpr size_t WS_LIST = 6 * MiB;
constexpr size_t WS_KCB = 8 * MiB;
constexpr size_t WS_VCB = 8 * MiB + 256 * KiB;
constexpr size_t WS_LOG = 9 * MiB;
constexpr size_t WS_WIN = 16 * MiB;
constexpr size_t WS_WBR = 44 * MiB;
constexpr size_t WS_WO = 50 * MiB;
constexpr size_t WS_W1T = 54 * MiB;
constexpr size_t WS_W2T = 320 * KiB;
constexpr size_t WS_BPE = 256 * KiB;
constexpr size_t WS_WRT = 15 * MiB;
constexpr size_t WS_Y = 56 * MiB;
constexpr size_t WS_LA = 280 * MiB;
constexpr size_t WS_VV = 312 * MiB;
constexpr size_t WS_XB = 280 * MiB;
constexpr size_t WS_WGU = WS_Y;
constexpr size_t WS_WD = WS_Y + 32 * MiB;
constexpr size_t WS_XG = WS_Y + 48 * MiB;
constexpr size_t WS_HM = WS_Y + 128 * MiB;
constexpr size_t WS_TOKS = WS_Y + 148 * MiB;
constexpr size_t WS_RWS = WS_Y + 148 * MiB + 256 * KiB;
constexpr size_t WS_YS = WS_Y + 152 * MiB;
constexpr size_t WS_TOTAL = 328 * MiB;
constexpr int MOE_ROWS = 40960;

struct Params {
    const float* in[30];
    float* out;
    unsigned char* ws;
};

DEVI float bf2f(bf16_t v) { return __uint_as_float(((unsigned)v) << 16); }
DEVI bf16_t f2bf(float f) { unsigned u = __float_as_uint(f); return (bf16_t)((u + 0x7fffu + ((u >> 16) & 1u)) >> 16); }
DEVI unsigned pk2(float lo, float hi) { return (unsigned)f2bf(lo) | ((unsigned)f2bf(hi) << 16); }
DEVI int launder_v0(int v) { asm volatile("" : "+v"(v)); return v; }
DEVI float shx(float v, int o) { const int lane = launder_v0((int)threadIdx.x) & 63; return __int_as_float(__builtin_amdgcn_ds_bpermute((lane ^ o) << 2, __float_as_int(v))); }
DEVI unsigned shxu(unsigned v, int o) { const int lane = launder_v0((int)threadIdx.x) & 63; return (unsigned)__builtin_amdgcn_ds_bpermute((lane ^ o) << 2, (int)v); }
DEVI float wave_sum(float v) {
#pragma unroll
    for (int o = 1; o < 64; o <<= 1) v += shx(v, o);
    return v;
}
DEVI float wave_max(float v) {
#pragma unroll
    for (int o = 1; o < 64; o <<= 1) v = fmaxf(v, shx(v, o));
    return v;
}
DEVI float sigmoidf_(float x) { return __builtin_amdgcn_rcpf(1.f + __builtin_amdgcn_exp2f(-1.4426950408889634f * x)); }
DEVI float gelu_tanh(float x) { const float u = 0.7978845608028654f * (x + 0.044715f * x * x * x); return x * __builtin_amdgcn_rcpf(1.f + __builtin_amdgcn_exp2f(-2.8853900817779268f * u)); }
DEVI int launder_v(int v) { asm volatile("" : "+v"(v)); return v; }
DEVI int launder_s(int v) { asm volatile("" : "+s"(v)); return v; }
#define TIDX launder_v((int)threadIdx.x)
#define BIDX launder_s((int)blockIdx.x)
DEVI f32x4 zero4() { float z = 0.f; asm volatile("" : "+v"(z)); return (f32x4){z, z, z, z}; }
#define LDS_FENCE() asm volatile("s_waitcnt lgkmcnt(0)" ::: "memory")

constexpr int GLD = 40;
template <class LA, class LB>
DEVI void gemm_tile(const int tid, f32x4 (&acc)[2][4], int K, bf16_t* As, bf16_t* Bs, LA la, LB lb) {
    const int lane = tid & 63, wave = tid >> 6, wm = wave >> 1, wn = wave & 1;
    const int ar = tid >> 2, ak = (tid & 3) * 8;
    const int bk = tid >> 4, bn = (tid & 15) * 8;
    for (int k0 = 0; k0 < K; k0 += 32) {
        float av[8], bv[8];
        la(k0 + ak, av);
        lb(k0 + bk, bv);
        __syncthreads();
        uint4 pa; pa.x = pk2(av[0], av[1]); pa.y = pk2(av[2], av[3]); pa.z = pk2(av[4], av[5]); pa.w = pk2(av[6], av[7]);
        *(uint4*)(As + ar * GLD + ak) = pa;
#pragma unroll
        for (int j = 0; j < 8; ++j) Bs[(bn + j) * GLD + bk] = f2bf(bv[j]);
        __syncthreads();
        bf16x8 af[2], bfr[4];
#pragma unroll
        for (int i = 0; i < 2; ++i) af[i] = *(const bf16x8*)(As + (wm * 32 + i * 16 + (lane & 15)) * GLD + (lane >> 4) * 8);
#pragma unroll
        for (int j = 0; j < 4; ++j) bfr[j] = *(const bf16x8*)(Bs + (wn * 64 + j * 16 + (lane & 15)) * GLD + (lane >> 4) * 8);
#pragma unroll
        for (int i = 0; i < 2; ++i)
#pragma unroll
            for (int j = 0; j < 4; ++j) acc[i][j] = __builtin_amdgcn_mfma_f32_16x16x32_bf16(bfr[j], af[i], acc[i][j], 0, 0, 0);
    }
    __syncthreads();
}
DEVI void acc_zero(f32x4 (&acc)[2][4]) {
#pragma unroll
    for (int i = 0; i < 2; ++i)
#pragma unroll
        for (int j = 0; j < 4; ++j) acc[i][j] = zero4();
}
#define ACC_ROW(i) (((tid >> 7) * 32) + (i) * 16 + (tid & 15))
#define ACC_COL(j) ((((tid >> 6) & 1) * 64) + (j) * 16 + (((tid & 63) >> 4) * 4))

DEVI void load8f(const float* p, float (&v)[8]) {
    const f32x4 a = *(const f32x4*)p, b = *(const f32x4*)(p + 4);
    v[0] = a[0]; v[1] = a[1]; v[2] = a[2]; v[3] = a[3]; v[4] = b[0]; v[5] = b[1]; v[6] = b[2]; v[7] = b[3];
}
DEVI void load8b(const bf16_t* p, float (&v)[8]) {
    const uint4 a = *(const uint4*)p;
    v[0] = __uint_as_float(a.x << 16); v[1] = __uint_as_float(a.x & 0xffff0000u);
    v[2] = __uint_as_float(a.y << 16); v[3] = __uint_as_float(a.y & 0xffff0000u);
    v[4] = __uint_as_float(a.z << 16); v[5] = __uint_as_float(a.z & 0xffff0000u);
    v[6] = __uint_as_float(a.w << 16); v[7] = __uint_as_float(a.w & 0xffff0000u);
}
DEVI void unpack8(const uint4 a, float (&v)[8]) {
    v[0] = __uint_as_float(a.x << 16); v[1] = __uint_as_float(a.x & 0xffff0000u);
    v[2] = __uint_as_float(a.y << 16); v[3] = __uint_as_float(a.y & 0xffff0000u);
    v[4] = __uint_as_float(a.z << 16); v[5] = __uint_as_float(a.z & 0xffff0000u);
    v[6] = __uint_as_float(a.w << 16); v[7] = __uint_as_float(a.w & 0xffff0000u);
}
DEVI void zero8(float (&v)[8]) {
#pragma unroll
    for (int j = 0; j < 8; ++j) v[j] = 0.f;
}

#define LAS3 __attribute__((address_space(3)))
DEVI int orig_col(int c) { return c < 2304 ? c : (c < OFF_NG ? c + 24 : (c < OFF_END ? c - 4608 : -1)); }
DEVI bool head_tile(int pn) { return pn == 4 || pn == 5 || pn == 7 || pn == 8; }
DEVI int phys2logical(int c) {
    const int pn = c >> 8;
    if (!head_tile(pn)) return c;
    const int p = c & 255, bj = p >> 7, wc = (p >> 5) & 3, i = p & 31;
    return (pn << 8) + wc * 64 + bj * 32 + i;
}
namespace pg8 {
#define PG8_LAS __attribute__((address_space(3)))
typedef unsigned u32x4 __attribute__((ext_vector_type(4)));
constexpr int BM = 256, BK = 64, HALF = 128, HTB = HALF * BK * 2, STAGE_BYTES = 8 * HTB, NXCD = 8, WGM = 8;
DEVI int lds_byte(int r, int c) { const int st = (r >> 4) * 2 + (c >> 5), rr = r & 15, cc = c & 31, ob = rr * 64 + cc * 2; return st * 1024 + (ob ^ (((ob >> 9) & 1) << 5)); }
DEVI void stage_rc(int b, int& R, int& C) { const int st = b / 1024, sb = b % 1024, swz = sb ^ (((sb >> 9) & 1) << 5); R = (st >> 1) * 16 + swz / 64; C = (st & 1) * 32 + (swz % 64) / 2; }
DEVI int perm32(int rho) { const int n = rho >> 4, i = rho & 15; return 8 * (i >> 2) + 4 * n + (i & 3); }
struct Unit { int pm, pn, ao = 0, aux = 0; };
struct Gemm { const bf16_t* A; const bf16_t* Bt; int K, lda, ldb; int kstepA = BK * 2, kstepB = BK * 2; };
struct StaticOrder {
    int nM, nN, nwg, G, c;
    DEVI void init(int M, int N, int G_, int c_) { nM = M / BM; nN = N / BM; nwg = nM * nN; G = G_; c = c_; }
    DEVI bool next(int i, Unit& u) const {
        const long L = (long)i * G + c; if (L >= nwg) return false;
        int wgid = (int)L; { const int q = nwg / NXCD, r = nwg % NXCD, xcd = wgid % NXCD, off = wgid / NXCD; wgid = (xcd < r ? xcd * (q + 1) : r * (q + 1) + (xcd - r) * q) + off; }
        const int nig = WGM * nN, gid = wgid / nig, fm = gid * WGM, gsz = (nM - fm) < WGM ? (nM - fm) : WGM;
        u.pm = fm + ((wgid % nig) % gsz); u.pn = (wgid % nig) / gsz; return true;
    }
};
DEVI unsigned cvt_pk_bf16(float lo, float hi) { unsigned r; asm volatile("v_cvt_pk_bf16_f32 %0, %1, %2" : "=v"(r) : "v"(lo), "v"(hi)); return r; }

template <class Epi, class Sched, bool GATHER = false, bool ALIGN_EPI = true, bool SP2 = true>
DEVI void gemm_phase(PG8_LAS unsigned char* lds, const Gemm g, const Sched& S, const Epi& E) {
    const int tid = TIDX; const int wid = __builtin_amdgcn_readfirstlane(tid >> 6), lane = tid & 63, wr = wid >> 2, wc = wid & 3, fr = lane & 15, fq = lane >> 4;
    const int K = launder_s(g.K), nt = K / BK;
    unsigned voffA[2][2], voffAn[2][2], voffB[2];
    const size_t kstepA = (size_t)g.kstepA, kstepB = (size_t)g.kstepB;
    const size_t hstepA = (size_t)HALF * g.lda * 2, hstepB = (size_t)HALF * g.ldb * 2;
    const size_t tstepA = 2 * hstepA, tstepB = 2 * hstepB;
#pragma unroll
    for (int i = 0; i < 2; ++i) { int R, C; stage_rc(tid * 16 + i * 8192, R, C); const int Rb = Epi::PERM ? ((R & ~31) + perm32(R & 31)) : R;
        voffB[i] = (unsigned)(Rb * g.ldb + C) * 2u;
        if constexpr (GATHER) {
#pragma unroll
            for (int h = 0; h < 2; ++h) { voffA[h][i] = (unsigned)(S.a_row(0, h * HALF + R) * g.lda + C) * 2u; voffAn[h][i] = (unsigned)(S.a_row(1, h * HALF + R) * g.lda + C) * 2u; }
        } else {
#pragma unroll
            for (int h = 0; h < 2; ++h) { voffA[h][i] = (unsigned)(R * g.lda + C) * 2u + (unsigned)(h * hstepA); voffAn[h][i] = voffA[h][i]; }
        } }
    const unsigned ldsw = (unsigned)wid * 1024u;
    const int aoff = lds_byte(wr * 64 + fr, fq * 8), boff = lds_byte(wc * 32 + fr, fq * 8);
#define PG8_SA(b, h) (((b) * 2 + (h)) * HTB)
#define PG8_SB(b, h) ((4 + (b) * 2 + (h)) * HTB)
#define PG8_STAGE(bufoff, gbase, voff) do { _Pragma("unroll") for (int _i = 0; _i < 2; ++_i) \
        __builtin_amdgcn_global_load_lds((const unsigned*)((const char*)(gbase) + (voff)[_i]), (PG8_LAS unsigned*)(lds + (bufoff) + ldsw + _i * 8192), 16, 0, 0); } while (0)
#define PG8_LDA(dst, b, h) do { _Pragma("unroll") for (int m = 0; m < 4; ++m) _Pragma("unroll") for (int k = 0; k < 2; ++k) dst[m][k] = *(const PG8_LAS bf16x8*)(lds + PG8_SA(b, h) + aoff + m * 2048 + k * 1024); } while (0)
#define PG8_LDB(dst, b, h) do { _Pragma("unroll") for (int n = 0; n < 2; ++n) _Pragma("unroll") for (int k = 0; k < 2; ++k) dst[n][k] = *(const PG8_LAS bf16x8*)(lds + PG8_SB(b, h) + boff + n * 2048 + k * 1024); } while (0)
#define PG8_MMA(ai, bj, At, Bt) do { __builtin_amdgcn_s_setprio(1); _Pragma("unroll") for (int m = 0; m < 4; ++m) _Pragma("unroll") for (int n = 0; n < 2; ++n) _Pragma("unroll") for (int k = 0; k < 2; ++k) \
        acc[ai][bj][m][n] = __builtin_amdgcn_mfma_f32_16x16x32_bf16(Bt[n][k], At[m][k], acc[ai][bj][m][n], 0, 0, 0); __builtin_amdgcn_s_setprio(0); } while (0)
#define PG8_WAIT_V(n) asm volatile("s_waitcnt vmcnt(" #n ")" ::: "memory")
#define PG8_WAIT_L(n) asm volatile("s_waitcnt lgkmcnt(" #n ")" ::: "memory")
#define PG8_BAR __builtin_amdgcn_s_barrier()
#define PG8_SCHED __builtin_amdgcn_sched_barrier(0)
    Unit cur, nxt; int ui = 0;
    if (!S.next(0, cur)) return;
    f32x4 acc[2][2][4][2];
#pragma unroll
    for (int a = 0; a < 2; ++a)
#pragma unroll
        for (int b = 0; b < 2; ++b)
#pragma unroll
            for (int m = 0; m < 4; ++m)
#pragma unroll
                for (int n = 0; n < 2; ++n) acc[a][b][m][n] = zero4();
    bf16x8 At[4][2], B0[2][2], B1[2][2];
    const char* cA = GATHER ? (const char*)g.A : (const char*)g.A + (size_t)cur.pm * tstepA + (size_t)cur.ao * 2; const char* cB = (const char*)g.Bt + (size_t)cur.pn * tstepB;
    if constexpr (SP2) {
        PG8_STAGE(PG8_SB(0, 0), cB, voffB); PG8_STAGE(PG8_SB(0, 1), cB + hstepB, voffB); PG8_STAGE(PG8_SA(0, 0), cA, voffA[0]); PG8_STAGE(PG8_SA(0, 1), cA, voffA[1]);
        if (wr == 1) PG8_BAR;
        PG8_WAIT_V(2); PG8_BAR;
        PG8_STAGE(PG8_SB(1, 0), cB + kstepB, voffB); PG8_STAGE(PG8_SA(1, 0), cA + kstepA, voffA[0]); PG8_STAGE(PG8_SB(1, 1), cB + hstepB + kstepB, voffB);
        PG8_WAIT_V(6); PG8_BAR;
    } else {
        PG8_STAGE(PG8_SB(0, 0), cB, voffB); PG8_STAGE(PG8_SA(0, 0), cA, voffA[0]); PG8_STAGE(PG8_SB(0, 1), cB + hstepB, voffB); PG8_STAGE(PG8_SA(0, 1), cA, voffA[1]);
        if (wr == 1) PG8_BAR;
        PG8_WAIT_V(4); PG8_BAR;
        PG8_STAGE(PG8_SB(1, 0), cB + kstepB, voffB); PG8_STAGE(PG8_SA(1, 0), cA + kstepA, voffA[0]); PG8_STAGE(PG8_SB(1, 1), cB + hstepB + kstepB, voffB);
        PG8_WAIT_V(6); PG8_BAR;
    }
    for (;;) {
        const bool has_next = S.next(ui + 1, nxt);
        const char* nA = GATHER ? (const char*)g.A : (has_next ? (const char*)g.A + (size_t)nxt.pm * tstepA + (size_t)nxt.ao * 2 : cA); const char* nB = has_next ? (const char*)g.Bt + (size_t)nxt.pn * tstepB : cB;
        for (int t = 0; t < nt; t += 2) {
            const bool last = (t == nt - 2);
            const char* a1 = cA + (size_t)(t + 1) * kstepA;
            const char* a2 = last ? nA : cA + (size_t)(t + 2) * kstepA; const char* b2 = last ? nB : cB + (size_t)(t + 2) * kstepB;
            const char* a3 = a2 + kstepA; const char* b3 = b2 + kstepB;
            unsigned vA2[2][2];
#pragma unroll
            for (int h = 0; h < 2; ++h)
#pragma unroll
                for (int i = 0; i < 2; ++i) vA2[h][i] = last ? voffAn[h][i] : voffA[h][i];
            if constexpr (SP2) {
            PG8_LDB(B0, 0, 0); PG8_LDB(B1, 0, 1); PG8_SCHED; PG8_LDA(At, 0, 0); PG8_STAGE(PG8_SA(1, 1), a1, voffA[1]);
            PG8_WAIT_V(8); PG8_WAIT_L(0); PG8_BAR; PG8_MMA(0, 0, At, B0); PG8_MMA(0, 1, At, B1); PG8_BAR; PG8_SCHED;
            PG8_LDA(At, 0, 1); PG8_STAGE(PG8_SB(0, 0), b2, voffB); PG8_STAGE(PG8_SB(0, 1), b2 + hstepB, voffB); PG8_STAGE(PG8_SA(0, 0), a2, vA2[0]);
            PG8_WAIT_V(8); PG8_WAIT_L(0); PG8_BAR; PG8_MMA(1, 0, At, B0); PG8_MMA(1, 1, At, B1); PG8_BAR; PG8_SCHED;
            PG8_LDB(B0, 1, 0); PG8_LDB(B1, 1, 1); PG8_SCHED; PG8_LDA(At, 1, 0); PG8_STAGE(PG8_SA(0, 1), a2, vA2[1]);
            PG8_WAIT_V(8); PG8_WAIT_L(0); PG8_BAR; PG8_MMA(0, 0, At, B0); PG8_MMA(0, 1, At, B1); PG8_BAR; PG8_SCHED;
            PG8_LDA(At, 1, 1); PG8_STAGE(PG8_SB(1, 0), b3, voffB); PG8_STAGE(PG8_SB(1, 1), b3 + hstepB, voffB); PG8_STAGE(PG8_SA(1, 0), a3, vA2[0]);
            PG8_WAIT_V(8); PG8_WAIT_L(0); PG8_BAR; PG8_MMA(1, 0, At, B0); PG8_MMA(1, 1, At, B1); PG8_BAR; PG8_SCHED;
            } else {
            PG8_LDB(B0, 0, 0); PG8_SCHED; PG8_LDA(At, 0, 0); PG8_STAGE(PG8_SA(1, 1), a1, voffA[1]);
            PG8_WAIT_L(8); PG8_BAR; PG8_WAIT_L(0); PG8_MMA(0, 0, At, B0); PG8_BAR; PG8_SCHED;
            PG8_LDB(B1, 0, 1); PG8_STAGE(PG8_SB(0, 0), b2, voffB);
            PG8_BAR; PG8_WAIT_L(0); PG8_MMA(0, 1, At, B1); PG8_BAR;
            PG8_LDA(At, 0, 1); PG8_STAGE(PG8_SA(0, 0), a2, vA2[0]);
            PG8_BAR; PG8_WAIT_L(0); PG8_MMA(1, 0, At, B0); PG8_BAR; PG8_SCHED;
            PG8_STAGE(PG8_SB(0, 1), b2 + hstepB, voffB);
            PG8_WAIT_V(6); PG8_BAR; PG8_MMA(1, 1, At, B1); PG8_BAR;
            PG8_LDB(B0, 1, 0); PG8_SCHED; PG8_LDA(At, 1, 0); PG8_STAGE(PG8_SA(0, 1), a2, vA2[1]);
            PG8_WAIT_L(8); PG8_BAR; PG8_WAIT_L(0); PG8_MMA(0, 0, At, B0); PG8_BAR; PG8_SCHED;
            PG8_LDB(B1, 1, 1); PG8_STAGE(PG8_SB(1, 0), b3, voffB);
            PG8_BAR; PG8_WAIT_L(0); PG8_MMA(0, 1, At, B1); PG8_BAR;
            PG8_LDA(At, 1, 1); PG8_STAGE(PG8_SA(1, 0), a3, vA2[0]);
            PG8_BAR; PG8_WAIT_L(0); PG8_MMA(1, 0, At, B0); PG8_BAR; PG8_SCHED;
            PG8_STAGE(PG8_SB(1, 1), b3 + hstepB, voffB);
            PG8_WAIT_V(6); PG8_BAR; PG8_MMA(1, 1, At, B1); PG8_BAR;
            }
        }
        if constexpr (ALIGN_EPI) { if (wr == 0) PG8_BAR; }
        bool keep = false;
        if constexpr (Epi::CHAIN) keep = E.chain(acc, cur, wr, wc, fr, fq);
        else E(acc, cur, wr, wc, fr, fq);
        if (!has_next) break;
        if (!keep) {
#pragma unroll
        for (int a = 0; a < 2; ++a)
#pragma unroll
            for (int b = 0; b < 2; ++b)
#pragma unroll
                for (int m = 0; m < 4; ++m)
#pragma unroll
                    for (int n = 0; n < 2; ++n) acc[a][b][m][n] = zero4();
        }
        cur = nxt; cA = nA; cB = nB; ++ui;
        if constexpr (GATHER) {
#pragma unroll
            for (int h = 0; h < 2; ++h)
#pragma unroll
                for (int i = 0; i < 2; ++i) voffA[h][i] = voffAn[h][i]; }
        if constexpr (ALIGN_EPI) { if (wr == 1) PG8_BAR; }
    }
    PG8_WAIT_V(0);
    if constexpr (!ALIGN_EPI) { if (wr == 0) PG8_BAR; }
    PG8_BAR;
#undef PG8_SA
#undef PG8_SB
#undef PG8_STAGE
#undef PG8_LDA
#undef PG8_LDB
#undef PG8_MMA
#undef PG8_WAIT_V
#undef PG8_WAIT_L
#undef PG8_BAR
#undef PG8_SCHED
}
}

typedef float f32x16 __attribute__((ext_vector_type(16)));
typedef unsigned u32x4v __attribute__((ext_vector_type(4)));
typedef short s16x4 __attribute__((ext_vector_type(4)));
constexpr int NSA_MISC = 49152, NSA_OUT = 53248, NSA_QF = 118784;
constexpr float NSA_NEG = -1e30f, NSA_M0 = -1e20f;
DEVI int crow16(int r, int hi) { return (r & 3) + 8 * (r >> 2) + 4 * hi; }
DEVI float half_max(float v) { auto rr = __builtin_amdgcn_permlane32_swap(__float_as_uint(v), __float_as_uint(v), false, false); return fmaxf(__uint_as_float(rr[0]), __uint_as_float(rr[1])); }
DEVI float half_sum(float v) { auto rr = __builtin_amdgcn_permlane32_swap(__float_as_uint(v), __float_as_uint(v), false, false); return __uint_as_float(rr[0]) + __uint_as_float(rr[1]); }
DEVI unsigned half_or(unsigned v) { auto rr = __builtin_amdgcn_permlane32_swap(v, v, false, false); return rr[0] | rr[1]; }
DEVI int half_addi(int v) { auto rr = __builtin_amdgcn_permlane32_swap((unsigned)v, (unsigned)v, false, false); return (int)(rr[0] + rr[1]); }

template <class LD>
DEVI void tr_item_f(LD ld, bf16_t* dst, int ldd, float* scr, int lane) {
#pragma unroll 8
    for (int i = 0; i < 32; ++i) { const int kk = 2 * i + (lane >> 5); scr[kk * 33 + (lane & 31)] = ld(kk); }
    LDS_FENCE();
    const int c = lane & 7;
#pragma unroll
    for (int j = 0; j < 4; ++j) {
        const int n = (lane >> 3) + 8 * j; const float* s = scr + (8 * c) * 33 + n;
        uint4 o; o.x = pk2(s[0], s[33]); o.y = pk2(s[66], s[99]); o.z = pk2(s[132], s[165]); o.w = pk2(s[198], s[231]);
        *(uint4*)(dst + (size_t)n * ldd + 8 * c) = o;
    }
    LDS_FENCE();
}
DEVI void tr_item(const float* srck0, int ldsrc, int col0, int nvalid, const float* ks, bf16_t* dst, int ldd, float* scr, int lane) {
    const int r8 = lane >> 3, c4 = (lane & 7) * 4;
    const bool ok = (col0 >= 0 && c4 < nvalid);
    const int col = ok ? col0 + c4 : 0;
    const float msk = ok ? 1.f : 0.f;
    f32x4 v[8];
#pragma unroll
    for (int i = 0; i < 8; ++i) v[i] = *(const f32x4*)(srck0 + (size_t)(8 * i + r8) * ldsrc + col);
#pragma unroll
    for (int i = 0; i < 8; ++i) {
        const int kk = 8 * i + r8;
        const float s = ks ? ks[kk] * msk : msk;
        *(f32x4*)(scr + kk * 36 + c4) = v[i] * s;
    }
    LDS_FENCE();
    const int c = lane & 7;
#pragma unroll
    for (int j = 0; j < 4; ++j) {
        const int n = (lane >> 3) + 8 * j; const float* s = scr + (8 * c) * 36 + n;
        uint4 o; o.x = pk2(s[0], s[36]); o.y = pk2(s[72], s[108]); o.z = pk2(s[144], s[180]); o.w = pk2(s[216], s[252]);
        *(uint4*)(dst + (size_t)n * ldd + 8 * c) = o;
    }
    LDS_FENCE();
}
DEVI void phase_prep(const Params& p, bf16_t* WIN, bf16_t* WBR, bf16_t* WO, bf16_t* WRT, bf16_t* W1T, bf16_t* W2T, float* BPE, float* ldsf) {
    const int tid = TIDX; const int bid = BIDX; const int lane = tid & 63, wv = tid >> 6, gw = bid * 8 + wv, ngw = gridDim.x * 8;
    float* scr = ldsf + wv * 2304;
    for (int e = gw * 64 + lane; e < 2 * 2 * 64 * 128; e += ngw * 64) {
        const int lz = e >> 13, d = (e >> 7) & 63, j = e & 127;
        W2T[e] = f2bf(p.in[13][(size_t)lz * 8192 + j * 64 + d]);
    }
    for (int it = gw; it < 2 * 2 * 128; it += ngw) {
        const int lz = it >> 7, j = it & 127;
        const float* pe = p.in[10] + (size_t)lz * 2048; const float* w1 = p.in[11] + (size_t)lz * 2048 * 128 + j;
        float s = 0.f;
#pragma unroll 8
        for (int i = 0; i < 32; ++i) { const int k = lane + 64 * i; s += pe[k] * w1[(size_t)k * 128]; }
        s = wave_sum(s);
        if (lane == 0) BPE[it] = s + p.in[12][it];
    }
    for (int it = gw; it < 2 * 2 * 128; it += ngw) {
        const int lz = it >> 7, r = it & 127, kb = r >> 2, nb = r & 3, k0 = kb * 64, n0 = nb * 32;
        tr_item(p.in[11] + (size_t)lz * 2048 * 128 + (size_t)k0 * 128, 128, n0, 32, nullptr, W1T + ((size_t)lz * 128 + n0) * 2048 + k0, 2048, scr, lane);
    }
    constexpr int I_IN = 16 * 224, I_BR = 8 * 32, I_O = 16 * 32, I_R = 16 * 8, I_L = I_IN + 3 * I_BR + I_O + I_R;
    for (int it = gw; it < 2 * I_L; it += ngw) {
        const int l = it / I_L; int r = it % I_L;
        if (r >= I_L - I_R) {
            r -= I_L - I_R; const int kb = r / 8, nb = r % 8, k0 = kb * 64, n0 = nb * 32, n = n0 + (lane & 31);
            const float* wg = p.in[23] + (size_t)l * DM * 4 + (size_t)k0 * 4; const float* we = p.in[25] + (size_t)l * DM * 32 + (size_t)k0 * 32; const float* gn = p.in[22] + l * DM + k0;
            tr_item_f([&](int kk) { return (n < 4 ? wg[kk * 4 + n] : (n < 36 ? we[kk * 32 + n - 4] : 0.f)) * gn[kk]; }, WRT + ((size_t)l * 256 + n0) * DM + k0, DM, scr, lane);
        } else if (r < I_IN) {
            const int kb = r / 224, nb = r % 224, k0 = kb * 64, n0 = nb * 32;
            tr_item(p.in[2] + (size_t)l * DM * INW + (size_t)k0 * INW, INW, orig_col(phys2logical(n0)), n0 == OFF_NG ? 24 : 32, p.in[1] + l * DM + k0, WIN + ((size_t)l * LDY + n0) * DM + k0, DM, scr, lane);
        } else if (r < I_IN + 3 * I_BR) {
            r -= I_IN; const int br = r / I_BR, rr = r % I_BR, kb = rr / 32, nb = rr % 32, k0 = kb * 64, n0 = nb * 32;
            const float* W = (br == 0 ? p.in[18] : (br == 1 ? p.in[19] : p.in[20])) + (size_t)l * 512 * DM;
            tr_item(W + (size_t)k0 * DM, DM, n0, 32, nullptr, WBR + ((size_t)(l * 3 + br) * DM + n0) * 512 + k0, 512, scr, lane);
        } else {
            r -= I_IN + 3 * I_BR; const int kb = r / 32, nb = r % 32, k0 = kb * 64, n0 = nb * 32;
            tr_item(p.in[21] + (size_t)l * DM * DM + (size_t)k0 * DM, DM, n0, 32, nullptr, WO + ((size_t)l * DM + n0) * DM + k0, DM, scr, lane);
        }
    }
}
DEVI void phase_moe_prep(const float* Wg, const float* Wu, const float* Wd, const float* gain, bf16_t* WGU, bf16_t* WD, float* ldsf) {
    const int tid = TIDX; const int bid = BIDX; const int lane = tid & 63, wv = tid >> 6, gw = bid * 8 + wv, ngw = gridDim.x * 8;
    float* scr = ldsf + wv * 2304;
    constexpr int I_GU = 16 * 16, I_D = 4 * 32, I_E = I_GU + I_D;
    int it0, it1;
    if (gridDim.x == 256) { if (bid >= 64) { const int v = (bid - 64) * 8 + wv; it0 = 7 * v; it1 = it0 + 7; } else { const int v = bid * 8 + wv; it0 = 10752 + 3 * v; it1 = it0 + 3; } }
    else { it0 = gw; it1 = NEXP * I_E; }
    const int istep = (gridDim.x == 256) ? 1 : ngw;
    for (int it = it0; it < it1; it += istep) {
        const int e = it / I_E; int r = it % I_E;
        if (r < I_GU) {
            const int kb = r / 16, nb = r % 16, k0 = kb * 64, n0 = nb * 32;
            const int half = n0 >> 8, isup = (n0 >> 7) & 1, i0 = n0 & 127;
            const float* W = (isup ? Wu : Wg) + (size_t)e * DM * 256 + (size_t)k0 * 256;
            tr_item(W, 256, half * 128 + i0, 32, gain + k0, WGU + ((size_t)e * 512 + n0) * DM + k0, DM, scr, lane);
        } else {
            r -= I_GU; const int kb = r / 32, nb = r % 32, k0 = kb * 64, n0 = nb * 32;
            tr_item(Wd + (size_t)e * 256 * DM + (size_t)k0 * DM, DM, n0, 32, nullptr, WD + ((size_t)e * DM + n0) * 256 + k0, 256, scr, lane);
        }
    }
}

DEVI void phase_xb(const float* x, float* rstd, bf16_t* XB) {
    const int tid = TIDX; const int bid = BIDX; const int lane = tid & 63, gw = bid * 8 + (tid >> 6), ngw = gridDim.x * 8;
    for (int m = gw; m < MTOK; m += ngw) {
        const f32x4* xr = (const f32x4*)(x + (size_t)m * DM) + lane;
        uint2* xo = (uint2*)(XB + (size_t)m * DM) + lane;
        float s = 0.f;
#pragma unroll
        for (int j = 0; j < 4; ++j) { const f32x4 v = xr[64 * j]; s += v[0] * v[0] + v[1] * v[1] + v[2] * v[2] + v[3] * v[3];
            uint2 o; o.x = pk2(v[0], v[1]); o.y = pk2(v[2], v[3]); xo[64 * j] = o; }
        s = wave_sum(s);
        if (lane == 0) rstd[m] = rsqrtf(s * (1.f / DM) + RMS_EPS);
    }
}

struct EpiInproj {
    static constexpr bool PERM = true, CHAIN = false;
    bf16_t* Y; const float* rstd; const float* qn; const float* kn;
    DEVI void operator()(const f32x4 (&acc)[2][2][4][2], const pg8::Unit& u, int wr, int wc, int fr, int fq) const {
        const int row0 = u.pm * 256 + wr * 64 + fr;
        if (head_tile(u.pn)) {
            const bool isq = u.pn < 6, normed = isq || wc < 2;
            const float* gp = isq ? qn : kn + (u.pn == 7 ? 64 : 128);
            float gn[2][8];
#pragma unroll
            for (int bj = 0; bj < 2; ++bj)
#pragma unroll
                for (int e = 0; e < 8; ++e) gn[bj][e] = normed ? gp[32 * bj + 8 * fq + e] * (isq ? 0.125f * 1.4426950408889634f : 1.f) : 1.f;
#pragma unroll
            for (int ai = 0; ai < 2; ++ai)
#pragma unroll
                for (int m = 0; m < 4; ++m) {
                    const int row = row0 + ai * 128 + m * 16; const float rs = rstd[row];
                    f32x4 v[2][2]; float ss = 0.f;
#pragma unroll
                    for (int bj = 0; bj < 2; ++bj)
#pragma unroll
                        for (int n = 0; n < 2; ++n) { v[bj][n] = acc[ai][bj][m][n] * rs; ss += v[bj][n][0] * v[bj][n][0] + v[bj][n][1] * v[bj][n][1] + v[bj][n][2] * v[bj][n][2] + v[bj][n][3] * v[bj][n][3]; }
                    ss += shx(ss, 16); ss += shx(ss, 32);
                    const float hs = normed ? rsqrtf(ss * (1.f / 64.f) + RMS_EPS) : 1.f;
#pragma unroll
                    for (int bj = 0; bj < 2; ++bj) {
                        uint4 w;
                        w.x = pk2(v[bj][0][0] * hs * gn[bj][0], v[bj][0][1] * hs * gn[bj][1]); w.y = pk2(v[bj][0][2] * hs * gn[bj][2], v[bj][0][3] * hs * gn[bj][3]);
                        w.z = pk2(v[bj][1][0] * hs * gn[bj][4], v[bj][1][1] * hs * gn[bj][5]); w.w = pk2(v[bj][1][2] * hs * gn[bj][6], v[bj][1][3] * hs * gn[bj][7]);
                        *(uint4*)(Y + (size_t)row * LDY + u.pn * 256 + wc * 64 + 32 * bj + 8 * fq) = w;
                    }
                }
            return;
        }
        const int col0 = u.pn * 256 + wc * 32 + 8 * fq;
#pragma unroll
        for (int ai = 0; ai < 2; ++ai)
#pragma unroll
            for (int m = 0; m < 4; ++m) {
                const int row = row0 + ai * 128 + m * 16; const float rs = rstd[row];
#pragma unroll
                for (int bj = 0; bj < 2; ++bj) {
                    const int col = col0 + bj * 128;
                    if (col >= OFF_END) continue;
                    f32x4 v0 = acc[ai][bj][m][0] * rs, v1 = acc[ai][bj][m][1] * rs;
                    if (col >= OFF_RY && col < OFF_Q) {
#pragma unroll
                        for (int e = 0; e < 4; ++e) { v0[e] = gelu_tanh(v0[e]); v1[e] = gelu_tanh(v1[e]); }
                    } else if (col >= OFF_MG) {
#pragma unroll
                        for (int e = 0; e < 4; ++e) { v0[e] = sigmoidf_(v0[e]); v1[e] = sigmoidf_(v1[e]); }
                    }
                    uint4 w; w.x = pk2(v0[0], v0[1]); w.y = pk2(v0[2], v0[3]); w.z = pk2(v1[0], v1[1]); w.w = pk2(v1[2], v1[3]);
                    *(uint4*)(Y + (size_t)row * LDY + col) = w;
                }
            }
    }
};
struct MergeOrder {
    pg8::StaticOrder so;
    DEVI bool next(int i, pg8::Unit& u) const {
        pg8::Unit t; if (!so.next(i / 3, t)) return false;
        const int br = i % 3;
        u.pm = t.pm; u.pn = br * 4 + t.pn; u.ao = br == 0 ? OFF_RY : (br == 1 ? OFF_RX : OFF_SB); return true;
    }
};
struct EpiMerge {
    static constexpr bool PERM = true, CHAIN = true;
    bf16_t* Y;
    DEVI void operator()(const f32x4 (&)[2][2][4][2], const pg8::Unit&, int, int, int, int) const {}
    DEVI bool chain(f32x4 (&acc)[2][2][4][2], const pg8::Unit& u, int wr, int wc, int fr, int fq) const {
        const int br = u.pn >> 2;
        const int row0 = u.pm * 256 + wr * 64 + fr, col0 = (u.pn & 3) * 256 + wc * 32 + 8 * fq;
#pragma unroll
        for (int ai = 0; ai < 2; ++ai)
#pragma unroll
            for (int m = 0; m < 4; ++m) {
                const int row = row0 + ai * 128 + m * 16;
#pragma unroll
                for (int bj = 0; bj < 2; ++bj) {
                    const bf16_t* gp = Y + (size_t)row * LDY + OFF_MG + col0 + bj * 128;
                    float g[8]; unpack8(*(const uint4*)(gp + br * 1024), g);
#pragma unroll
                    for (int e = 0; e < 8; ++e) g[e] = fmaxf(g[e], 9.5367431640625e-7f);
                    if (br < 2) {
                        float gnx[8]; unpack8(*(const uint4*)(gp + (br + 1) * 1024), gnx);
#pragma unroll
                        for (int e = 0; e < 8; ++e) { const float r = g[e] * __builtin_amdgcn_rcpf(fmaxf(gnx[e], 9.5367431640625e-7f)); acc[ai][bj][m][e >> 2][e & 3] *= r; }
                    } else {
                        uint4 w;
                        w.x = pk2(g[0] * acc[ai][bj][m][0][0], g[1] * acc[ai][bj][m][0][1]); w.y = pk2(g[2] * acc[ai][bj][m][0][2], g[3] * acc[ai][bj][m][0][3]);
                        w.z = pk2(g[4] * acc[ai][bj][m][1][0], g[5] * acc[ai][bj][m][1][1]); w.w = pk2(g[6] * acc[ai][bj][m][1][2], g[7] * acc[ai][bj][m][1][3]);
                        *(uint4*)(Y + (size_t)row * LDY + OFF_SC + col0 + bj * 128) = w;
                    }
                }
            }
        return br < 2;
    }
};
DEVI float row_rstd16(const float* ssp) {
    const f32x4 a = *(const f32x4*)ssp, b = *(const f32x4*)(ssp + 4), c = *(const f32x4*)(ssp + 8), d = *(const f32x4*)(ssp + 12);
    const float s = ((a[0] + a[1]) + (a[2] + a[3])) + ((b[0] + b[1]) + (b[2] + b[3])) + ((c[0] + c[1]) + (c[2] + c[3])) + ((d[0] + d[1]) + (d[2] + d[3]));
    return rsqrtf(s * (1.f / DM) + RMS_EPS);
}
struct EpiOut {
    static constexpr bool PERM = false, CHAIN = false;
    bf16_t* XB; float* SS;
    DEVI void operator()(const f32x4 (&acc)[2][2][4][2], const pg8::Unit& u, int wr, int wc, int fr, int fq) const {
        const int row0 = u.pm * 256 + wr * 64 + fr, col0 = u.pn * 256 + wc * 32 + 4 * fq;
#pragma unroll
        for (int ai = 0; ai < 2; ++ai)
#pragma unroll
            for (int m = 0; m < 4; ++m) {
                const int row = row0 + ai * 128 + m * 16;
                const size_t ro = (size_t)row * DM + col0;
                float s = 0.f;
#pragma unroll
                for (int bj = 0; bj < 2; ++bj)
#pragma unroll
                    for (int n = 0; n < 2; ++n) {
                        const size_t off = ro + bj * 128 + n * 16;
                        const uint2 xr = *(const uint2*)(XB + off);
                        f32x4 v = acc[ai][bj][m][n];
                        v[0] += __uint_as_float(xr.x << 16); v[1] += __uint_as_float(xr.x & 0xffff0000u); v[2] += __uint_as_float(xr.y << 16); v[3] += __uint_as_float(xr.y & 0xffff0000u);
                        uint2 w; w.x = pk2(v[0], v[1]); w.y = pk2(v[2], v[3]);
                        *(uint2*)(XB + off) = w;
                        const float r0 = __uint_as_float(w.x << 16), r1 = __uint_as_float(w.x & 0xffff0000u), r2 = __uint_as_float(w.y << 16), r3 = __uint_as_float(w.y & 0xffff0000u);
                        s += r0 * r0 + r1 * r1 + r2 * r2 + r3 * r3;
                    }
                s += shx(s, 16); s += shx(s, 32);
                if (fq == 0) SS[(size_t)row * 16 + u.pn * 4 + wc] = s;
            }
    }
};
struct CmpOrder {
    int G, c;
    DEVI bool next(int i, pg8::Unit& u) const {
        const int L = i * G + c; if (L >= 16) return false;
        const int z = L >> 3, g = (L >> 2) & 1, b = L & 3;
        u.pm = b; u.pn = 0; u.ao = (z ? OFF_VC : OFF_KC) + g * 64; return true;
    }
};
struct EpiCmp1 {
    static constexpr bool PERM = false, CHAIN = false;
    bf16_t* HID; const float* BPE;
    DEVI void operator()(const f32x4 (&acc)[2][2][4][2], const pg8::Unit& u, int wr, int wc, int fr, int fq) const {
        const int z = (u.ao >= OFF_VC) ? 1 : 0, g = ((u.ao - (z ? OFF_VC : OFF_KC)) >> 6) & 1, b = u.pm;
        const int col0 = wc * 32 + 4 * fq;
#pragma unroll
        for (int ai = 0; ai < 2; ++ai)
#pragma unroll
            for (int m = 0; m < 4; ++m) {
                const int n = ai * 128 + wr * 64 + m * 16 + fr;
                if (n >= NCMP) continue;
                bf16_t* dst = HID + ((size_t)z * 2048 + (size_t)(b * NCMP + n) * 2 + g) * 128 + col0;
#pragma unroll
                for (int nn = 0; nn < 2; ++nn) {
                    const f32x4 a = z ? acc[ai][1][m][nn] : acc[ai][0][m][nn];
                    const f32x4 bb = *(const f32x4*)(BPE + z * 128 + col0 + nn * 16);
                    uint2 o; o.x = pk2(gelu_tanh(a[0] + bb[0]), gelu_tanh(a[1] + bb[1])); o.y = pk2(gelu_tanh(a[2] + bb[2]), gelu_tanh(a[3] + bb[3]));
                    *(uint2*)(dst + nn * 16) = o;
                }
            }
    }
};
DEVI void cmp2_unit(const bf16_t* HID, const bf16_t* W2T  , const float* b2  , const float* kn0  , bf16_t* KCB, bf16_t* VCB, int z, int g, int b) {
    const int tid = TIDX; const int lane = tid & 63, w = tid >> 6, r32 = lane & 31, hi = lane >> 5;
    const int n = 32 * w + r32;
    const bf16_t* hrow = HID + ((size_t)z * 2048 + (size_t)(b * NCMP + (n < NCMP ? n : 0)) * 2 + g) * 128;
    f32x16 acc[2];
#pragma unroll
    for (int blk = 0; blk < 2; ++blk)
#pragma unroll
        for (int r = 0; r < 16; ++r) acc[blk][r] = 0.f;
#pragma unroll
    for (int s = 0; s < 8; ++s) {
        const bf16x8 hf = *(const bf16x8*)(hrow + 16 * s + 8 * hi);
#pragma unroll
        for (int blk = 0; blk < 2; ++blk) {
            const bf16x8 wf = *(const bf16x8*)(W2T + ((size_t)z * 64 + 32 * blk + r32) * 128 + 16 * s + 8 * hi);
            acc[blk] = __builtin_amdgcn_mfma_f32_32x32x16_bf16(wf, hf, acc[blk], 0, 0, 0);
        }
    }
    float ss = 0.f;
#pragma unroll
    for (int blk = 0; blk < 2; ++blk)
#pragma unroll
        for (int r = 0; r < 16; ++r) { acc[blk][r] += b2[z * 64 + 32 * blk + crow16(r, hi)]; ss += acc[blk][r] * acc[blk][r]; }
    ss = half_sum(ss);
    const float rs = (z == 0) ? rsqrtf(ss * (1.f / 64.f) + RMS_EPS) : 1.f;
    bf16_t* dst = (z ? VCB : KCB) + ((size_t)((b * 2 + g) * 256) + n) * 64;
#pragma unroll
    for (int blk = 0; blk < 2; ++blk)
#pragma unroll
        for (int gi = 0; gi < 4; ++gi) {
            const int d0 = 32 * blk + 8 * gi + 4 * hi;
            float o[4];
#pragma unroll
            for (int e = 0; e < 4; ++e) o[e] = (n < NCMP) ? acc[blk][4 * gi + e] * rs * (z == 0 ? kn0[d0 + e] : 1.f) : 0.f;
            uint2 wv; wv.x = pk2(o[0], o[1]); wv.y = pk2(o[2], o[3]);
            *(uint2*)(dst + d0) = wv;
        }
}
struct EpiRouter {
    static constexpr bool PERM = false, CHAIN = false;
    float* LOG; const float* SS;
    DEVI void operator()(const f32x4 (&acc)[2][2][4][2], const pg8::Unit& u, int wr, int wc, int fr, int fq) const {
        if (wc >= 2) return;
        const int row0 = u.pm * 256 + wr * 64 + fr, col0 = wc * 32 + 4 * fq;
#pragma unroll
        for (int ai = 0; ai < 2; ++ai)
#pragma unroll
            for (int m = 0; m < 4; ++m) {
                const int row = row0 + ai * 128 + m * 16;
                const float rs = row_rstd16(SS + (size_t)row * 16);
#pragma unroll
                for (int n = 0; n < 2; ++n) *(f32x4*)(LOG + (size_t)row * 64 + col0 + n * 16) = acc[ai][0][m][n] * rs;
            }
    }
};
constexpr int LDS_ROWT = 132096;
struct EpiMoeUp {
    static constexpr bool PERM = true, CHAIN = false;
    bf16_t* HM; const float* wl; const float* rsl;
    DEVI void operator()(const f32x4 (&acc)[2][2][4][2], const pg8::Unit& u, int wr, int wc, int fr, int fq) const {
        const int rl0 = wr * 64 + fr, col0 = (u.pn & 1) * 128 + wc * 32 + 8 * fq;
#pragma unroll
        for (int ai = 0; ai < 2; ++ai)
#pragma unroll
            for (int m = 0; m < 4; ++m) {
                const int rl = rl0 + ai * 128 + m * 16; const float w = wl[u.aux * 256 + rl], rs = rsl[u.aux * 256 + rl];
                float h[8];
#pragma unroll
                for (int n = 0; n < 2; ++n)
#pragma unroll
                    for (int q = 0; q < 4; ++q) { const float g = acc[ai][0][m][n][q] * rs; h[n * 4 + q] = g * sigmoidf_(g) * (acc[ai][1][m][n][q] * rs) * w; }
                uint4 o; o.x = pk2(h[0], h[1]); o.y = pk2(h[2], h[3]); o.z = pk2(h[4], h[5]); o.w = pk2(h[6], h[7]);
                *(uint4*)(HM + (size_t)(u.pm * 256 + rl) * 256 + col0) = o;
            }
    }
};
DEVI void moe_xcd(const int* tb, int G, int bid, int& rt0, int& ntile, int& j, int& per) {
    if ((G & 7) == 0) { const int x = bid & 7; rt0 = tb[4 * x]; ntile = tb[4 * x + 4] - rt0; j = bid >> 3; per = G >> 3; }
    else { rt0 = 0; ntile = tb[NEXP]; j = bid; per = G; }
}
DEVI int moe_rounds(const int* tb, int G, int nsplit) {
    int r = 0;
    if ((G & 7) == 0) { for (int x = 0; x < 8; ++x) { const int u = (tb[4 * x + 4] - tb[4 * x]) * nsplit, q = (u + (G >> 3) - 1) / (G >> 3); r = q > r ? q : r; } }
    else r = (tb[NEXP] * nsplit + G - 1) / G;
    return r;
}
struct MoeUpOrder {
    const int* tb; int G, c, r; const int* tokl;
    DEVI bool unit(int& rt, int& part) const {
        int rt0, ntile, j, per; moe_xcd(tb, G, c, rt0, ntile, j, per);
        const int u = r * per + j; if (u >= ntile * 2) return false;
        rt = rt0 + (u >> 1); part = u & 1; return true;
    }
    DEVI bool next(int i, pg8::Unit& u) const {
        int rt, part; if (i >= 1 || !unit(rt, part)) return false;
        u.pm = rt; u.pn = tb[40 + rt] * 2 + part; u.aux = 0; return true;
    }
    DEVI int a_row(int ord, int r_) const { return tokl[r_]; }
};
DEVI void moe_tables(const int* cnt, int* tb) {
    const int tid = TIDX;
    __syncthreads();
    if (tid == 0) { int a = 0; for (int e = 0; e < NEXP; ++e) { tb[e] = a; a += (cnt[e] + 255) >> 8; } tb[NEXP] = a; }
    __syncthreads();
    if (tid < 192) { int e = 0; for (int q = 1; q < NEXP; ++q) e += (tb[q] <= tid) ? 1 : 0; tb[40 + tid] = e; }
    __syncthreads();
}
DEVI void moe_up_setup(const int* cnt, const int* LIST, const float* RW, const float* SS, int* TOKS, const MoeUpOrder& S, int* tokl, float* wl, float* rsl) {
    const int tid = TIDX;
    __syncthreads();
    if (tid < 256) {
        const int rl = tid;
        int tok = 0; float w = 0.f, rs = 0.f;
        int rt, part;
        if (S.unit(rt, part)) {
            const int e = S.tb[40 + rt], r = (rt - S.tb[e]) * 256 + rl;
            int slot = -1;
            if (r < cnt[e]) { slot = LIST[e * MTOK + r]; tok = slot >> 1; w = RW[slot]; rs = row_rstd16(SS + (size_t)tok * 16); }
            TOKS[rt * 256 + rl] = slot;
        }
        tokl[tid] = tok; wl[tid] = w; rsl[tid] = rs;
    }
    __syncthreads();
}
struct EpiMoeDown {
    static constexpr bool PERM = true, CHAIN = false;
    bf16_t* YS; const int* SLOTS;
    DEVI void operator()(const f32x4 (&acc)[2][2][4][2], const pg8::Unit& u, int wr, int wc, int fr, int fq) const {
        const int row0 = u.pm * 256 + wr * 64 + fr, col0 = (u.pn & 3) * 256 + wc * 32 + 8 * fq;
#pragma unroll
        for (int ai = 0; ai < 2; ++ai)
#pragma unroll
            for (int m = 0; m < 4; ++m) {
                const int slot = SLOTS[row0 + ai * 128 + m * 16];
                if (slot >= 0) {
                    bf16_t* dst = YS + (size_t)slot * DM + col0;
#pragma unroll
                    for (int bj = 0; bj < 2; ++bj) {
                        uint4 w; w.x = pk2(acc[ai][bj][m][0][0], acc[ai][bj][m][0][1]); w.y = pk2(acc[ai][bj][m][0][2], acc[ai][bj][m][0][3]);
                        w.z = pk2(acc[ai][bj][m][1][0], acc[ai][bj][m][1][1]); w.w = pk2(acc[ai][bj][m][1][2], acc[ai][bj][m][1][3]);
                        *(uint4*)(dst + bj * 128) = w;
                    }
                }
                asm volatile("" ::: "memory");
            }
    }
};
DEVI void phase_combine(bf16_t* XB, const bf16_t* YS, float* rstd, float* xout, bool next) {
    const int tid = TIDX; const int bid = BIDX; const int lane = tid & 63, gw = bid * 8 + (tid >> 6), ngw = gridDim.x * 8;
    for (int m0 = gw * 2; m0 < MTOK; m0 += ngw * 2) {
        uint2 xv[2][4], a[2][4], b[2][4];
#pragma unroll
        for (int u = 0; u < 2; ++u) {
            const int m = m0 + u;
            const uint2* xr = (const uint2*)(XB + (size_t)m * DM) + lane;
            const uint2* y0 = (const uint2*)(YS + (size_t)(2 * m) * DM) + lane; const uint2* y1 = (const uint2*)(YS + (size_t)(2 * m + 1) * DM) + lane;
#pragma unroll
            for (int j = 0; j < 4; ++j) { xv[u][j] = xr[64 * j]; a[u][j] = y0[64 * j]; b[u][j] = y1[64 * j]; }
        }
#pragma unroll
        for (int u = 0; u < 2; ++u) {
            const int m = m0 + u;
            f32x4* xr = (f32x4*)(xout + (size_t)m * DM) + lane; uint2* xo = (uint2*)(XB + (size_t)m * DM) + lane;
            float s = 0.f;
#pragma unroll
            for (int j = 0; j < 4; ++j) {
                const uint2 xx = xv[u][j], aa = a[u][j], bb = b[u][j];
                f32x4 w;
                w[0] = __uint_as_float(xx.x << 16) + __uint_as_float(aa.x << 16) + __uint_as_float(bb.x << 16); w[1] = __uint_as_float(xx.x & 0xffff0000u) + __uint_as_float(aa.x & 0xffff0000u) + __uint_as_float(bb.x & 0xffff0000u);
                w[2] = __uint_as_float(xx.y << 16) + __uint_as_float(aa.y << 16) + __uint_as_float(bb.y << 16); w[3] = __uint_as_float(xx.y & 0xffff0000u) + __uint_as_float(aa.y & 0xffff0000u) + __uint_as_float(bb.y & 0xffff0000u);
                if (next) {
                    uint2 o; o.x = pk2(w[0], w[1]); o.y = pk2(w[2], w[3]); xo[64 * j] = o;
                    const float r0 = __uint_as_float(o.x << 16), r1 = __uint_as_float(o.x & 0xffff0000u), r2 = __uint_as_float(o.y << 16), r3 = __uint_as_float(o.y & 0xffff0000u);
                    s += r0 * r0 + r1 * r1 + r2 * r2 + r3 * r3;
                } else xr[64 * j] = w;
            }
            if (next) { s = wave_sum(s); if (lane == 0) rstd[m] = rsqrtf(s * (1.f / DM) + RMS_EPS); }
        }
    }
}
struct MoeOrder {
    const int* tb; int nsplit, G, c;
    DEVI bool next(int i, pg8::Unit& u) const {
        int rt0, ntile, j, per; moe_xcd(tb, G, c, rt0, ntile, j, per);
        const int L = i * per + j; if (L >= ntile * nsplit) return false;
        const int rt = rt0 + L / nsplit, part = L % nsplit;
        u.pm = rt; u.pn = tb[40 + rt] * nsplit + part; return true;
    }
};

DEVI void phase_gather(const bf16_t* XB, const float* SS, const int* cnt, const int* LIST, const float* RW, bf16_t* XG, int* TOKS, float* RWS, int* tb) {
    const int tid = TIDX; const int bid = BIDX; const int lane = tid & 63, gw = bid * 8 + (tid >> 6), ngw = gridDim.x * 8;
    if (tid == 0) { int a = 0; for (int e = 0; e < NEXP; ++e) { tb[e] = a; a += (cnt[e] + 255) >> 8; } tb[NEXP] = a; }
    __syncthreads();
    if (tid < 192) { int e = 0; for (int q = 1; q < NEXP; ++q) e += (tb[q] <= tid) ? 1 : 0; tb[40 + tid] = e; }
    __syncthreads();
    const int total = tb[NEXP] * 256;
    for (int rp0 = gw * 4; rp0 < total; rp0 += ngw * 4) {
        int slot[4]; bool ok[4];
#pragma unroll
        for (int q = 0; q < 4; ++q) {
            const int rp = rp0 + q, rt = rp >> 8;
            const int e = tb[40 + rt];
            const int r = rp - tb[e] * 256;
            ok[q] = r < cnt[e];
            slot[q] = ok[q] ? LIST[e * MTOK + r] : 0;
        }
        uint4 xr[4][2]; float rs[4], rw[4];
#pragma unroll
        for (int q = 0; q < 4; ++q) {
            const int tok = slot[q] >> 1;
            rs[q] = row_rstd16(SS + (size_t)tok * 16); rw[q] = RW[slot[q]];
            const uint4* xp = (const uint4*)(XB + (size_t)tok * DM) + lane;
            xr[q][0] = xp[0]; xr[q][1] = xp[64];
        }
#pragma unroll
        for (int q = 0; q < 4; ++q) {
            const int rp = rp0 + q;
            if (ok[q]) {
                uint4* xo = (uint4*)(XG + (size_t)rp * DM) + lane;
#pragma unroll
                for (int j = 0; j < 2; ++j) { float v[8]; unpack8(xr[q][j], v); const float s = rs[q]; uint4 o; o.x = pk2(v[0] * s, v[1] * s); o.y = pk2(v[2] * s, v[3] * s); o.z = pk2(v[4] * s, v[5] * s); o.w = pk2(v[6] * s, v[7] * s); xo[64 * j] = o; }
            }
            if (lane == 0) { TOKS[rp] = ok[q] ? slot[q] : -1; RWS[rp] = ok[q] ? rw[q] : 0.f; }
        }
    }
}

#ifndef NSA_FAST
#define NSA_FAST 1
#endif
DEVI void phase_qknorm(bf16_t* Y, const float* qn  , const float* kn  , int vb, int vg) {
    const int tid = TIDX; const int bid = vb; const int lane = tid & 63, gw = bid * 8 + (tid >> 6), ngw = vg * 8;
    const int sl = lane >> 4, e0 = (lane & 15) * 4;
    const int col2 = (sl < 2 ? OFF_KS + sl * 64 : OFF_KW + (sl - 2) * 64);
    const float* gn2 = kn + (sl < 2 ? 64 : 128);
    float g[3][4];
#pragma unroll
    for (int e = 0; e < 4; ++e) { g[0][e] = qn[e0 + e]; g[1][e] = g[0][e]; g[2][e] = gn2[e0 + e]; }
#if NSA_FAST
#pragma unroll
    for (int e = 0; e < 4; ++e) { g[0][e] *= 0.125f * 1.4426950408889634f; g[1][e] *= 0.125f * 1.4426950408889634f; }
#endif
    for (int m0 = gw * 2; m0 < MTOK; m0 += ngw * 2) {
        uint2 raw[2][3];
#pragma unroll
        for (int u = 0; u < 2; ++u) {
            bf16_t* row = Y + (size_t)(m0 + u) * LDY;
            raw[u][0] = *(const uint2*)(row + OFF_Q + sl * 64 + e0); raw[u][1] = *(const uint2*)(row + OFF_Q + (4 + sl) * 64 + e0); raw[u][2] = *(const uint2*)(row + col2 + e0);
        }
#pragma unroll
        for (int u = 0; u < 2; ++u) {
            bf16_t* row = Y + (size_t)(m0 + u) * LDY;
#pragma unroll
            for (int part = 0; part < 3; ++part) {
                const uint2 r = raw[u][part];
                const float v0 = __uint_as_float(r.x << 16), v1 = __uint_as_float(r.x & 0xffff0000u), v2 = __uint_as_float(r.y << 16), v3 = __uint_as_float(r.y & 0xffff0000u);
                float s = v0 * v0 + v1 * v1 + v2 * v2 + v3 * v3;
                s += shx(s, 1); s += shx(s, 2); s += shx(s, 4); s += shx(s, 8);
                const float rs = rsqrtf(s * (1.f / 64.f) + RMS_EPS);
                uint2 o; o.x = pk2(v0 * rs * g[part][0], v1 * rs * g[part][1]); o.y = pk2(v2 * rs * g[part][2], v3 * rs * g[part][3]);
                *(uint2*)(row + (part == 0 ? OFF_Q + sl * 64 : (part == 1 ? OFF_Q + (4 + sl) * 64 : col2)) + e0) = o;
            }
        }
    }
}

DEVI void phase_rglru1(const bf16_t* Y, const float* convw  , const float* convb, const float* wa  , const float* ba,
                       const float* wx, const float* bx, const float* lam, float* LA, bf16_t* VV, float* PA, float* PH, float* lds, int vb, int vg) {
    bf16_t* UB = (bf16_t*)lds;
    bf16_t* WT = UB + 64 * 72;
    float* SEG = (float*)(WT + 128 * 72);
    const int tid = TIDX;
    const int n = vb & 7;
    const int nper = vg >> 3;
    if ((vb >> 3) >= nper) return;
    __syncthreads();
    for (int e = tid; e < 8192; e += 512) {
        const int o = e & 127, i = e >> 7;
        WT[o * 72 + i] = f2bf(o < 64 ? wa[n * 4096 + i * 64 + o] : wx[n * 4096 + i * 64 + o - 64]);
    }
    const int j = tid & 63, tg = tid >> 6;
    const int lane = tid & 63, w = tid >> 6, mt = w & 3, cgp = w >> 2;
    const int chj = n * 64 + j;
    const float cw0 = convw[chj], cw1 = convw[512 + chj], cw2 = convw[1024 + chj], cw3 = convw[1536 + chj], cb = convb[chj];
    float bav[2], bxv[2], sp[2];
#pragma unroll
    for (int q = 0; q < 2; ++q) {
        const int ch = n * 64 + 16 * (cgp * 2 + q) + (lane & 15);
        bav[q] = ba[ch]; bxv[q] = bx[ch];
        const float ex = __expf(-lam[ch]);
        sp[q] = (ex < 0.03f) ? ex * (1.f - ex * (0.5f - ex * (0.33333334f - 0.25f * ex))) : __logf(1.f + ex);
    }
    float xin[11];
    {   const int c = vb >> 3; const int tl0 = (c & 63) * 64; const size_t m0 = (size_t)c * 64;
#pragma unroll
        for (int i = 0; i < 11; ++i) { const int t = tg * 8 + i - 3; xin[i] = (tl0 + t >= 0) ? bf2f(Y[(m0 + t) * LDY + OFF_RX + chj]) : 0.f; }
    }
    for (int c = vb >> 3; c < 256; c += nper) {
        const size_t m0 = (size_t)c * 64;
        __syncthreads();
#pragma unroll
        for (int q = 0; q < 8; ++q) UB[(tg * 8 + q) * 72 + j] = f2bf(cb + cw0 * xin[q] + cw1 * xin[q + 1] + cw2 * xin[q + 2] + cw3 * xin[q + 3]);
        if (c + nper < 256) {
            const int cn = c + nper; const int tl0 = (cn & 63) * 64; const size_t mn = (size_t)cn * 64;
#pragma unroll
            for (int i = 0; i < 11; ++i) { const int t = tg * 8 + i - 3; xin[i] = (tl0 + t >= 0) ? bf2f(Y[(mn + t) * LDY + OFF_RX + chj]) : 0.f; }
        }
        __syncthreads();
        f32x4 accr[2], acci[2];
#pragma unroll
        for (int q = 0; q < 2; ++q) { accr[q] = zero4(); acci[q] = zero4(); }
#pragma unroll
        for (int ks = 0; ks < 2; ++ks) {
            const bf16x8 af = *(const bf16x8*)(UB + (16 * mt + (lane & 15)) * 72 + 8 * (lane >> 4) + 32 * ks);
#pragma unroll
            for (int q = 0; q < 2; ++q) {
                const int o = 16 * (cgp * 2 + q) + (lane & 15);
                const bf16x8 br_ = *(const bf16x8*)(WT + o * 72 + 8 * (lane >> 4) + 32 * ks);
                const bf16x8 bi_ = *(const bf16x8*)(WT + (64 + o) * 72 + 8 * (lane >> 4) + 32 * ks);
                accr[q] = __builtin_amdgcn_mfma_f32_16x16x32_bf16(af, br_, accr[q], 0, 0, 0);
                acci[q] = __builtin_amdgcn_mfma_f32_16x16x32_bf16(af, bi_, acci[q], 0, 0, 0);
            }
        }
#pragma unroll
        for (int q = 0; q < 2; ++q) {
            const int cl = 16 * (cgp * 2 + q) + (lane & 15), ch = n * 64 + cl;
            float hseg = 0.f, aseg = 1.f;
#pragma unroll
            for (int r = 0; r < 4; ++r) {
                const int t = 16 * mt + 4 * (lane >> 4) + r;
                const float rg = sigmoidf_(accr[q][r] + bav[q]), ig = sigmoidf_(acci[q][r] + bxv[q]);
                const float la = -8.0f * rg * sp[q];
                const float y2 = 2.f * la;
                const float om = (y2 > -0.01f) ? -y2 * (1.f + y2 * (0.5f + y2 * 0.16666667f)) : 1.f - __expf(y2);
                const bf16_t vb16 = f2bf(sqrtf(om) * ig * bf2f(UB[t * 72 + cl]));
                LA[(m0 + t) * 512 + ch] = la; VV[(m0 + t) * 512 + ch] = vb16;
                const float a = __expf(la);
                hseg = a * hseg + bf2f(vb16); aseg *= a;
            }
            const int seg = 4 * mt + (lane >> 4);
            SEG[(seg * 64 + cl) * 2] = aseg; SEG[(seg * 64 + cl) * 2 + 1] = hseg;
        }
        __syncthreads();
        if (tid < 64) {
            float h = 0.f, A = 1.f;
#pragma unroll
            for (int s = 0; s < 16; ++s) { const float a = SEG[(s * 64 + tid) * 2]; h = a * h + SEG[(s * 64 + tid) * 2 + 1]; A *= a; }
            PA[c * 512 + n * 64 + tid] = A; PH[c * 512 + n * 64 + tid] = h;
        }
    }
    __syncthreads();
}

DEVI void phase_shortconv(bf16_t* Y, const float* w  , int vb, int vg) {
    const int tid = TIDX; const int bid = vb; const int gt = bid * 512 + tid, ngt = vg * 512;
    for (int it = gt; it < (MTOK / 8) * 64; it += ngt) {
        const int cg8 = (it & 63) * 8, m0 = (it >> 6) * 8, tl0 = m0 & (SEQ - 1);
        float wk[3][8];
#pragma unroll
        for (int k = 0; k < 3; ++k) load8f(w + k * 512 + cg8, wk[k]);
        uint4 rc[10], rh[10], rb[8];
#pragma unroll
        for (int i = 0; i < 10; ++i) {
            const int d = i - 2;
            if (tl0 + d >= 0) { const bf16_t* r = Y + (size_t)(m0 + d) * LDY; rc[i] = *(const uint4*)(r + OFF_SC + cg8); rh[i] = *(const uint4*)(r + OFF_SH + cg8); }
            else { rc[i] = make_uint4(0, 0, 0, 0); rh[i] = make_uint4(0, 0, 0, 0); }
        }
#pragma unroll
        for (int i = 0; i < 8; ++i) rb[i] = *(const uint4*)(Y + (size_t)(m0 + i) * LDY + OFF_SB + cg8);
        float p[10][8];
#pragma unroll
        for (int i = 0; i < 10; ++i) { float a[8], b2[8]; unpack8(rc[i], a); unpack8(rh[i], b2);
#pragma unroll
            for (int e = 0; e < 8; ++e) p[i][e] = a[e] * b2[e]; }
#pragma unroll
        for (int i = 0; i < 8; ++i) {
            float sb[8]; unpack8(rb[i], sb);
            float o[8];
#pragma unroll
            for (int e = 0; e < 8; ++e) o[e] = sb[e] * (wk[0][e] * p[i][e] + wk[1][e] * p[i + 1][e] + wk[2][e] * p[i + 2][e]);
            uint4 ow; ow.x = pk2(o[0], o[1]); ow.y = pk2(o[2], o[3]); ow.z = pk2(o[4], o[5]); ow.w = pk2(o[6], o[7]);
            *(uint4*)(Y + (size_t)(m0 + i) * LDY + OFF_SB + cg8) = ow;
        }
    }
}

DEVI void phase_cmp1(const bf16_t* Y, const float* pe  , const float* w1  , const float* b1  , float* HID, bf16_t* As, bf16_t* Bs) {
    const int tid = TIDX; const int bid = BIDX;
    for (int t = bid; t < 32; t += gridDim.x) {
        const int z = t >> 4, rt = t & 15;
        const int r = rt * 128 + (tid >> 2);
        const bool rv = r < NB * NCMP * 2;
        const int g = r & 1, bn_ = r >> 1, b = bn_ / NCMP, n = bn_ % NCMP;
        const bf16_t* abase = Y + (size_t)(b * SEQ + 16 * n) * LDY + (z ? OFF_VC : OFF_KC) + g * 64;
        const float* pez = pe + z * 2048;
        const float* wz = w1 + (size_t)z * 2048 * 128 + (tid & 15) * 8;
        f32x4 acc[2][4]; acc_zero(acc);
        gemm_tile(tid, acc, 2048, As, Bs,
                  [&](int k, float (&v)[8]) {
                      if (rv) { const int lp = k >> 6, d = k & 63; load8b(abase + (size_t)lp * LDY + d, v);
#pragma unroll
                          for (int j = 0; j < 8; ++j) v[j] += pez[k + j]; }
                      else zero8(v); },
                  [&](int k, float (&v)[8]) { load8f(wz + (size_t)k * 128, v); });
#pragma unroll
        for (int i = 0; i < 2; ++i) {
            const int rr = rt * 128 + ACC_ROW(i);
#pragma unroll
            for (int j = 0; j < 4; ++j) {
                const int c = ACC_COL(j);
                f32x4 o;
#pragma unroll
                for (int e = 0; e < 4; ++e) o[e] = gelu_tanh(acc[i][j][e] + b1[z * 128 + c + e]);
                *(f32x4*)(HID + ((size_t)z * 2048 + rr) * 128 + c) = o;
            }
        }
    }
}

DEVI void phase_cmp2_carry(const float* HID, const float* w2  , const float* b2  , const float* kn0  , float* KCMP, float* VCMP,
                           bf16_t* KCB, bf16_t* VCB) {
    const int tid = TIDX; const int bid = BIDX; const int lane = tid & 63, gw = bid * 8 + (tid >> 6), ngw = gridDim.x * 8;
    for (int it = gw; it < 2 * NB * NCMP * 2; it += ngw) {
        const int z = it / (NB * NCMP * 2), r = it % (NB * NCMP * 2);
        const float* h = HID + ((size_t)z * 2048 + r) * 128;
        const float* w = w2 + z * 8192 + lane;
        float acc = b2[z * 64 + lane];
        for (int j = 0; j < 128; ++j) acc += h[j] * w[j * 64];
        const int g = r & 1, bn_ = r >> 1, b = bn_ / NCMP, n = bn_ % NCMP;
        float* dst = (z ? VCMP : KCMP) + ((size_t)(b * 256 + n) * 2 + g) * 64 + lane;
        if (z == 0) { const float s = wave_sum(acc * acc); acc = acc * rsqrtf(s * (1.f / 64.f) + RMS_EPS) * kn0[lane]; }
        *dst = acc;
        (z ? VCB : KCB)[((size_t)((b * 2 + g) * 256) + n) * 64 + lane] = f2bf(acc);
    }
    if (gw < 16) { const int z = gw >> 3, bg = gw & 7; (z ? VCB : KCB)[((size_t)(bg * 256) + 255) * 64 + lane] = 0; }
}

DEVI void phase_rglru2(bf16_t* __restrict__ Y, const float* __restrict__ LA, const bf16_t* __restrict__ VV, const float* __restrict__ PA, const float* __restrict__ PH) {
    const int tid = TIDX; const int bid = BIDX; const int gt = bid * 512 + tid, ngt = gridDim.x * 512;
    for (int e = gt; e < 256 * 512; e += ngt) {
        const int c = e >> 9, ch = e & 511, cl = c & 63;
        const float* pa = PA + (size_t)(c - cl) * 512 + ch; const float* ph = PH + (size_t)(c - cl) * 512 + ch;
        float h = 0.f;
#pragma unroll 8
        for (int cc = 0; cc < cl; ++cc) h = pa[cc * 512] * h + ph[cc * 512];
        const size_t m0 = (size_t)c * 64;
#pragma unroll 1
        for (int t0 = 0; t0 < 64; t0 += 8) {
            float la[8], vv[8], ry[8];
#pragma unroll
            for (int i = 0; i < 8; ++i) { const size_t m = m0 + t0 + i; la[i] = LA[m * 512 + ch]; vv[i] = bf2f(VV[m * 512 + ch]); ry[i] = bf2f(Y[m * LDY + OFF_RY + ch]); }
#pragma unroll
            for (int i = 0; i < 8; ++i) { h = __expf(la[i]) * h + vv[i]; ry[i] *= h; }
#pragma unroll
            for (int i = 0; i < 8; ++i) Y[(m0 + t0 + i) * LDY + OFF_RY + ch] = f2bf(ry[i]);
        }
    }
}

DEVI void attend_block(const bf16_t* Y, int b, int g, int j, int t, int lo, int offk, int offv, const float* qs, float* ps, float (&mx)[4], float (&l)[4], float (&o)[4], int lane) {
    const int pos = 64 * j + lane;
    const bool valid = (pos <= t) && (pos >= lo);
    const bf16_t* kr = Y + (size_t)(b * SEQ + pos) * LDY + offk + g * 64;
    float s[4] = {0.f, 0.f, 0.f, 0.f};
#pragma unroll 2
    for (int d8 = 0; d8 < 8; ++d8) {
        float kv[8]; load8b(kr + d8 * 8, kv);
#pragma unroll
        for (int h = 0; h < 4; ++h) {
            const f32x4 qa = *(const f32x4*)(qs + h * 64 + d8 * 8), qb = *(const f32x4*)(qs + h * 64 + d8 * 8 + 4);
            s[h] += qa[0] * kv[0] + qa[1] * kv[1] + qa[2] * kv[2] + qa[3] * kv[3] + qb[0] * kv[4] + qb[1] * kv[5] + qb[2] * kv[6] + qb[3] * kv[7];
        }
    }
    LDS_FENCE();
#pragma unroll
    for (int h = 0; h < 4; ++h) {
        const float sv = valid ? s[h] : -1e30f;
        const float mn = fmaxf(mx[h], wave_max(sv));
        const float corr = __expf(mx[h] - mn);
        const float p = valid ? __expf(sv - mn) : 0.f;
        l[h] = l[h] * corr + wave_sum(p);
        o[h] *= corr; mx[h] = mn;
        ps[h * 64 + lane] = p;
    }
    LDS_FENCE();
    const bf16_t* vr = Y + (size_t)(b * SEQ + 64 * j) * LDY + offv + g * 64 + lane;
    for (int k = 0; k < 64; ++k) {
        const float v = bf2f(vr[(size_t)k * LDY]);
#pragma unroll
        for (int h = 0; h < 4; ++h) o[h] += ps[h * 64 + k] * v;
    }
    LDS_FENCE();
}

DEVI void phase_nsa(bf16_t* Y, const float* KCMP, const float* VCMP, float* lds) {
    const int tid = TIDX; const int bid = BIDX; const int lane = tid & 63, wv = tid >> 6, gw = bid * 8 + wv, ngw = gridDim.x * 8;
    float* qs = lds + wv * 1536;
    float* ps = qs + 256;
    float* pss = ps + 1024;
    for (int it = gw; it < MTOK * 2; it += ngw) {
        const int g = it & 1, m = it >> 1, b = m >> 12, t = m & (SEQ - 1);
        bf16_t* qrow = Y + (size_t)m * LDY + OFF_Q + g * 256;
        LDS_FENCE();
#pragma unroll
        for (int h = 0; h < 4; ++h) qs[h * 64 + lane] = bf2f(qrow[h * 64 + lane]) * 0.125f;
        LDS_FENCE();
        const int nvalid = (t >= 31) ? ((t - 31) / 16 + 1) : 0;
        float sc[4][4];
#pragma unroll
        for (int i = 0; i < 4; ++i) {
            const int n = lane + 64 * i;
#pragma unroll
            for (int h = 0; h < 4; ++h) sc[i][h] = -1e30f;
            if (n < nvalid) {
                const float* kp = KCMP + ((size_t)(b * 256 + n) * 2 + g) * 64;
                float s[4] = {0.f, 0.f, 0.f, 0.f};
#pragma unroll 4
                for (int d4 = 0; d4 < 16; ++d4) {
                    const f32x4 kv = *(const f32x4*)(kp + d4 * 4);
#pragma unroll
                    for (int h = 0; h < 4; ++h) { const f32x4 qa = *(const f32x4*)(qs + h * 64 + d4 * 4); s[h] += qa[0] * kv[0] + qa[1] * kv[1] + qa[2] * kv[2] + qa[3] * kv[3]; }
                }
#pragma unroll
                for (int h = 0; h < 4; ++h) sc[i][h] = s[h];
            }
        }
        float psum[4] = {0.f, 0.f, 0.f, 0.f};
#pragma unroll
        for (int h = 0; h < 4; ++h) {
            const float mxv = wave_max(fmaxf(fmaxf(sc[0][h], sc[1][h]), fmaxf(sc[2][h], sc[3][h])));
            float p[4], su = 0.f;
#pragma unroll
            for (int i = 0; i < 4; ++i) { p[i] = (lane + 64 * i < nvalid) ? __expf(sc[i][h] - mxv) : 0.f; su += p[i]; }
            su = wave_sum(su);
            const float inv = nvalid > 0 ? 1.f / su : 0.f;
#pragma unroll
            for (int i = 0; i < 4; ++i) { p[i] *= inv; ps[h * 256 + lane + 64 * i] = p[i]; psum[i] += p[i]; }
        }
#pragma unroll
        for (int i = 0; i < 4; ++i) pss[lane + 64 * i] = psum[i];
        LDS_FENCE();
        float oc[4] = {0.f, 0.f, 0.f, 0.f};
        for (int n = 0; n < nvalid; ++n) {
            const float v = VCMP[((size_t)(b * 256 + n) * 2 + g) * 64 + lane];
#pragma unroll
            for (int h = 0; h < 4; ++h) oc[h] += ps[h * 256 + n] * v;
        }
        const int j = lane, cur = t >> 6;
        float imp = pss[4 * j] + pss[4 * j + 1] + pss[4 * j + 2] + 0.5f * pss[4 * j + 3];
        if (j >= 1) imp += 0.5f * pss[4 * j - 1];
        LDS_FENCE();
        const bool forced = (j == 0) || (j == cur) || (j + 1 == cur);
        const bool cand = (j >= 1) && (j + 2 <= cur);
        const int nforced = cur == 0 ? 1 : (cur == 1 ? 2 : 3), quota = 16 - nforced;
        bool sel;
        if (cur - 2 <= quota) sel = forced || cand;
        else {
            int rank = 0;
            for (int jj = 1; jj <= cur - 2; ++jj) { const float v = __shfl(imp, jj); rank += ((v > imp) || (v == imp && jj < j)) ? 1 : 0; }
            sel = forced || (cand && rank < quota);
        }
        unsigned long long mask = __ballot(sel);
        float ms[4], ls[4], os[4];
#pragma unroll
        for (int h = 0; h < 4; ++h) { ms[h] = -1e30f; ls[h] = 0.f; os[h] = 0.f; }
        while (mask) {
            const int jb = __builtin_ctzll(mask); mask &= mask - 1;
            attend_block(Y, b, g, jb, t, 0, OFF_KS, OFF_VS, qs, ps, ms, ls, os, lane);
        }
        float mw[4], lw[4], ow[4];
#pragma unroll
        for (int h = 0; h < 4; ++h) { mw[h] = -1e30f; lw[h] = 0.f; ow[h] = 0.f; }
        const int lo = t - 511 > 0 ? t - 511 : 0;
        for (int jb = lo >> 6; jb <= cur; ++jb) attend_block(Y, b, g, jb, t, lo, OFF_KW, OFF_VW, qs, ps, mw, lw, ow, lane);
        const bf16_t* gp = Y + (size_t)m * LDY + OFF_NG + g * 12;
#pragma unroll
        for (int h = 0; h < 4; ++h) {
            const float gc = bf2f(gp[h * 3]), gs = bf2f(gp[h * 3 + 1]), gwn = bf2f(gp[h * 3 + 2]);
            const float o = gc * oc[h] + gs * os[h] / ls[h] + gwn * ow[h] / lw[h];
            qrow[h * 64 + lane] = f2bf(o);
        }
    }
}

DEVI float ld_sc1(const float* p) { return __hip_atomic_load(p, __ATOMIC_RELAXED, __HIP_MEMORY_SCOPE_AGENT); }
DEVI void router_finalize(int m, int t, const float* LOG, const float* bg, const float* be, int* cnt  , int* LIST, float* RW, volatile int* hist  ) {
    const float* lg = LOG + (size_t)m * 64;
    float gl[4];
#pragma unroll
    for (int o = 0; o < 4; ++o) gl[o] = ld_sc1(lg + o) + bg[o];
    int grp = 0; float gmax = gl[0];
#pragma unroll
    for (int o = 1; o < 4; ++o) if (gl[o] > gmax) { gmax = gl[o]; grp = o; }
    float gs = 0.f;
#pragma unroll
    for (int o = 0; o < 4; ++o) gs += __expf(gl[o] - gmax);
    const float pgrp = 1.f / gs;
    float el[8];
#pragma unroll
    for (int i = 0; i < 8; ++i) el[i] = ld_sc1(lg + 4 + grp * 8 + i) + be[grp * 8 + i];
    int i0 = 0; float m0 = el[0];
#pragma unroll
    for (int i = 1; i < 8; ++i) if (el[i] > m0) { m0 = el[i]; i0 = i; }
    int i1 = -1; float m1 = -3.0e38f;
#pragma unroll
    for (int i = 0; i < 8; ++i) if (i != i0 && el[i] > m1) { m1 = el[i]; i1 = i; }
    const float e1 = __expf(m1 - m0);
    const float w0 = pgrp / (1.f + e1), w1 = pgrp * e1 / (1.f + e1);
    const int ea = grp * 8 + i0, eb = grp * 8 + i1;
    if (t < 32) hist[t] = 0;
    __syncthreads();
    const bool act = t < 256;
    int ra = 0, rb = 0;
    if (act) { ra = atomicAdd((int*)hist + ea, 1); rb = atomicAdd((int*)hist + eb, 1); }
    __syncthreads();
    if (t < 32) hist[32 + t] = atomicAdd(cnt + t, hist[t]);
    __syncthreads();
    if (act) {
        LIST[ea * MTOK + hist[32 + ea] + ra] = m * 2;
        LIST[eb * MTOK + hist[32 + eb] + rb] = m * 2 + 1;
        RW[m * 2] = w0; RW[m * 2 + 1] = w1;
    }
}


struct NsaCtx {
    LAS3 unsigned char* lds;
    int tid, lane, r32, hi, w;
    unsigned okY, ovY, okC, ovC;
};
DEVI void nsa_dma(const NsaCtx& c, int slot, const bf16_t* kbase, const bf16_t* vbase, unsigned ok, unsigned ov) {
    __builtin_amdgcn_global_load_lds((const unsigned*)((const char*)kbase + ok), (LAS3 unsigned*)(c.lds + slot * 16384 + c.w * 1024), 16, 0, 0);
    __builtin_amdgcn_global_load_lds((const unsigned*)((const char*)vbase + ov), (LAS3 unsigned*)(c.lds + slot * 16384 + 8192 + c.w * 1024), 16, 0, 0);
}
#define NSA_WAIT_BAR(N) do { asm volatile("s_waitcnt vmcnt(" #N ")" ::: "memory"); __builtin_amdgcn_s_barrier(); asm volatile("" ::: "memory"); } while (0)
template <class NextFn, class SrcFn, class BodyFn>
DEVI void nsa_run(const NsaCtx& c, int& slot, int first, unsigned ok, unsigned ov, NextFn next, SrcFn srcf, BodyFn body) {
    int t0 = first, t1 = next(t0);
    { const bf16_t* kb; const bf16_t* vb; srcf(t0, kb, vb); nsa_dma(c, slot, kb, vb, ok, ov); }
    if (t1 >= 0) { const bf16_t* kb; const bf16_t* vb; srcf(t1, kb, vb); nsa_dma(c, slot == 2 ? 0 : slot + 1, kb, vb, ok, ov); }
#pragma unroll 1
    while (t0 >= 0) {
        if (t1 >= 0) NSA_WAIT_BAR(2); else NSA_WAIT_BAR(0);
        const int t2 = (t1 >= 0) ? next(t1) : -1;
        if (t2 >= 0) { const bf16_t* kb; const bf16_t* vb; srcf(t2, kb, vb); nsa_dma(c, slot == 0 ? 2 : slot - 1, kb, vb, ok, ov); }
        body(t0, slot);
        t0 = t1; t1 = t2; slot = slot == 2 ? 0 : slot + 1;
    }
}
DEVI void nsa_scores(const NsaCtx& c, int buf, const f32x16& z, f32x16& p0, f32x16& p1) {
    const LAS3 bf16x8* qfl = (const LAS3 bf16x8*)(c.lds + NSA_QF) + c.tid;
    const LAS3 unsigned char* kb = c.lds + buf * 16384 + c.r32 * 128;
    const int sw = (c.r32 >> 1) & 7;
#pragma unroll
    for (int s = 0; s < 4; ++s) {
        const bf16x8 k0 = *(const LAS3 bf16x8*)(kb + (((2 * s + c.hi) ^ sw) * 16));
        const bf16x8 k1 = *(const LAS3 bf16x8*)(kb + 4096 + (((2 * s + c.hi) ^ sw) * 16));
        if (s == 0) {
            const bf16x8 q = qfl[0]; p0 = __builtin_amdgcn_mfma_f32_32x32x16_bf16(k0, q, z, 0, 0, 0); p1 = __builtin_amdgcn_mfma_f32_32x32x16_bf16(k1, q, z, 0, 0, 0); }
        else { const bf16x8 q = qfl[s * 512]; p0 = __builtin_amdgcn_mfma_f32_32x32x16_bf16(k0, q, p0, 0, 0, 0); p1 = __builtin_amdgcn_mfma_f32_32x32x16_bf16(k1, q, p1, 0, 0, 0); }
    }
}
DEVI unsigned nsa_pk(float lo, float hi) { return pg8::cvt_pk_bf16(lo, hi); }
DEVI void nsa_pack(const f32x16& p0, const f32x16& p1, bf16x8 (&pa)[4]) {
#pragma unroll
    for (int s = 0; s < 4; ++s) {
        const f32x16& p = (s < 2) ? p0 : p1; const int b = (s & 1) * 8;
        uint4 w; w.x = nsa_pk(p[b], p[b + 1]); w.y = nsa_pk(p[b + 2], p[b + 3]); w.z = nsa_pk(p[b + 4], p[b + 5]); w.w = nsa_pk(p[b + 6], p[b + 7]);
        pa[s] = __builtin_bit_cast(bf16x8, w);
    }
}
DEVI void nsa_pv(const NsaCtx& c, int buf, const bf16x8 (&pa)[4], f32x16 (&o)[2]) {
    const unsigned vb = (unsigned)(uintptr_t)(c.lds + buf * 16384 + 8192 + (4 * c.hi + ((c.lane & 15) >> 2)) * 64 + ((c.lane >> 4) & 1) * 32 + (c.lane & 3) * 8);
#pragma unroll
    for (int d0 = 0; d0 < 2; ++d0) {
        s16x4 lo[4], hi[4];
#pragma unroll
        for (int s = 0; s < 4; ++s) {
            asm volatile("ds_read_b64_tr_b16 %0, %1 offset:%c2" : "=&v"(lo[s]) : "v"(vb), "i"(d0 * 4096 + s * 1024) : "memory");
            asm volatile("ds_read_b64_tr_b16 %0, %1 offset:%c2" : "=&v"(hi[s]) : "v"(vb), "i"(d0 * 4096 + s * 1024 + 512) : "memory");
        }
        asm volatile("s_waitcnt lgkmcnt(0)" ::: "memory");
        __builtin_amdgcn_sched_barrier(0);
#pragma unroll
        for (int s = 0; s < 4; ++s)
            o[d0] = __builtin_amdgcn_mfma_f32_32x32x16_bf16((bf16x8){lo[s][0], lo[s][1], lo[s][2], lo[s][3], hi[s][0], hi[s][1], hi[s][2], hi[s][3]}, pa[s], o[d0], 0, 0, 0);
    }
}
typedef float f32x2v __attribute__((ext_vector_type(2)));
DEVI void nsa_exp_all(f32x16& p0, f32x16& p1) {
#pragma unroll
    for (int r = 0; r < 16; ++r) { p0[r] = __builtin_amdgcn_exp2f(p0[r]); p1[r] = __builtin_amdgcn_exp2f(p1[r]); }
}
DEVI float nsa_rowsum(const f32x16& p0, const f32x16& p1) {
    f32x2v a = {p0[0], p0[1]}, b = {p1[0], p1[1]};
#pragma unroll
    for (int r = 2; r < 16; r += 2) { a += (f32x2v){p0[r], p0[r + 1]}; b += (f32x2v){p1[r], p1[r + 1]}; }
    a += b; return a[0] + a[1];
}
DEVI void nsa_fill(f32x16& z, float v) {
#pragma unroll
    for (int r = 0; r < 16; ++r) z[r] = v;
    asm volatile("" : "+v"(z));
}
DEVI float nsa_msel(bool dead, float e) { return __uint_as_float(__float_as_uint(e) & (dead ? 0u : 0xffffffffu)); }
DEVI void nsa_unit(bf16_t* Y, const bf16_t* KCB, const bf16_t* VCB, int b, int g, int qt, const NsaCtx& c, const float (&bnd)[3], int& slot) {
    const int w = c.w, tq = 8 * w + (c.r32 >> 2), head = c.r32 & 3, t = 64 * qt + tq;
    const size_t m = (size_t)b * SEQ + t;
    bf16_t* qrow = Y + m * LDY + OFF_Q + (g * 4 + head) * 64;
    {   LAS3 bf16x8* qfl = (LAS3 bf16x8*)(c.lds + NSA_QF) + c.tid;
#pragma unroll
        for (int s = 0; s < 4; ++s) qfl[s * 512] = *(const bf16x8*)(qrow + 16 * s + 8 * c.hi);
    }
    const bf16_t* gp = Y + m * LDY + OFF_NG + (g * 4 + head) * 3;
    const float gate_c = bf2f(gp[0]), gate_s = bf2f(gp[1]), gate_w = bf2f(gp[2]);
    LAS3 float* outl = (LAS3 float*)(c.lds + NSA_OUT) + c.tid;
    f32x16 p0, p1, o[2]; bf16x8 pa[4];

    const int nmax = (t - 31) >> 4;
    const int ntc = (((64 * qt + 32) >> 4) >> 6) + 1;
    const bf16_t* kc = KCB + (size_t)((b * 2 + g) * 256) * 64; const bf16_t* vc = VCB + (size_t)((b * 2 + g) * 256) * 64;
    auto cmp_next = [&](int ct) { return ct + 1 < ntc ? ct + 1 : -1; };
    auto cmp_src = [&](int ct, const bf16_t*& kb, const bf16_t*& vb) { kb = kc + (size_t)ct * 4096; vb = vc + (size_t)ct * 4096; };
    float lc = 0.f;
#pragma unroll
    for (int d0 = 0; d0 < 2; ++d0)
#pragma unroll
        for (int r = 0; r < 16; ++r) o[d0][r] = 0.f;
    f32x16 zb; nsa_fill(zb, -bnd[0]);
    nsa_run(c, slot, 0, c.okC, c.ovC, cmp_next, cmp_src, [&](int ct, int buf) {
        nsa_scores(c, buf, zb, p0, p1);
        nsa_exp_all(p0, p1);
        if (!__all(64 * ct + 63 <= nmax)) {
#pragma unroll
            for (int r = 0; r < 16; ++r) { const int n0 = 64 * ct + crow16(r, c.hi); p0[r] = nsa_msel(n0 > nmax, p0[r]); p1[r] = nsa_msel(n0 + 32 > nmax, p1[r]); }
        }
        lc += nsa_rowsum(p0, p1);
        nsa_pack(p0, p1, pa);
        nsa_pv(c, buf, pa, o);
    });
    lc = half_sum(lc);
    const float invc = lc > 0.f ? 1.f / lc : 0.f;
    {   const float sc_ = gate_c * invc;
#pragma unroll
        for (int d0 = 0; d0 < 2; ++d0)
#pragma unroll
            for (int r = 0; r < 16; ++r) outl[(d0 * 16 + r) * 512] = o[d0][r] * sc_;
    }
    unsigned msk0, msk1;
    if (qt < 16) { msk0 = (2u << qt) - 1u; msk1 = 0u; }
    else {
#pragma unroll
        for (int d0 = 0; d0 < 2; ++d0)
#pragma unroll
            for (int r = 0; r < 16; ++r) o[d0][r] = 0.f;
        nsa_run(c, slot, 0, c.okC, c.ovC, cmp_next, cmp_src, [&](int ct, int buf) {
            nsa_scores(c, buf, zb, p0, p1);
            nsa_exp_all(p0, p1);
            if (!__all(64 * ct + 63 <= nmax)) {
#pragma unroll
                for (int r = 0; r < 16; ++r) { const int n0 = 64 * ct + crow16(r, c.hi); p0[r] = nsa_msel(n0 > nmax, p0[r]); p1[r] = nsa_msel(n0 + 32 > nmax, p1[r]); }
            }
            nsa_pack(p0, p1, pa);
#pragma unroll
            for (int s = 0; s < 4; ++s)
#pragma unroll
                for (int jb = 0; jb < 2; ++jb) {
                    if (!(jb == (ct >> 1) || (s == 3 && (ct & 1) && jb == (ct >> 1) + 1))) continue;
                    const int j = 32 * jb + c.r32, jn0 = 16 * ct + 4 * s + c.hi, jn1 = jn0 + 2;
                    uint4 wv;
                    wv.x = (jn0 == j) ? 0x3F803F80u : 0u; wv.y = (jn0 == j) ? 0x3F003F80u : ((jn0 + 1 == j) ? 0x3F000000u : 0u);
                    wv.z = (jn1 == j) ? 0x3F803F80u : 0u; wv.w = (jn1 == j) ? 0x3F003F80u : ((jn1 + 1 == j) ? 0x3F000000u : 0u);
                    o[jb] = __builtin_amdgcn_mfma_f32_32x32x16_bf16(__builtin_bit_cast(bf16x8, wv), pa[s], o[jb], 0, 0, 0);
                }
        });
        unsigned key[2][16];
#pragma unroll
        for (int jb = 0; jb < 2; ++jb)
#pragma unroll
            for (int r = 0; r < 16; ++r) {
                float v = o[jb][r] * invc;
                v += shx(v, 1); v += shx(v, 2);
                const int j = 32 * jb + crow16(r, c.hi);
                const bool cand = (j >= 1) && (j + 2 <= qt);
                key[jb][r] = cand ? ((__float_as_uint(fmaxf(v, 0.f)) & ~63u) | (unsigned)(63 - j)) : 0u;
            }
        unsigned thr = 0u;
#pragma unroll 1
        for (int bit = 30; bit >= 0; --bit) {
            const unsigned tt = thr | (1u << bit);
            int cnt = 0;
#pragma unroll
            for (int jb = 0; jb < 2; ++jb)
#pragma unroll
                for (int r = 0; r < 16; ++r) cnt += (key[jb][r] >= tt) ? 1 : 0;
            cnt = half_addi(cnt);
            thr = (cnt >= 13) ? tt : thr;
        }
        unsigned w0 = 0u, w1 = 0u;
#pragma unroll
        for (int r = 0; r < 16; ++r) {
            const int bitpos = (r & 3) + 8 * (r >> 2);
            w0 |= ((key[0][r] != 0u && key[0][r] >= thr) ? 1u : 0u) << bitpos;
            w1 |= ((key[1][r] != 0u && key[1][r] >= thr) ? 1u : 0u) << bitpos;
        }
        w0 <<= 4 * c.hi; w1 <<= 4 * c.hi;
        msk0 = half_or(w0); msk1 = half_or(w1);
        msk0 |= 1u;
        if (qt < 32) msk0 |= (3u << (qt - 1)); else if (qt == 32) { msk0 |= 0x80000000u; msk1 |= 1u; } else msk1 |= (3u << (qt - 33));
    }
    unsigned u0 = msk0, u1 = msk1;
    u0 |= shxu(u0, 4); u1 |= shxu(u1, 4); u0 |= shxu(u0, 8); u1 |= shxu(u1, 8); u0 |= shxu(u0, 16); u1 |= shxu(u1, 16);
    LAS3 unsigned* misc = (LAS3 unsigned*)(c.lds + NSA_MISC);
    if (c.lane == 0) { misc[2 * w] = u0; misc[2 * w + 1] = u1; }
    asm volatile("s_waitcnt lgkmcnt(0)" ::: "memory"); __builtin_amdgcn_s_barrier(); asm volatile("" ::: "memory");
    u0 = 0u; u1 = 0u;
#pragma unroll
    for (int i = 0; i < 8; ++i) { u0 |= misc[2 * i]; u1 |= misc[2 * i + 1]; }
    const unsigned long long um = ((unsigned long long)(unsigned)__builtin_amdgcn_readfirstlane(u1) << 32) | (unsigned)__builtin_amdgcn_readfirstlane(u0);
    const unsigned long long mym = ((unsigned long long)msk1 << 32) | msk0;

    {
        const bf16_t* kb0 = Y + (size_t)b * SEQ * LDY + OFF_KS + g * 64; const bf16_t* vb0 = Y + (size_t)b * SEQ * LDY + OFF_VS + g * 64;
        float ls = 0.f;
#pragma unroll
        for (int d0 = 0; d0 < 2; ++d0)
#pragma unroll
            for (int r = 0; r < 16; ++r) o[d0][r] = 0.f;
        nsa_fill(zb, -bnd[1]);
        nsa_run(c, slot, 0, c.okY, c.ovY,
                [&](int j) { const unsigned long long rest = (j >= 63) ? 0ull : (um >> (j + 1)); return rest ? j + 1 + (int)__builtin_ctzll(rest) : -1; },
                [&](int j, const bf16_t*& kb, const bf16_t*& vb) { kb = kb0 + (size_t)j * 64 * LDY; vb = vb0 + (size_t)j * 64 * LDY; },
                [&](int j, int buf) {
            nsa_scores(c, buf, zb, p0, p1);
            nsa_exp_all(p0, p1);
            const bool keep = (mym >> j) & 1ull;
            if (j == qt) {
#pragma unroll
                for (int r = 0; r < 16; ++r) { const int kv = crow16(r, c.hi); p0[r] = nsa_msel(kv > tq, p0[r]); p1[r] = nsa_msel(kv + 32 > tq, p1[r]); }
            }
            ls += keep ? nsa_rowsum(p0, p1) : 0.f;
            nsa_pack(p0, p1, pa);
            {   const unsigned km = keep ? 0xffffffffu : 0u;
#pragma unroll
                for (int s = 0; s < 4; ++s) { uint4 w = __builtin_bit_cast(uint4, pa[s]); w.x &= km; w.y &= km; w.z &= km; w.w &= km; pa[s] = __builtin_bit_cast(bf16x8, w); }
            }
            nsa_pv(c, buf, pa, o);
        });
        ls = half_sum(ls);
        const float sc_ = ls > 0.f ? gate_s / ls : 0.f;
#pragma unroll
        for (int d0 = 0; d0 < 2; ++d0)
#pragma unroll
            for (int r = 0; r < 16; ++r) outl[(d0 * 16 + r) * 512] += o[d0][r] * sc_;
    }
    {
        const bf16_t* kb0 = Y + (size_t)b * SEQ * LDY + OFF_KW + g * 64; const bf16_t* vb0 = Y + (size_t)b * SEQ * LDY + OFF_VW + g * 64;
        float lw = 0.f;
#pragma unroll
        for (int d0 = 0; d0 < 2; ++d0)
#pragma unroll
            for (int r = 0; r < 16; ++r) o[d0][r] = 0.f;
        const int jlo = qt - 8 > 0 ? qt - 8 : 0;
        nsa_fill(zb, -bnd[2]);
        nsa_run(c, slot, qt, c.okY, c.ovY,
                [&](int j) { return j > jlo ? j - 1 : -1; },
                [&](int j, const bf16_t*& kb, const bf16_t*& vb) { kb = kb0 + (size_t)j * 64 * LDY; vb = vb0 + (size_t)j * 64 * LDY; },
                [&](int j, int buf) {
            nsa_scores(c, buf, zb, p0, p1);
            nsa_exp_all(p0, p1);
            if (j == qt || j == qt - 8) {
                const int hi_lim = (j == qt) ? tq : 64, lo_lim = (j == qt - 8) ? tq + 1 : 0;
#pragma unroll
                for (int r = 0; r < 16; ++r) { const int kv = crow16(r, c.hi); p0[r] = nsa_msel((kv > hi_lim) || (kv < lo_lim), p0[r]); p1[r] = nsa_msel((kv + 32 > hi_lim) || (kv + 32 < lo_lim), p1[r]); }
            }
            lw += nsa_rowsum(p0, p1);
            nsa_pack(p0, p1, pa);
            nsa_pv(c, buf, pa, o);
        });
        lw = half_sum(lw);
        const float sc_ = lw > 0.f ? gate_w / lw : 0.f;
#pragma unroll
        for (int d0 = 0; d0 < 2; ++d0)
#pragma unroll
            for (int r = 0; r < 16; ++r) o[d0][r] = outl[(d0 * 16 + r) * 512] + o[d0][r] * sc_;
    }
#pragma unroll
    for (int d0 = 0; d0 < 2; ++d0)
#pragma unroll
        for (int gi = 0; gi < 4; ++gi) {
            uint2 wv; wv.x = pk2(o[d0][4 * gi], o[d0][4 * gi + 1]); wv.y = pk2(o[d0][4 * gi + 2], o[d0][4 * gi + 3]);
            *(uint2*)(qrow + (OFF_RX - OFF_Q) + 32 * d0 + 8 * gi + 4 * c.hi) = wv;
        }
}

DEVI void phase_nsa_fast(bf16_t* Y, const bf16_t* KCB, const bf16_t* VCB, const float* qn  , const float* kn  , LAS3 unsigned char* lds) {
    float bnd[3];
    {   const int l0 = TIDX & 63;
        const float gq = wave_max(fabsf(qn[l0]));
#pragma unroll
        for (int i = 0; i < 3; ++i) bnd[i] = __uint_as_float(__builtin_amdgcn_readfirstlane(__float_as_uint(64.f * 1.02f * 0.125f * 1.4426950408889634f * gq * wave_max(fabsf(kn[i * 64 + l0])))));
    }
    NsaCtx c; c.lds = lds; c.tid = TIDX; c.lane = c.tid & 63; c.r32 = c.lane & 31; c.hi = c.lane >> 5; c.w = __builtin_amdgcn_readfirstlane(c.tid >> 6);
    {   const int l = c.lane, w = c.w;
        const int rk = 8 * w + (l >> 3), ck = (l & 7) ^ ((rk >> 1) & 7);
        const int rv = 16 * (w & 3) + (l >> 2), cv = (w >> 2) * 4 + (l & 3);
        c.okY = (unsigned)(rk * LDY + ck * 8) * 2u; c.ovY = (unsigned)(rv * LDY + cv * 8) * 2u;
        c.okC = (unsigned)(rk * 64 + ck * 8) * 2u;  c.ovC = (unsigned)(rv * 64 + cv * 8) * 2u;
    }
    const int bid = BIDX;
    int slot = 0;
    for (int u0 = bid; u0 < 256; u0 += gridDim.x) {
        const int u = (gridDim.x == 256) ? ((u0 & 7) * 32 + (u0 >> 3)) : u0;
        const int bg = u >> 5, k = u & 31;
#pragma unroll 1
        for (int h2 = 0; h2 < 2; ++h2) nsa_unit(Y, KCB, VCB, bg >> 1, bg & 1, h2 ? k : 63 - k, c, bnd, slot);
    }
    asm volatile("s_waitcnt vmcnt(0) lgkmcnt(0)" ::: "memory"); __builtin_amdgcn_s_barrier();
}

#define XB_TMO      128
#define XB_XCNT(j)  (256  + 64 * (j))
#define XB_XSUB(j)  (1280 + 64 * (j))
#define XB_XGEN(j)  (2304 + 64 * (j))
#define XB_TOP      3328
#define XB_TOPGEN   3392
#define XCD_BAR_WORDS 3456
#define XB_SPIN_CAP (1u << 18)
DEVI unsigned xb_ld(unsigned* p)              { return __hip_atomic_load(p, __ATOMIC_RELAXED, __HIP_MEMORY_SCOPE_AGENT); }
DEVI unsigned xb_add(unsigned* p, unsigned v) { return __hip_atomic_fetch_add(p, v, __ATOMIC_RELAXED, __HIP_MEMORY_SCOPE_AGENT); }
DEVI unsigned xb_xcc_id() { return (unsigned)__builtin_amdgcn_s_getreg((3 << 11) | 20) & 0xFu; }
#define XB_SPIN(cond, bar) do { unsigned _sp = 0; while (cond) { __builtin_amdgcn_s_sleep(1); \
    if ((++_sp & 255u) == 0u) { if (xb_ld(&(bar)[XB_TMO])) break; if (_sp > XB_SPIN_CAP) { atomicAdd(&(bar)[XB_TMO], 1u); break; } } } } while (0)
struct XcdBarrier { unsigned* bar; unsigned x; volatile LAS3 unsigned* st; };
DEVI XcdBarrier xcd_barrier_post(unsigned* bar, volatile LAS3 unsigned* st) {
    XcdBarrier b; b.bar = bar; b.x = xb_xcc_id(); b.st = st;
    if (threadIdx.x == 0) (void)xb_add(&bar[XB_XCNT(b.x)], 1u);
    return b;
}
DEVI void xcd_barrier_complete(unsigned* bar, unsigned x, unsigned& nloc, unsigned& nx) {
    const unsigned G = gridDim.x * gridDim.y * gridDim.z;
    unsigned sum, cnt, mine, sp = 0u;
    for (;;) {
        sum = 0u; cnt = 0u; mine = 0u;
#pragma unroll
        for (unsigned j = 0; j < 16; ++j) { const unsigned c = xb_ld(&bar[XB_XCNT(j)]); sum += c; cnt += (c > 0u) ? 1u : 0u; mine = (j == x) ? c : mine; }
        if (sum == G) break;
        __builtin_amdgcn_s_sleep(1);
        if ((++sp & 255u) == 0u) { if (xb_ld(&bar[XB_TMO])) break; if (sp > XB_SPIN_CAP) { atomicAdd(&bar[XB_TMO], 1u); break; } }
    }
    nloc = mine > 0u ? mine : 1u; nx = cnt > 0u ? cnt : 1u;
}
DEVI void xcd_barrier(const XcdBarrier& b) {
    asm volatile("s_waitcnt vmcnt(0)" ::: "memory");
    __syncthreads();
    if (threadIdx.x == 0) {
        unsigned* bar = b.bar;
        __builtin_amdgcn_s_waitcnt(0);
        unsigned nloc = b.st[0], nx = b.st[1];
        if (nloc == 0u) { xcd_barrier_complete(bar, b.x, nloc, nx); b.st[0] = nloc; b.st[1] = nx; }
        const unsigned old = xb_add(&bar[XB_XSUB(b.x)], 1u);
        const unsigned gen = old / nloc;
        if (old + 1u == (gen + 1u) * nloc) {
            __builtin_amdgcn_fence(__ATOMIC_RELEASE, "agent");
            asm volatile("s_waitcnt vmcnt(0)" ::: "memory");
            const unsigned og = xb_add(&bar[XB_TOP], 1u);
            const unsigned tg = og / nx;
            if (og + 1u == (tg + 1u) * nx) xb_add(&bar[XB_TOPGEN], 1u);
            else XB_SPIN(xb_ld(&bar[XB_TOPGEN]) == tg, bar);
            __builtin_amdgcn_fence(__ATOMIC_ACQUIRE, "agent");
            xb_add(&bar[XB_XGEN(b.x)], 1u);
            asm volatile("s_waitcnt vmcnt(0)" ::: "memory");
        } else {
            XB_SPIN(xb_ld(&bar[XB_XGEN(b.x)]) == gen, bar);
            __builtin_amdgcn_fence(__ATOMIC_ACQUIRE, "agent");
            asm volatile("s_waitcnt vmcnt(0)" ::: "memory");
        }
    }
    __syncthreads();
}

constexpr int LDS_BYTES = 160 * 1024;
constexpr int LDS_PTRS = 151552;
DEVI const void* lds_ptr(const LAS3 unsigned char* lds, int i) {
    const unsigned long long v = ((const LAS3 unsigned long long*)(lds + LDS_PTRS))[i];
    const unsigned lo = __builtin_amdgcn_readfirstlane((unsigned)v), hi = __builtin_amdgcn_readfirstlane((unsigned)(v >> 32));
    return (const void*)(((unsigned long long)hi << 32) | lo);
}
#ifndef PHMASK
#define PHMASK 0xffffffffu
#endif
__global__ void __launch_bounds__(512, 2) fwd_kernel(Params p) {
    extern __shared__ __attribute__((aligned(16))) unsigned char lds[];
    cg::grid_group grid = cg::this_grid();
    unsigned char* ws = p.ws;
    int* CNT = (int*)(ws + WS_CNT);
    float* RSTD = (float*)(ws + WS_RSTD); float* SS = (float*)(ws + WS_SS); float* LOG = (float*)(ws + WS_LOG); bf16_t* WRT = (bf16_t*)(ws + WS_WRT); bf16_t* W1T = (bf16_t*)(ws + WS_W1T); bf16_t* W2T = (bf16_t*)(ws + WS_W2T); float* BPE = (float*)(ws + WS_BPE);
    float* PA = (float*)(ws + WS_PA); float* PH = (float*)(ws + WS_PH);
    float* KCMP = (float*)(ws + WS_KCMP); float* VCMP = (float*)(ws + WS_VCMP); float* HID = (float*)(ws + WS_HID);
    float* RW = (float*)(ws + WS_RW); int* LIST = (int*)(ws + WS_LIST);
    bf16_t* KCB = (bf16_t*)(ws + WS_KCB); bf16_t* VCB = (bf16_t*)(ws + WS_VCB);
    bf16_t* WIN = (bf16_t*)(ws + WS_WIN); bf16_t* WBR = (bf16_t*)(ws + WS_WBR); bf16_t* WO = (bf16_t*)(ws + WS_WO);
    bf16_t* Y = (bf16_t*)(ws + WS_Y); float* LA = (float*)p.out; bf16_t* VV = (bf16_t*)((unsigned char*)p.out + 32 * MiB);
    bf16_t* XB = (bf16_t*)(ws + WS_XB);
    bf16_t* WGU = (bf16_t*)(ws + WS_WGU); bf16_t* WD = (bf16_t*)(ws + WS_WD); bf16_t* XG = (bf16_t*)(ws + WS_XG); bf16_t* HM = (bf16_t*)(ws + WS_HM);
    int* TOKS = (int*)(ws + WS_TOKS); float* RWS = (float*)(ws + WS_RWS); bf16_t* YS = (bf16_t*)(ws + WS_YS);
    bf16_t* As = (bf16_t*)lds; bf16_t* Bs = As + 128 * GLD;
    float* ldsf = (float*)lds;
    int* tb = (int*)(lds + 131072);
    LAS3 unsigned char* lds3 = (LAS3 unsigned char*)lds;
    const int G = gridDim.x;
    {   LAS3 unsigned long long* ptab = (LAS3 unsigned long long*)(lds3 + LDS_PTRS);
        if (threadIdx.x == 0) {
#pragma unroll
            for (int i = 0; i < 30; ++i) ptab[i] = (unsigned long long)p.in[i];
            ptab[30] = (unsigned long long)p.out;
        }
        if (threadIdx.x == 0) { ((volatile LAS3 unsigned*)(lds3 + LDS_PTRS + 256))[0] = 0u; ((volatile LAS3 unsigned*)(lds3 + LDS_PTRS + 256))[1] = 0u; }
        __syncthreads();
    }
    const XcdBarrier xbar = xcd_barrier_post((unsigned*)(ws + WS_BAR), (volatile LAS3 unsigned*)(lds3 + LDS_PTRS + 256));
#define INP(i) ((const float*)lds_ptr(lds3, (i)))
#define OUTP ((float*)lds_ptr(lds3, 30))

    if (PHMASK & (1u << 0)) phase_prep(p, WIN, WBR, WO, WRT, W1T, W2T, BPE, ldsf);

    for (int l = 0; l < DEPTH; ++l) {
        if (l == 0) { if (PHMASK & (1u << 1)) phase_xb(INP(0), RSTD, XB); }
        if (l == 0) grid.sync();
        if (PHMASK & (1u << 2)) { pg8::Gemm g{XB, WIN + (size_t)l * LDY * DM, DM, DM, DM}; pg8::StaticOrder S; S.init(MTOK, LDY, G, BIDX); EpiInproj E{Y, RSTD, INP(15) + l * 64, INP(16) + l * 192};
          pg8::gemm_phase<EpiInproj, pg8::StaticOrder>(lds3, g, S, E);
        }
        xcd_barrier(xbar);
        {
            const int bid_ = BIDX;
            if (bid_ < 16) {
                pg8::Gemm g{Y, W1T + (size_t)l * 256 * 2048, 2048, 16 * LDY, 2048, LDY * 2, 128}; CmpOrder S{G, bid_}; EpiCmp1 E{(bf16_t*)HID, BPE + l * 256};
                pg8::gemm_phase<EpiCmp1, CmpOrder>(lds3, g, S, E);
                asm volatile("s_waitcnt vmcnt(0)" ::: "memory"); __syncthreads();
                cmp2_unit((const bf16_t*)HID, W2T + (size_t)l * 2 * 64 * 128, INP(14) + l * 128, INP(16) + l * 192, KCB, VCB, bid_ >> 3, (bid_ >> 2) & 1, bid_ & 3);
            } else {
                phase_rglru1(Y, INP(3) + l * 2048, INP(4) + l * 512, INP(5) + l * 32768, INP(6) + l * 512, INP(7) + l * 32768, INP(8) + l * 512, INP(9) + l * 512,
                             LA, VV, PA, PH, ldsf, bid_ - 16, G - 16);
                phase_shortconv(Y, INP(17) + l * 1536, bid_ - 16, G - 16);
            }
        }
        xcd_barrier(xbar);
        if (PHMASK & (1u << 8)) phase_rglru2(Y, LA, VV, PA, PH);
#if NSA_FAST
        if (PHMASK & (1u << 9)) phase_nsa_fast(Y, KCB, VCB, INP(15) + l * 64, INP(16) + l * 192, lds3);
#else
        if (PHMASK & (1u << 9)) phase_nsa(Y, KCMP, VCMP, ldsf);
#endif
        xcd_barrier(xbar);
        if (PHMASK & (1u << 10)) {
            pg8::Gemm g{Y, WBR + (size_t)l * 3 * DM * 512, 512, LDY, 512}; MergeOrder S; S.so.init(MTOK, DM, G, BIDX); EpiMerge E{Y};
            pg8::gemm_phase<EpiMerge, MergeOrder>(lds3, g, S, E);
        }
        xcd_barrier(xbar);
        if (PHMASK & (1u << 11)) { pg8::Gemm g{Y + OFF_SC, WO + (size_t)l * DM * DM, DM, LDY, DM}; pg8::StaticOrder S; S.init(MTOK, DM, G, BIDX); EpiOut E{XB, SS + (size_t)l * MTOK * 16};
          pg8::gemm_phase<EpiOut, pg8::StaticOrder>(lds3, g, S, E); }
        xcd_barrier(xbar);
        if (PHMASK & (1u << 12)) {
            pg8::Gemm g{XB, WRT + (size_t)l * 256 * DM, DM, DM, DM}; pg8::StaticOrder S; S.init(MTOK, 256, G, BIDX); EpiRouter E{LOG, SS + (size_t)l * MTOK * 16};
            pg8::gemm_phase<EpiRouter, pg8::StaticOrder>(lds3, g, S, E);
            pg8::Unit u;
            if (S.next(0, u)) {
                asm volatile("s_waitcnt vmcnt(0)" ::: "memory"); __syncthreads();
                const int t_ = TIDX;
                router_finalize(u.pm * 256 + (t_ & 255), t_, LOG, INP(24) + l * 4, INP(26) + l * 32, CNT + l * 32, LIST, RW, (volatile int*)(lds + LDS_ROWT));
            }
        }
        if (PHMASK & (1u << 13)) phase_moe_prep(INP(27) + (size_t)l * NEXP * DM * 256, INP(28) + (size_t)l * NEXP * DM * 256, INP(29) + (size_t)l * NEXP * 256 * DM, INP(22) + l * DM, WGU, WD, ldsf);
        xcd_barrier(xbar);
        if (PHMASK & (1u << 15)) {
            int* tokl = (int*)(lds + LDS_ROWT); float* wl = (float*)(lds + LDS_ROWT + 2048); float* rsl = (float*)(lds + LDS_ROWT + 4096);
            const int bid_ = BIDX;
            moe_tables(CNT + l * 32, tb);
            const int R = moe_rounds(tb, G, 2);
#pragma unroll 1
            for (int r = 0; r < R; ++r) {
                MoeUpOrder S{tb, G, bid_, r, tokl};
                moe_up_setup(CNT + l * 32, LIST, RW, SS + (size_t)l * MTOK * 16, TOKS, S, tokl, wl, rsl);
                pg8::Gemm g{XB, WGU, DM, DM, DM}; EpiMoeUp E{HM, wl, rsl};
                pg8::gemm_phase<EpiMoeUp, MoeUpOrder, true>(lds3, g, S, E);
            }
        }
        xcd_barrier(xbar);
        if (PHMASK & (1u << 16)) { pg8::Gemm g{HM, WD, 256, 256, 256}; MoeOrder S{tb, 4, G, BIDX}; EpiMoeDown E{YS, TOKS};
          pg8::gemm_phase<EpiMoeDown, MoeOrder>(lds3, g, S, E); }
        xcd_barrier(xbar);
        if (PHMASK & (1u << 17)) phase_combine(XB, YS, RSTD, OUTP, l + 1 < DEPTH);
        if (l + 1 < DEPTH) xcd_barrier(xbar);
    }
}

extern "C" void kernel_launch(void* const* d_in, const int* in_sizes, int n_in, void* d_out, int out_size, void* d_ws, size_t ws_size, hipStream_t stream) {
    static int grid = 0;
    if (grid == 0) {
        if (n_in != 30 || out_size != MTOK * DM || ws_size < WS_TOTAL) { fprintf(stderr, "kernel_launch: unexpected sizes n_in=%d out=%d ws=%zu\n", n_in, out_size, ws_size); grid = -1; return; }
        int dev = 0, cus = 0, per_cu = 0;
        hipGetDevice(&dev);
        hipDeviceGetAttribute(&cus, hipDeviceAttributeMultiprocessorCount, dev);
        hipFuncSetAttribute((const void*)fwd_kernel, hipFuncAttributeMaxDynamicSharedMemorySize, LDS_BYTES);
        hipOccupancyMaxActiveBlocksPerMultiprocessor(&per_cu, (const void*)fwd_kernel, 512, LDS_BYTES);
        (void)hipGetLastError();
        if (per_cu < 1) { fprintf(stderr, "kernel_launch: occupancy query says %d blocks/CU\n", per_cu); grid = -1; return; }
        grid = cus;
    }
    if (grid < 0) return;
    hipMemsetAsync(d_ws, 0, WS_ZERO_BYTES, stream);
    Params p{};
    for (int i = 0; i < 30; ++i) p.in[i] = (const float*)d_in[i];
    p.out = (float*)d_out; p.ws = (unsigned char*)d_ws;
    void* args[] = {&p};
    hipError_t e = hipLaunchCooperativeKernel((const void*)fwd_kernel, dim3(grid), dim3(512), args, LDS_BYTES, stream);
    if (e != hipSuccess) fprintf(stderr, "cooperative launch failed: %s (grid %d)\n", hipGetErrorString(e), grid);
}
```

```cpp
#include <hip/hip_runtime.h>
#include <hip/hip_cooperative_groups.h>
#include <cstdio>
#include <cstdint>
namespace cg = cooperative_groups;

typedef unsigned short bf16_t;
typedef short bf16x8 __attribute__((ext_vector_type(8)));
typedef float f32x4 __attribute__((ext_vector_type(4)));
#define DEVI __device__ __forceinline__

constexpr int DM = 1024, NB = 4, SEQ = 4096, MTOK = NB * SEQ, DEPTH = 2;
constexpr int INW = 6936;
constexpr int LDY = 7168;
constexpr int OFF_RX = 0, OFF_RY = 512, OFF_Q = 1024, OFF_KC = 1536, OFF_VC = 1664, OFF_KS = 1792, OFF_VS = 1920,
              OFF_KW = 2048, OFF_VW = 2176, OFF_SB = 2304, OFF_SC = 2816, OFF_SH = 3328, OFF_MG = 3840, OFF_NG = 6912, OFF_END = 6936;
constexpr int NCMP = 255;
constexpr float RMS_EPS = 1e-6f;
constexpr int NEXP = 32;

constexpr size_t KiB = 1024, MiB = 1024 * 1024;
constexpr size_t WS_CNT = 0;
constexpr size_t WS_BAR = 16 * KiB;
constexpr size_t WS_ZERO_BYTES = 32 * KiB;
constexpr size_t WS_SS = 13 * MiB;
constexpr size_t WS_RSTD = 192 * KiB;
constexpr size_t WS_PA = 512 * KiB;
constexpr size_t WS_PH = 1024 * KiB;
constexpr size_t WS_KCMP = 2 * MiB;
constexpr size_t WS_VCMP = 2 * MiB + 512 * KiB;
constexpr size_t WS_HID = 3 * MiB;
constexpr size_t WS_RW = 5 * MiB;
constexpr size_t WS_LIST = 6 * MiB;
constexpr size_t WS_KCB = 8 * MiB;
constexpr size_t WS_VCB = 8 * MiB + 256 * KiB;
constexpr size_t WS_LOG = 9 * MiB;
constexpr size_t WS_WIN = 16 * MiB;
constexpr size_t WS_WBR = 44 * MiB;
constexpr size_t WS_WO = 50 * MiB;
constexpr size_t WS_W1T = 54 * MiB;
constexpr size_t WS_W2T = 320 * KiB;
constexpr size_t WS_BPE = 256 * KiB;
constexpr size_t WS_WRT = 15 * MiB;
constexpr size_t WS_Y = 56 * MiB;
constexpr size_t WS_LA = 280 * MiB;
constexpr size_t WS_VV = 312 * MiB;
constexpr size_t WS_XB = 280 * MiB;
constexpr size_t WS_WGU = WS_Y;
constexpr size_t WS_WD = WS_Y + 32 * MiB;
constexpr size_t WS_XG = WS_Y + 48 * MiB;
constexpr size_t WS_HM = WS_Y + 128 * MiB;
constexpr size_t WS_TOKS = WS_Y + 148 * MiB;
constexpr size_t WS_RWS = WS_Y + 148 * MiB + 256 * KiB;
constexpr size_t WS_YS = WS_Y + 152 * MiB;
constexpr size_t WS_TOTAL = 328 * MiB;
constexpr int MOE_ROWS = 40960;

struct Params {
    const float* in[30];
    float* out;
    unsigned char* ws;
};

DEVI float bf2f(bf16_t v) { return __uint_as_float(((unsigned)v) << 16); }
DEVI bf16_t f2bf(float f) { unsigned u = __float_as_uint(f); return (bf16_t)((u + 0x7fffu + ((u >> 16) & 1u)) >> 16); }
DEVI unsigned pk2(float lo, float hi) { return (unsigned)f2bf(lo) | ((unsigned)f2bf(hi) << 16); }
DEVI int launder_v0(int v) { asm volatile("" : "+v"(v)); return v; }
DEVI float shx(float v, int o) { const int lane = launder_v0((int)threadIdx.x) & 63; return __int_as_float(__builtin_amdgcn_ds_bpermute((lane ^ o) << 2, __float_as_int(v))); }
DEVI unsigned shxu(unsigned v, int o) { const int lane = launder_v0((int)threadIdx.x) & 63; return (unsigned)__builtin_amdgcn_ds_bpermute((lane ^ o) << 2, (int)v); }
DEVI float wave_sum(float v) {
#pragma unroll
    for (int o = 1; o < 64; o <<= 1) v += shx(v, o);
    return v;
}
DEVI float wave_max(float v) {
#pragma unroll
    for (int o = 1; o < 64; o <<= 1) v = fmaxf(v, shx(v, o));
    return v;
}
DEVI float sigmoidf_(float x) { return __builtin_amdgcn_rcpf(1.f + __builtin_amdgcn_exp2f(-1.4426950408889634f * x)); }
DEVI float gelu_tanh(float x) { const float u = 0.7978845608028654f * (x + 0.044715f * x * x * x); return x * __builtin_amdgcn_rcpf(1.f + __builtin_amdgcn_exp2f(-2.8853900817779268f * u)); }
DEVI int launder_v(int v) { asm volatile("" : "+v"(v)); return v; }
DEVI int launder_s(int v) { asm volatile("" : "+s"(v)); return v; }
#define TIDX launder_v((int)threadIdx.x)
#define BIDX launder_s((int)blockIdx.x)
DEVI f32x4 zero4() { float z = 0.f; asm volatile("" : "+v"(z)); return (f32x4){z, z, z, z}; }
#define LDS_FENCE() asm volatile("s_waitcnt lgkmcnt(0)" ::: "memory")

constexpr int GLD = 40;
template <class LA, class LB>
DEVI void gemm_tile(const int tid, f32x4 (&acc)[2][4], int K, bf16_t* As, bf16_t* Bs, LA la, LB lb) {
    const int lane = tid & 63, wave = tid >> 6, wm = wave >> 1, wn = wave & 1;
    const int ar = tid >> 2, ak = (tid & 3) * 8;
    const int bk = tid >> 4, bn = (tid & 15) * 8;
    for (int k0 = 0; k0 < K; k0 += 32) {
        float av[8], bv[8];
        la(k0 + ak, av);
        lb(k0 + bk, bv);
        __syncthreads();
        uint4 pa; pa.x = pk2(av[0], av[1]); pa.y = pk2(av[2], av[3]); pa.z = pk2(av[4], av[5]); pa.w = pk2(av[6], av[7]);
        *(uint4*)(As + ar * GLD + ak) = pa;
#pragma unroll
        for (int j = 0; j < 8; ++j) Bs[(bn + j) * GLD + bk] = f2bf(bv[j]);
        __syncthreads();
        bf16x8 af[2], bfr[4];
#pragma unroll
        for (int i = 0; i < 2; ++i) af[i] = *(const bf16x8*)(As + (wm * 32 + i * 16 + (lane & 15)) * GLD + (lane >> 4) * 8);
#pragma unroll
        for (int j = 0; j < 4; ++j) bfr[j] = *(const bf16x8*)(Bs + (wn * 64 + j * 16 + (lane & 15)) * GLD + (lane >> 4) * 8);
#pragma unroll
        for (int i = 0; i < 2; ++i)
#pragma unroll
            for (int j = 0; j < 4; ++j) acc[i][j] = __builtin_amdgcn_mfma_f32_16x16x32_bf16(bfr[j], af[i], acc[i][j], 0, 0, 0);
    }
    __syncthreads();
}
DEVI void acc_zero(f32x4 (&acc)[2][4]) {
#pragma unroll
    for (int i = 0; i < 2; ++i)
#pragma unroll
        for (int j = 0; j < 4; ++j) acc[i][j] = zero4();
}
#define ACC_ROW(i) (((tid >> 7) * 32) + (i) * 16 + (tid & 15))
#define ACC_COL(j) ((((tid >> 6) & 1) * 64) + (j) * 16 + (((tid & 63) >> 4) * 4))

DEVI void load8f(const float* p, float (&v)[8]) {
    const f32x4 a = *(const f32x4*)p, b = *(const f32x4*)(p + 4);
    v[0] = a[0]; v[1] = a[1]; v[2] = a[2]; v[3] = a[3]; v[4] = b[0]; v[5] = b[1]; v[6] = b[2]; v[7] = b[3];
}
DEVI void load8b(const bf16_t* p, float (&v)[8]) {
    const uint4 a = *(const uint4*)p;
    v[0] = __uint_as_float(a.x << 16); v[1] = __uint_as_float(a.x & 0xffff0000u);
    v[2] = __uint_as_float(a.y << 16); v[3] = __uint_as_float(a.y & 0xffff0000u);
    v[4] = __uint_as_float(a.z << 16); v[5] = __uint_as_float(a.z & 0xffff0000u);
    v[6] = __uint_as_float(a.w << 16); v[7] = __uint_as_float(a.w & 0xffff0000u);
}
DEVI void unpack8(const uint4 a, float (&v)[8]) {
    v[0] = __uint_as_float(a.x << 16); v[1] = __uint_as_float(a.x & 0xffff0000u);
    v[2] = __uint_as_float(a.y << 16); v[3] = __uint_as_float(a.y & 0xffff0000u);
    v[4] = __uint_as_float(a.z << 16); v[5] = __uint_as_float(a.z & 0xffff0000u);
    v[6] = __uint_as_float(a.w << 16); v[7] = __uint_as_float(a.w & 0xffff0000u);
}
DEVI void zero8(float (&v)[8]) {
#pragma unroll
    for (int j = 0; j < 8; ++j) v[j] = 0.f;
}

#define LAS3 __attribute__((address_space(3)))
DEVI int orig_col(int c) { return c < 2304 ? c : (c < OFF_NG ? c + 24 : (c < OFF_END ? c - 4608 : -1)); }
DEVI bool head_tile(int pn) { return pn == 4 || pn == 5 || pn == 7 || pn == 8; }
DEVI int phys2logical(int c) {
    const int pn = c >> 8;
    if (!head_tile(pn)) return c;
    const int p = c & 255, bj = p >> 7, wc = (p >> 5) & 3, i = p & 31;
    return (pn << 8) + wc * 64 + bj * 32 + i;
}
namespace pg8 {
#define PG8_LAS __attribute__((address_space(3)))
typedef unsigned u32x4 __attribute__((ext_vector_type(4)));
constexpr int BM = 256, BK = 64, HALF = 128, HTB = HALF * BK * 2, STAGE_BYTES = 8 * HTB, NXCD = 8, WGM = 8;
DEVI int lds_byte(int r, int c) { const int st = (r >> 4) * 2 + (c >> 5), rr = r & 15, cc = c & 31, ob = rr * 64 + cc * 2; return st * 1024 + (ob ^ (((ob >> 9) & 1) << 5)); }
DEVI void stage_rc(int b, int& R, int& C) { const int st = b / 1024, sb = b % 1024, swz = sb ^ (((sb >> 9) & 1) << 5); R = (st >> 1) * 16 + swz / 64; C = (st & 1) * 32 + (swz % 64) / 2; }
DEVI int perm32(int rho) { const int n = rho >> 4, i = rho & 15; return 8 * (i >> 2) + 4 * n + (i & 3); }
struct Unit { int pm, pn, ao = 0, aux = 0; };
struct Gemm { const bf16_t* A; const bf16_t* Bt; int K, lda, ldb; int kstepA = BK * 2, kstepB = BK * 2; };
struct StaticOrder {
    int nM, nN, nwg, G, c;
    DEVI void init(int M, int N, int G_, int c_) { nM = M / BM; nN = N / BM; nwg = nM * nN; G = G_; c = c_; }
    DEVI bool next(int i, Unit& u) const {
        const long L = (long)i * G + c; if (L >= nwg) return false;
        int wgid = (int)L; { const int q = nwg / NXCD, r = nwg % NXCD, xcd = wgid % NXCD, off = wgid / NXCD; wgid = (xcd < r ? xcd * (q + 1) : r * (q + 1) + (xcd - r) * q) + off; }
        const int nig = WGM * nN, gid = wgid / nig, fm = gid * WGM, gsz = (nM - fm) < WGM ? (nM - fm) : WGM;
        u.pm = fm + ((wgid % nig) % gsz); u.pn = (wgid % nig) / gsz; return true;
    }
};
DEVI unsigned cvt_pk_bf16(float lo, float hi) { unsigned r; asm volatile("v_cvt_pk_bf16_f32 %0, %1, %2" : "=v"(r) : "v"(lo), "v"(hi)); return r; }

template <class Epi, class Sched, bool GATHER = false, bool ALIGN_EPI = true, bool SP2 = true>
DEVI void gemm_phase(PG8_LAS unsigned char* lds, const Gemm g, const Sched& S, const Epi& E) {
    const int tid = TIDX; const int wid = __builtin_amdgcn_readfirstlane(tid >> 6), lane = tid & 63, wr = wid >> 2, wc = wid & 3, fr = lane & 15, fq = lane >> 4;
    const int K = launder_s(g.K), nt = K / BK;
    unsigned voffA[2][2], voffAn[2][2], voffB[2];
    const size_t kstepA = (size_t)g.kstepA, kstepB = (size_t)g.kstepB;
    const size_t hstepA = (size_t)HALF * g.lda * 2, hstepB = (size_t)HALF * g.ldb * 2;
    const size_t tstepA = 2 * hstepA, tstepB = 2 * hstepB;
#pragma unroll
    for (int i = 0; i < 2; ++i) { int R, C; stage_rc(tid * 16 + i * 8192, R, C); const int Rb = Epi::PERM ? ((R & ~31) + perm32(R & 31)) : R;
        voffB[i] = (unsigned)(Rb * g.ldb + C) * 2u;
        if constexpr (GATHER) {
#pragma unroll
            for (int h = 0; h < 2; ++h) { voffA[h][i] = (unsigned)(S.a_row(0, h * HALF + R) * g.lda + C) * 2u; voffAn[h][i] = (unsigned)(S.a_row(1, h * HALF + R) * g.lda + C) * 2u; }
        } else {
#pragma unroll
            for (int h = 0; h < 2; ++h) { voffA[h][i] = (unsigned)(R * g.lda + C) * 2u + (unsigned)(h * hstepA); voffAn[h][i] = voffA[h][i]; }
        } }
    const unsigned ldsw = (unsigned)wid * 1024u;
    const int aoff = lds_byte(wr * 64 + fr, fq * 8), boff = lds_byte(wc * 32 + fr, fq * 8);
#define PG8_SA(b, h) (((b) * 2 + (h)) * HTB)
#define PG8_SB(b, h) ((4 + (b) * 2 + (h)) * HTB)
#define PG8_STAGE(bufoff, gbase, voff) do { _Pragma("unroll") for (int _i = 0; _i < 2; ++_i) \
        __builtin_amdgcn_global_load_lds((const unsigned*)((const char*)(gbase) + (voff)[_i]), (PG8_LAS unsigned*)(lds + (bufoff) + ldsw + _i * 8192), 16, 0, 0); } while (0)
#define PG8_LDA(dst, b, h) do { _Pragma("unroll") for (int m = 0; m < 4; ++m) _Pragma("unroll") for (int k = 0; k < 2; ++k) dst[m][k] = *(const PG8_LAS bf16x8*)(lds + PG8_SA(b, h) + aoff + m * 2048 + k * 1024); } while (0)
#define PG8_LDB(dst, b, h) do { _Pragma("unroll") for (int n = 0; n < 2; ++n) _Pragma("unroll") for (int k = 0; k < 2; ++k) dst[n][k] = *(const PG8_LAS bf16x8*)(lds + PG8_SB(b, h) + boff + n * 2048 + k * 1024); } while (0)
#define PG8_MMA(ai, bj, At, Bt) do { __builtin_amdgcn_s_setprio(1); _Pragma("unroll") for (int m = 0; m < 4; ++m) _Pragma("unroll") for (int n = 0; n < 2; ++n) _Pragma("unroll") for (int k = 0; k < 2; ++k) \
        acc[ai][bj][m][n] = __builtin_amdgcn_mfma_f32_16x16x32_bf16(Bt[n][k], At[m][k], acc[ai][bj][m][n], 0, 0, 0); __builtin_amdgcn_s_setprio(0); } while (0)
#define PG8_WAIT_V(n) asm volatile("s_waitcnt vmcnt(" #n ")" ::: "memory")
#define PG8_WAIT_L(n) asm volatile("s_waitcnt lgkmcnt(" #n ")" ::: "memory")
#define PG8_BAR __builtin_amdgcn_s_barrier()
#define PG8_SCHED __builtin_amdgcn_sched_barrier(0)
    Unit cur, nxt; int ui = 0;
    if (!S.next(0, cur)) return;
    f32x4 acc[2][2][4][2];
#pragma unroll
    for (int a = 0; a < 2; ++a)
#pragma unroll
        for (int b = 0; b < 2; ++b)
#pragma unroll
            for (int m = 0; m < 4; ++m)
#pragma unroll
                for (int n = 0; n < 2; ++n) acc[a][b][m][n] = zero4();
    bf16x8 At[4][2], B0[2][2], B1[2][2];
    const char* cA = GATHER ? (const char*)g.A : (const char*)g.A + (size_t)cur.pm * tstepA + (size_t)cur.ao * 2; const char* cB = (const char*)g.Bt + (size_t)cur.pn * tstepB;
    if constexpr (SP2) {
        PG8_STAGE(PG8_SB(0, 0), cB, voffB); PG8_STAGE(PG8_SB(0, 1), cB + hstepB, voffB); PG8_STAGE(PG8_SA(0, 0), cA, voffA[0]); PG8_STAGE(PG8_SA(0, 1), cA, voffA[1]);
        if (wr == 1) PG8_BAR;
        PG8_WAIT_V(2); PG8_BAR;
        PG8_STAGE(PG8_SB(1, 0), cB + kstepB, voffB); PG8_STAGE(PG8_SA(1, 0), cA + kstepA, voffA[0]); PG8_STAGE(PG8_SB(1, 1), cB + hstepB + kstepB, voffB);
        PG8_WAIT_V(6); PG8_BAR;
    } else {
        PG8_STAGE(PG8_SB(0, 0), cB, voffB); PG8_STAGE(PG8_SA(0, 0), cA, voffA[0]); PG8_STAGE(PG8_SB(0, 1), cB + hstepB, voffB); PG8_STAGE(PG8_SA(0, 1), cA, voffA[1]);
        if (wr == 1) PG8_BAR;
        PG8_WAIT_V(4); PG8_BAR;
        PG8_STAGE(PG8_SB(1, 0), cB + kstepB, voffB); PG8_STAGE(PG8_SA(1, 0), cA + kstepA, voffA[0]); PG8_STAGE(PG8_SB(1, 1), cB + hstepB + kstepB, voffB);
        PG8_WAIT_V(6); PG8_BAR;
    }
    for (;;) {
        const bool has_next = S.next(ui + 1, nxt);
        const char* nA = GATHER ? (const char*)g.A : (has_next ? (const char*)g.A + (size_t)nxt.pm * tstepA + (size_t)nxt.ao * 2 : cA); const char* nB = has_next ? (const char*)g.Bt + (size_t)nxt.pn * tstepB : cB;
        for (int t = 0; t < nt; t += 2) {
            const bool last = (t == nt - 2);
            const char* a1 = cA + (size_t)(t + 1) * kstepA;
            const char* a2 = last ? nA : cA + (size_t)(t + 2) * kstepA; const char* b2 = last ? nB : cB + (size_t)(t + 2) * kstepB;
            const char* a3 = a2 + kstepA; const char* b3 = b2 + kstepB;
            unsigned vA2[2][2];
#pragma unroll
            for (int h = 0; h < 2; ++h)
#pragma unroll
                for (int i = 0; i < 2; ++i) vA2[h][i] = last ? voffAn[h][i] : voffA[h][i];
            if constexpr (SP2) {
            PG8_LDB(B0, 0, 0); PG8_LDB(B1, 0, 1); PG8_SCHED; PG8_LDA(At, 0, 0); PG8_STAGE(PG8_SA(1, 1), a1, voffA[1]);
            PG8_WAIT_V(8); PG8_WAIT_L(0); PG8_BAR; PG8_MMA(0, 0, At, B0); PG8_MMA(0, 1, At, B1); PG8_BAR; PG8_SCHED;
            PG8_LDA(At, 0, 1); PG8_STAGE(PG8_SB(0, 0), b2, voffB); PG8_STAGE(PG8_SB(0, 1), b2 + hstepB, voffB); PG8_STAGE(PG8_SA(0, 0), a2, vA2[0]);
            PG8_WAIT_V(8); PG8_WAIT_L(0); PG8_BAR; PG8_MMA(1, 0, At, B0); PG8_MMA(1, 1, At, B1); PG8_BAR; PG8_SCHED;
            PG8_LDB(B0, 1, 0); PG8_LDB(B1, 1, 1); PG8_SCHED; PG8_LDA(At, 1, 0); PG8_STAGE(PG8_SA(0, 1), a2, vA2[1]);
            PG8_WAIT_V(8); PG8_WAIT_L(0); PG8_BAR; PG8_MMA(0, 0, At, B0); PG8_MMA(0, 1, At, B1); PG8_BAR; PG8_SCHED;
            PG8_LDA(At, 1, 1); PG8_STAGE(PG8_SB(1, 0), b3, voffB); PG8_STAGE(PG8_SB(1, 1), b3 + hstepB, voffB); PG8_STAGE(PG8_SA(1, 0), a3, vA2[0]);
            PG8_WAIT_V(8); PG8_WAIT_L(0); PG8_BAR; PG8_MMA(1, 0, At, B0); PG8_MMA(1, 1, At, B1); PG8_BAR; PG8_SCHED;
            } else {
            PG8_LDB(B0, 0, 0); PG8_SCHED; PG8_LDA(At, 0, 0); PG8_STAGE(PG8_SA(1, 1), a1, voffA[1]);
            PG8_WAIT_L(8); PG8_BAR; PG8_WAIT_L(0); PG8_MMA(0, 0, At, B0); PG8_BAR; PG8_SCHED;
            PG8_LDB(B1, 0, 1); PG8_STAGE(PG8_SB(0, 0), b2, voffB);
            PG8_BAR; PG8_WAIT_L(0); PG8_MMA(0, 1, At, B1); PG8_BAR;
            PG8_LDA(At, 0, 1); PG8_STAGE(PG8_SA(0, 0), a2, vA2[0]);
            PG8_BAR; PG8_WAIT_L(0); PG8_MMA(1, 0, At, B0); PG8_BAR; PG8_SCHED;
            PG8_STAGE(PG8_SB(0, 1), b2 + hstepB, voffB);
            PG8_WAIT_V(6); PG8_BAR; PG8_MMA(1, 1, At, B1); PG8_BAR;
            PG8_LDB(B0, 1, 0); PG8_SCHED; PG8_LDA(At, 1, 0); PG8_STAGE(PG8_SA(0, 1), a2, vA2[1]);
            PG8_WAIT_L(8); PG8_BAR; PG8_WAIT_L(0); PG8_MMA(0, 0, At, B0); PG8_BAR; PG8_SCHED;
            PG8_LDB(B1, 1, 1); PG8_STAGE(PG8_SB(1, 0), b3, voffB);
            PG8_BAR; PG8_WAIT_L(0); PG8_MMA(0, 1, At, B1); PG8_BAR;
            PG8_LDA(At, 1, 1); PG8_STAGE(PG8_SA(1, 0), a3, vA2[0]);
            PG8_BAR; PG8_WAIT_L(0); PG8_MMA(1, 0, At, B0); PG8_BAR; PG8_SCHED;
            PG8_STAGE(PG8_SB(1, 1), b3 + hstepB, voffB);
            PG8_WAIT_V(6); PG8_BAR; PG8_MMA(1, 1, At, B1); PG8_BAR;
            }
        }
        if constexpr (ALIGN_EPI) { if (wr == 0) PG8_BAR; }
        bool keep = false;
        if constexpr (Epi::CHAIN) keep = E.chain(acc, cur, wr, wc, fr, fq);
        else E(acc, cur, wr, wc, fr, fq);
        if (!has_next) break;
        if (!keep) {
#pragma unroll
        for (int a = 0; a < 2; ++a)
#pragma unroll
            for (int b = 0; b < 2; ++b)
#pragma unroll
                for (int m = 0; m < 4; ++m)
#pragma unroll
                    for (int n = 0; n < 2; ++n) acc[a][b][m][n] = zero4();
        }
        cur = nxt; cA = nA; cB = nB; ++ui;
        if constexpr (GATHER) {
#pragma unroll
            for (int h = 0; h < 2; ++h)
#pragma unroll
                for (int i = 0; i < 2; ++i) voffA[h][i] = voffAn[h][i]; }
        if constexpr (ALIGN_EPI) { if (wr == 1) PG8_BAR; }
    }
    PG8_WAIT_V(0);
    if constexpr (!ALIGN_EPI) { if (wr == 0) PG8_BAR; }
    PG8_BAR;
#undef PG8_SA
#undef PG8_SB
#undef PG8_STAGE
#undef PG8_LDA
#undef PG8_LDB
#undef PG8_MMA
#undef PG8_WAIT_V
#undef PG8_WAIT_L
#undef PG8_BAR
#undef PG8_SCHED
}
}

typedef float f32x16 __attribute__((ext_vector_type(16)));
typedef unsigned u32x4v __attribute__((ext_vector_type(4)));
typedef short s16x4 __attribute__((ext_vector_type(4)));
constexpr int NSA_MISC = 49152, NSA_OUT = 53248, NSA_QF = 118784;
constexpr float NSA_NEG = -1e30f, NSA_M0 = -1e20f;
DEVI int crow16(int r, int hi) { return (r & 3) + 8 * (r >> 2) + 4 * hi; }
DEVI float half_max(float v) { auto rr = __builtin_amdgcn_permlane32_swap(__float_as_uint(v), __float_as_uint(v), false, false); return fmaxf(__uint_as_float(rr[0]), __uint_as_float(rr[1])); }
DEVI float half_sum(float v) { auto rr = __builtin_amdgcn_permlane32_swap(__float_as_uint(v), __float_as_uint(v), false, false); return __uint_as_float(rr[0]) + __uint_as_float(rr[1]); }
DEVI unsigned half_or(unsigned v) { auto rr = __builtin_amdgcn_permlane32_swap(v, v, false, false); return rr[0] | rr[1]; }
DEVI int half_addi(int v) { auto rr = __builtin_amdgcn_permlane32_swap((unsigned)v, (unsigned)v, false, false); return (int)(rr[0] + rr[1]); }

template <class LD>
DEVI void tr_item_f(LD ld, bf16_t* dst, int ldd, float* scr, int lane) {
#pragma unroll 8
    for (int i = 0; i < 32; ++i) { const int kk = 2 * i + (lane >> 5); scr[kk * 33 + (lane & 31)] = ld(kk); }
    LDS_FENCE();
    const int c = lane & 7;
#pragma unroll
    for (int j = 0; j < 4; ++j) {
        const int n = (lane >> 3) + 8 * j; const float* s = scr + (8 * c) * 33 + n;
        uint4 o; o.x = pk2(s[0], s[33]); o.y = pk2(s[66], s[99]); o.z = pk2(s[132], s[165]); o.w = pk2(s[198], s[231]);
        *(uint4*)(dst + (size_t)n * ldd + 8 * c) = o;
    }
    LDS_FENCE();
}
DEVI void tr_item(const float* srck0, int ldsrc, int col0, int nvalid, const float* ks, bf16_t* dst, int ldd, float* scr, int lane) {
    const int r8 = lane >> 3, c4 = (lane & 7) * 4;
    const bool ok = (col0 >= 0 && c4 < nvalid);
    const int col = ok ? col0 + c4 : 0;
    const float msk = ok ? 1.f : 0.f;
    f32x4 v[8];
#pragma unroll
    for (int i = 0; i < 8; ++i) v[i] = *(const f32x4*)(srck0 + (size_t)(8 * i + r8) * ldsrc + col);
#pragma unroll
    for (int i = 0; i < 8; ++i) {
        const int kk = 8 * i + r8;
        const float s = ks ? ks[kk] * msk : msk;
        *(f32x4*)(scr + kk * 36 + c4) = v[i] * s;
    }
    LDS_FENCE();
    const int c = lane & 7;
#pragma unroll
    for (int j = 0; j < 4; ++j) {
        const int n = (lane >> 3) + 8 * j; const float* s = scr + (8 * c) * 36 + n;
        uint4 o; o.x = pk2(s[0], s[36]); o.y = pk2(s[72], s[108]); o.z = pk2(s[144], s[180]); o.w = pk2(s[216], s[252]);
        *(uint4*)(dst + (size_t)n * ldd + 8 * c) = o;
    }
    LDS_FENCE();
}
DEVI void phase_prep(const Params& p, bf16_t* WIN, bf16_t* WBR, bf16_t* WO, bf16_t* WRT, bf16_t* W1T, bf16_t* W2T, float* BPE, float* ldsf) {
    const int tid = TIDX; const int bid = BIDX; const int lane = tid & 63, wv = tid >> 6, gw = bid * 8 + wv, ngw = gridDim.x * 8;
    float* scr = ldsf + wv * 2304;
    for (int e = gw * 64 + lane; e < 2 * 2 * 64 * 128; e += ngw * 64) {
        const int lz = e >> 13, d = (e >> 7) & 63, j = e & 127;
        W2T[e] = f2bf(p.in[13][(size_t)lz * 8192 + j * 64 + d]);
    }
    for (int it = gw; it < 2 * 2 * 128; it += ngw) {
        const int lz = it >> 7, j = it & 127;
        const float* pe = p.in[10] + (size_t)lz * 2048; const float* w1 = p.in[11] + (size_t)lz * 2048 * 128 + j;
        float s = 0.f;
#pragma unroll 8
        for (int i = 0; i < 32; ++i) { const int k = lane + 64 * i; s += pe[k] * w1[(size_t)k * 128]; }
        s = wave_sum(s);
        if (lane == 0) BPE[it] = s + p.in[12][it];
    }
    for (int it = gw; it < 2 * 2 * 128; it += ngw) {
        const int lz = it >> 7, r = it & 127, kb = r >> 2, nb = r & 3, k0 = kb * 64, n0 = nb * 32;
        tr_item(p.in[11] + (size_t)lz * 2048 * 128 + (size_t)k0 * 128, 128, n0, 32, nullptr, W1T + ((size_t)lz * 128 + n0) * 2048 + k0, 2048, scr, lane);
    }
    constexpr int I_IN = 16 * 224, I_BR = 8 * 32, I_O = 16 * 32, I_R = 16 * 8, I_L = I_IN + 3 * I_BR + I_O + I_R;
    for (int it = gw; it < 2 * I_L; it += ngw) {
        const int l = it / I_L; int r = it % I_L;
        if (r >= I_L - I_R) {
            r -= I_L - I_R; const int kb = r / 8, nb = r % 8, k0 = kb * 64, n0 = nb * 32, n = n0 + (lane & 31);
            const float* wg = p.in[23] + (size_t)l * DM * 4 + (size_t)k0 * 4; const float* we = p.in[25] + (size_t)l * DM * 32 + (size_t)k0 * 32; const float* gn = p.in[22] + l * DM + k0;
            tr_item_f([&](int kk) { return (n < 4 ? wg[kk * 4 + n] : (n < 36 ? we[kk * 32 + n - 4] : 0.f)) * gn[kk]; }, WRT + ((size_t)l * 256 + n0) * DM + k0, DM, scr, lane);
        } else if (r < I_IN) {
            const int kb = r / 224, nb = r % 224, k0 = kb * 64, n0 = nb * 32;
            tr_item(p.in[2] + (size_t)l * DM * INW + (size_t)k0 * INW, INW, orig_col(phys2logical(n0)), n0 == OFF_NG ? 24 : 32, p.in[1] + l * DM + k0, WIN + ((size_t)l * LDY + n0) * DM + k0, DM, scr, lane);
        } else if (r < I_IN + 3 * I_BR) {
            r -= I_IN; const int br = r / I_BR, rr = r % I_BR, kb = rr / 32, nb = rr % 32, k0 = kb * 64, n0 = nb * 32;
            const float* W = (br == 0 ? p.in[18] : (br == 1 ? p.in[19] : p.in[20])) + (size_t)l * 512 * DM;
            tr_item(W + (size_t)k0 * DM, DM, n0, 32, nullptr, WBR + ((size_t)(l * 3 + br) * DM + n0) * 512 + k0, 512, scr, lane);
        } else {
            r -= I_IN + 3 * I_BR; const int kb = r / 32, nb = r % 32, k0 = kb * 64, n0 = nb * 32;
            tr_item(p.in[21] + (size_t)l * DM * DM + (size_t)k0 * DM, DM, n0, 32, nullptr, WO + ((size_t)l * DM + n0) * DM + k0, DM, scr, lane);
        }
    }
}
DEVI void phase_moe_prep(const float* Wg, const float* Wu, const float* Wd, const float* gain, bf16_t* WGU, bf16_t* WD, float* ldsf) {
    const int tid = TIDX; const int bid = BIDX; const int lane = tid & 63, wv = tid >> 6, gw = bid * 8 + wv, ngw = gridDim.x * 8;
    float* scr = ldsf + wv * 2304;
    constexpr int I_GU = 16 * 16, I_D = 4 * 32, I_E = I_GU + I_D;
    int it0, it1;
    if (gridDim.x == 256) { if (bid >= 64) { const int v = (bid - 64) * 8 + wv; it0 = 7 * v; it1 = it0 + 7; } else { const int v = bid * 8 + wv; it0 = 10752 + 3 * v; it1 = it0 + 3; } }
    else { it0 = gw; it1 = NEXP * I_E; }
    const int istep = (gridDim.x == 256) ? 1 : ngw;
    for (int it = it0; it < it1; it += istep) {
        const int e = it / I_E; int r = it % I_E;
        if (r < I_GU) {
            const int kb = r / 16, nb = r % 16, k0 = kb * 64, n0 = nb * 32;
            const int half = n0 >> 8, isup = (n0 >> 7) & 1, i0 = n0 & 127;
            const float* W = (isup ? Wu : Wg) + (size_t)e * DM * 256 + (size_t)k0 * 256;
            tr_item(W, 256, half * 128 + i0, 32, gain + k0, WGU + ((size_t)e * 512 + n0) * DM + k0, DM, scr, lane);
        } else {
            r -= I_GU; const int kb = r / 32, nb = r % 32, k0 = kb * 64, n0 = nb * 32;
            tr_item(Wd + (size_t)e * 256 * DM + (size_t)k0 * DM, DM, n0, 32, nullptr, WD + ((size_t)e * DM + n0) * 256 + k0, 256, scr, lane);
        }
    }
}

DEVI void phase_xb(const float* x, float* rstd, bf16_t* XB) {
    const int tid = TIDX; const int bid = BIDX; const int lane = tid & 63, gw = bid * 8 + (tid >> 6), ngw = gridDim.x * 8;
    for (int m = gw; m < MTOK; m += ngw) {
        const f32x4* xr = (const f32x4*)(x + (size_t)m * DM) + lane;
        uint2* xo = (uint2*)(XB + (size_t)m * DM) + lane;
        float s = 0.f;
#pragma unroll
        for (int j = 0; j < 4; ++j) { const f32x4 v = xr[64 * j]; s += v[0] * v[0] + v[1] * v[1] + v[2] * v[2] + v[3] * v[3];
            uint2 o; o.x = pk2(v[0], v[1]); o.y = pk2(v[2], v[3]); xo[64 * j] = o; }
        s = wave_sum(s);
        if (lane == 0) rstd[m] = rsqrtf(s * (1.f / DM) + RMS_EPS);
    }
}

struct EpiInproj {
    static constexpr bool PERM = true, CHAIN = false;
    bf16_t* Y; const float* rstd; const float* qn; const float* kn; bf16_t* KVC;
    DEVI void operator()(const f32x4 (&acc)[2][2][4][2], const pg8::Unit& u, int wr, int wc, int fr, int fq) const {
        const int row0 = u.pm * 256 + wr * 64 + fr;
        if (head_tile(u.pn)) {
            const bool isq = u.pn < 6, normed = isq || wc < 2;
            const float* gp = isq ? qn : kn + (u.pn == 7 ? 64 : 128);
            float gn[2][8];
#pragma unroll
            for (int bj = 0; bj < 2; ++bj)
#pragma unroll
                for (int e = 0; e < 8; ++e) gn[bj][e] = normed ? gp[32 * bj + 8 * fq + e] * (isq ? 0.125f * 1.4426950408889634f : 1.f) : 1.f;
#pragma unroll
            for (int ai = 0; ai < 2; ++ai)
#pragma unroll
                for (int m = 0; m < 4; ++m) {
                    const int row = row0 + ai * 128 + m * 16; const float rs = rstd[row];
                    f32x4 v[2][2]; float ss = 0.f;
#pragma unroll
                    for (int bj = 0; bj < 2; ++bj)
#pragma unroll
                        for (int n = 0; n < 2; ++n) { v[bj][n] = acc[ai][bj][m][n] * rs; ss += v[bj][n][0] * v[bj][n][0] + v[bj][n][1] * v[bj][n][1] + v[bj][n][2] * v[bj][n][2] + v[bj][n][3] * v[bj][n][3]; }
                    ss += shx(ss, 16); ss += shx(ss, 32);
                    const float hs = normed ? rsqrtf(ss * (1.f / 64.f) + RMS_EPS) : 1.f;
#pragma unroll
                    for (int bj = 0; bj < 2; ++bj) {
                        uint4 w;
                        w.x = pk2(v[bj][0][0] * hs * gn[bj][0], v[bj][0][1] * hs * gn[bj][1]); w.y = pk2(v[bj][0][2] * hs * gn[bj][2], v[bj][0][3] * hs * gn[bj][3]);
                        w.z = pk2(v[bj][1][0] * hs * gn[bj][4], v[bj][1][1] * hs * gn[bj][5]); w.w = pk2(v[bj][1][2] * hs * gn[bj][6], v[bj][1][3] * hs * gn[bj][7]);
                        *(uint4*)(Y + (size_t)row * LDY + u.pn * 256 + wc * 64 + 32 * bj + 8 * fq) = w;
                    }
                }
            return;
        }
        const int col0 = u.pn * 256 + wc * 32 + 8 * fq;
#pragma unroll
        for (int ai = 0; ai < 2; ++ai)
#pragma unroll
            for (int m = 0; m < 4; ++m) {
                const int row = row0 + ai * 128 + m * 16; const float rs = rstd[row];
#pragma unroll
                for (int bj = 0; bj < 2; ++bj) {
                    const int col = col0 + bj * 128;
                    if (col >= OFF_END) continue;
                    f32x4 v0 = acc[ai][bj][m][0] * rs, v1 = acc[ai][bj][m][1] * rs;
                    if (col >= OFF_RY && col < OFF_Q) {
#pragma unroll
                        for (int e = 0; e < 4; ++e) { v0[e] = gelu_tanh(v0[e]); v1[e] = gelu_tanh(v1[e]); }
                    } else if (col >= OFF_MG) {
#pragma unroll
                        for (int e = 0; e < 4; ++e) { v0[e] = sigmoidf_(v0[e]); v1[e] = sigmoidf_(v1[e]); }
                        if (col < OFF_NG) {
                            uint2 w8;
                            w8.x = (unsigned)(v0[0] * 255.f + 0.5f) | ((unsigned)(v0[1] * 255.f + 0.5f) << 8) | ((unsigned)(v0[2] * 255.f + 0.5f) << 16) | ((unsigned)(v0[3] * 255.f + 0.5f) << 24);
                            w8.y = (unsigned)(v1[0] * 255.f + 0.5f) | ((unsigned)(v1[1] * 255.f + 0.5f) << 8) | ((unsigned)(v1[2] * 255.f + 0.5f) << 16) | ((unsigned)(v1[3] * 255.f + 0.5f) << 24);
                            *(uint2*)((unsigned char*)(Y + (size_t)row * LDY + OFF_MG) + (col - OFF_MG)) = w8;
                            continue;
                        }
                    }
                    uint4 w; w.x = pk2(v0[0], v0[1]); w.y = pk2(v0[2], v0[3]); w.z = pk2(v1[0], v1[1]); w.w = pk2(v1[2], v1[3]);
                    if (u.pn == 6) *(uint4*)(KVC + (size_t)row * 256 + (col - OFF_KC)) = w;
                    else *(uint4*)(Y + (size_t)row * LDY + col) = w;
                }
            }
    }
};
DEVI void gate8(const uint2 w, float (&g)[8]) {
#pragma unroll
    for (int e = 0; e < 4; ++e) { g[e] = (float)((w.x >> (8 * e)) & 255u) * (1.f / 255.f); g[4 + e] = (float)((w.y >> (8 * e)) & 255u) * (1.f / 255.f); }
}
struct MergeOrder {
    pg8::StaticOrder so;
    DEVI bool next(int i, pg8::Unit& u) const {
        pg8::Unit t; if (!so.next(i / 3, t)) return false;
        const int br = i % 3;
        u.pm = t.pm; u.pn = br * 4 + t.pn; u.ao = br == 0 ? OFF_RY : (br == 1 ? OFF_RX : OFF_SB); return true;
    }
};
struct EpiMerge {
    static constexpr bool PERM = true, CHAIN = true;
    bf16_t* Y;
    DEVI void operator()(const f32x4 (&)[2][2][4][2], const pg8::Unit&, int, int, int, int) const {}
    DEVI bool chain(f32x4 (&acc)[2][2][4][2], const pg8::Unit& u, int wr, int wc, int fr, int fq) const {
        const int br = u.pn >> 2;
        const int row0 = u.pm * 256 + wr * 64 + fr, col0 = (u.pn & 3) * 256 + wc * 32 + 8 * fq;
#pragma unroll
        for (int ai = 0; ai < 2; ++ai)
#pragma unroll
            for (int m = 0; m < 4; ++m) {
                const int row = row0 + ai * 128 + m * 16;
#pragma unroll
                for (int bj = 0; bj < 2; ++bj) {
                    const unsigned char* gp = (const unsigned char*)(Y + (size_t)row * LDY + OFF_MG) + col0 + bj * 128;
                    float g[8]; gate8(*(const uint2*)(gp + br * 1024), g);
#pragma unroll
                    for (int e = 0; e < 8; ++e) g[e] = fmaxf(g[e], 9.5367431640625e-7f);
                    if (br < 2) {
                        float gnx[8]; gate8(*(const uint2*)(gp + (br + 1) * 1024), gnx);
#pragma unroll
                        for (int e = 0; e < 8; ++e) { const float r = g[e] * __builtin_amdgcn_rcpf(fmaxf(gnx[e], 9.5367431640625e-7f)); acc[ai][bj][m][e >> 2][e & 3] *= r; }
                    } else {
                        uint4 w;
                        w.x = pk2(g[0] * acc[ai][bj][m][0][0], g[1] * acc[ai][bj][m][0][1]); w.y = pk2(g[2] * acc[ai][bj][m][0][2], g[3] * acc[ai][bj][m][0][3]);
                        w.z = pk2(g[4] * acc[ai][bj][m][1][0], g[5] * acc[ai][bj][m][1][1]); w.w = pk2(g[6] * acc[ai][bj][m][1][2], g[7] * acc[ai][bj][m][1][3]);
                        *(uint4*)(Y + (size_t)row * LDY + OFF_SC + col0 + bj * 128) = w;
                    }
                }
            }
        return br < 2;
    }
};
DEVI float row_rstd16(const float* ssp) {
    const f32x4 a = *(const f32x4*)ssp, b = *(const f32x4*)(ssp + 4), c = *(const f32x4*)(ssp + 8), d = *(const f32x4*)(ssp + 12);
    const float s = ((a[0] + a[1]) + (a[2] + a[3])) + ((b[0] + b[1]) + (b[2] + b[3])) + ((c[0] + c[1]) + (c[2] + c[3])) + ((d[0] + d[1]) + (d[2] + d[3]));
    return rsqrtf(s * (1.f / DM) + RMS_EPS);
}
struct EpiOut {
    static constexpr bool PERM = false, CHAIN = false;
    bf16_t* XB; float* SS;
    DEVI void operator()(const f32x4 (&acc)[2][2][4][2], const pg8::Unit& u, int wr, int wc, int fr, int fq) const {
        const int row0 = u.pm * 256 + wr * 64 + fr, col0 = u.pn * 256 + wc * 32 + 4 * fq;
#pragma unroll
        for (int ai = 0; ai < 2; ++ai)
#pragma unroll
            for (int m = 0; m < 4; ++m) {
                const int row = row0 + ai * 128 + m * 16;
                const size_t ro = (size_t)row * DM + col0;
                float s = 0.f;
#pragma unroll
                for (int bj = 0; bj < 2; ++bj)
#pragma unroll
                    for (int n = 0; n < 2; ++n) {
                        const size_t off = ro + bj * 128 + n * 16;
                        const uint2 xr = *(const uint2*)(XB + off);
                        f32x4 v = acc[ai][bj][m][n];
                        v[0] += __uint_as_float(xr.x << 16); v[1] += __uint_as_float(xr.x & 0xffff0000u); v[2] += __uint_as_float(xr.y << 16); v[3] += __uint_as_float(xr.y & 0xffff0000u);
                        uint2 w; w.x = pk2(v[0], v[1]); w.y = pk2(v[2], v[3]);
                        *(uint2*)(XB + off) = w;
                        const float r0 = __uint_as_float(w.x << 16), r1 = __uint_as_float(w.x & 0xffff0000u), r2 = __uint_as_float(w.y << 16), r3 = __uint_as_float(w.y & 0xffff0000u);
                        s += r0 * r0 + r1 * r1 + r2 * r2 + r3 * r3;
                    }
                s += shx(s, 16); s += shx(s, 32);
                if (fq == 0) SS[(size_t)row * 16 + u.pn * 4 + wc] = s;
            }
    }
};
struct CmpOrder {
    int G, c;
    DEVI bool next(int i, pg8::Unit& u) const {
        const int L = i * G + c; if (L >= 16) return false;
        const int z = L >> 3, g = (L >> 2) & 1, b = L & 3;
        u.pm = b; u.pn = 0; u.ao = z * 128 + g * 64; return true;
    }
};
struct EpiCmp1 {
    static constexpr bool PERM = false, CHAIN = false;
    bf16_t* HID; const float* BPE;
    DEVI void operator()(const f32x4 (&acc)[2][2][4][2], const pg8::Unit& u, int wr, int wc, int fr, int fq) const {
        const int z = u.ao >> 7, g = (u.ao >> 6) & 1, b = u.pm;
        const int col0 = wc * 32 + 4 * fq;
#pragma unroll
        for (int ai = 0; ai < 2; ++ai)
#pragma unroll
            for (int m = 0; m < 4; ++m) {
                const int n = ai * 128 + wr * 64 + m * 16 + fr;
                if (n >= NCMP) continue;
                bf16_t* dst = HID + ((size_t)z * 2048 + (size_t)(b * NCMP + n) * 2 + g) * 128 + col0;
#pragma unroll
                for (int nn = 0; nn < 2; ++nn) {
                    const f32x4 a = z ? acc[ai][1][m][nn] : acc[ai][0][m][nn];
                    const f32x4 bb = *(const f32x4*)(BPE + z * 128 + col0 + nn * 16);
                    uint2 o; o.x = pk2(gelu_tanh(a[0] + bb[0]), gelu_tanh(a[1] + bb[1])); o.y = pk2(gelu_tanh(a[2] + bb[2]), gelu_tanh(a[3] + bb[3]));
                    *(uint2*)(dst + nn * 16) = o;
                }
            }
    }
};
DEVI void cmp2_unit(const bf16_t* HID, const bf16_t* W2T  , const float* b2  , const float* kn0  , bf16_t* KCB, bf16_t* VCB, int z, int g, int b) {
    const int tid = TIDX; const int lane = tid & 63, w = tid >> 6, r32 = lane & 31, hi = lane >> 5;
    const int n = 32 * w + r32;
    const bf16_t* hrow = HID + ((size_t)z * 2048 + (size_t)(b * NCMP + (n < NCMP ? n : 0)) * 2 + g) * 128;
    f32x16 acc[2];
#pragma unroll
    for (int blk = 0; blk < 2; ++blk)
#pragma unroll
        for (int r = 0; r < 16; ++r) acc[blk][r] = 0.f;
#pragma unroll
    for (int s = 0; s < 8; ++s) {
        const bf16x8 hf = *(const bf16x8*)(hrow + 16 * s + 8 * hi);
#pragma unroll
        for (int blk = 0; blk < 2; ++blk) {
            const bf16x8 wf = *(const bf16x8*)(W2T + ((size_t)z * 64 + 32 * blk + r32) * 128 + 16 * s + 8 * hi);
            acc[blk] = __builtin_amdgcn_mfma_f32_32x32x16_bf16(wf, hf, acc[blk], 0, 0, 0);
        }
    }
    float ss = 0.f;
#pragma unroll
    for (int blk = 0; blk < 2; ++blk)
#pragma unroll
        for (int r = 0; r < 16; ++r) { acc[blk][r] += b2[z * 64 + 32 * blk + crow16(r, hi)]; ss += acc[blk][r] * acc[blk][r]; }
    ss = half_sum(ss);
    const float rs = (z == 0) ? rsqrtf(ss * (1.f / 64.f) + RMS_EPS) : 1.f;
    bf16_t* dst = (z ? VCB : KCB) + ((size_t)((b * 2 + g) * 256) + n) * 64;
#pragma unroll
    for (int blk = 0; blk < 2; ++blk)
#pragma unroll
        for (int gi = 0; gi < 4; ++gi) {
            const int d0 = 32 * blk + 8 * gi + 4 * hi;
            float o[4];
#pragma unroll
            for (int e = 0; e < 4; ++e) o[e] = (n < NCMP) ? acc[blk][4 * gi + e] * rs * (z == 0 ? kn0[d0 + e] : 1.f) : 0.f;
            uint2 wv; wv.x = pk2(o[0], o[1]); wv.y = pk2(o[2], o[3]);
            *(uint2*)(dst + d0) = wv;
        }
}
struct EpiRouter {
    static constexpr bool PERM = false, CHAIN = false;
    float* LOG; const float* SS;
    DEVI void operator()(const f32x4 (&acc)[2][2][4][2], const pg8::Unit& u, int wr, int wc, int fr, int fq) const {
        if (wc >= 2) return;
        const int row0 = u.pm * 256 + wr * 64 + fr, col0 = wc * 32 + 4 * fq;
#pragma unroll
        for (int ai = 0; ai < 2; ++ai)
#pragma unroll
            for (int m = 0; m < 4; ++m) {
                const int row = row0 + ai * 128 + m * 16;
                const float rs = row_rstd16(SS + (size_t)row * 16);
#pragma unroll
                for (int n = 0; n < 2; ++n) *(f32x4*)(LOG + (size_t)row * 64 + col0 + n * 16) = acc[ai][0][m][n] * rs;
            }
    }
};
constexpr int LDS_ROWT = 132096;
struct EpiMoeUp {
    static constexpr bool PERM = true, CHAIN = false;
    bf16_t* HM; const float* wl; const float* rsl;
    DEVI void operator()(const f32x4 (&acc)[2][2][4][2], const pg8::Unit& u, int wr, int wc, int fr, int fq) const {
        const int rl0 = wr * 64 + fr, col0 = (u.pn & 1) * 128 + wc * 32 + 8 * fq;
#pragma unroll
        for (int ai = 0; ai < 2; ++ai)
#pragma unroll
            for (int m = 0; m < 4; ++m) {
                const int rl = rl0 + ai * 128 + m * 16; const float w = wl[u.aux * 256 + rl], rs = rsl[u.aux * 256 + rl];
                float h[8];
#pragma unroll
                for (int n = 0; n < 2; ++n)
#pragma unroll
                    for (int q = 0; q < 4; ++q) { const float g = acc[ai][0][m][n][q] * rs; h[n * 4 + q] = g * sigmoidf_(g) * (acc[ai][1][m][n][q] * rs) * w; }
                uint4 o; o.x = pk2(h[0], h[1]); o.y = pk2(h[2], h[3]); o.z = pk2(h[4], h[5]); o.w = pk2(h[6], h[7]);
                *(uint4*)(HM + (size_t)(u.pm * 256 + rl) * 256 + col0) = o;
            }
    }
};
DEVI void moe_xcd(const int* tb, int G, int bid, int& rt0, int& ntile, int& j, int& per) {
    if ((G & 7) == 0) { const int x = bid & 7; rt0 = tb[4 * x]; ntile = tb[4 * x + 4] - rt0; j = bid >> 3; per = G >> 3; }
    else { rt0 = 0; ntile = tb[NEXP]; j = bid; per = G; }
}
DEVI int moe_rounds(const int* tb, int G, int nsplit) {
    int r = 0;
    if ((G & 7) == 0) { for (int x = 0; x < 8; ++x) { const int u = (tb[4 * x + 4] - tb[4 * x]) * nsplit, q = (u + (G >> 3) - 1) / (G >> 3); r = q > r ? q : r; } }
    else r = (tb[NEXP] * nsplit + G - 1) / G;
    return r;
}
struct MoeUpOrder {
    const int* tb; int G, c, r; const int* tokl;
    DEVI bool unit(int& rt, int& part) const {
        int rt0, ntile, j, per; moe_xcd(tb, G, c, rt0, ntile, j, per);
        const int u = r * per + j; if (u >= ntile * 2) return false;
        rt = rt0 + (u >> 1); part = u & 1; return true;
    }
    DEVI bool next(int i, pg8::Unit& u) const {
        int rt, part; if (i >= 1 || !unit(rt, part)) return false;
        u.pm = rt; u.pn = tb[40 + rt] * 2 + part; u.aux = 0; return true;
    }
    DEVI int a_row(int ord, int r_) const { return tokl[r_]; }
};
DEVI void moe_tables(const int* cnt, int* tb) {
    const int tid = TIDX;
    __syncthreads();
    if (tid == 0) { int a = 0; for (int e = 0; e < NEXP; ++e) { tb[e] = a; a += (cnt[e] + 255) >> 8; } tb[NEXP] = a; }
    __syncthreads();
    if (tid < 192) { int e = 0; for (int q = 1; q < NEXP; ++q) e += (tb[q] <= tid) ? 1 : 0; tb[40 + tid] = e; }
    __syncthreads();
}
DEVI void moe_up_setup(const int* cnt, const int* LIST, const float* RW, const float* SS, int* TOKS, const MoeUpOrder& S, int* tokl, float* wl, float* rsl) {
    const int tid = TIDX;
    __syncthreads();
    if (tid < 256) {
        const int rl = tid;
        int tok = 0; float w = 0.f, rs = 0.f;
        int rt, part;
        if (S.unit(rt, part)) {
            const int e = S.tb[40 + rt], r = (rt - S.tb[e]) * 256 + rl;
            int slot = -1;
            if (r < cnt[e]) { slot = LIST[e * MTOK + r]; tok = slot >> 1; w = RW[slot]; rs = row_rstd16(SS + (size_t)tok * 16); }
            TOKS[rt * 256 + rl] = slot;
        }
        tokl[tid] = tok; wl[tid] = w; rsl[tid] = rs;
    }
    __syncthreads();
}
struct EpiMoeDown {
    static constexpr bool PERM = true, CHAIN = false;
    bf16_t* YS; const int* SLOTS;
    DEVI void operator()(const f32x4 (&acc)[2][2][4][2], const pg8::Unit& u, int wr, int wc, int fr, int fq) const {
        const int row0 = u.pm * 256 + wr * 64 + fr, col0 = (u.pn & 3) * 256 + wc * 32 + 8 * fq;
#pragma unroll
        for (int ai = 0; ai < 2; ++ai)
#pragma unroll
            for (int m = 0; m < 4; ++m) {
                const int slot = SLOTS[row0 + ai * 128 + m * 16];
                if (slot >= 0) {
                    bf16_t* dst = YS + (size_t)slot * DM + col0;
#pragma unroll
                    for (int bj = 0; bj < 2; ++bj) {
                        uint4 w; w.x = pk2(acc[ai][bj][m][0][0], acc[ai][bj][m][0][1]); w.y = pk2(acc[ai][bj][m][0][2], acc[ai][bj][m][0][3]);
                        w.z = pk2(acc[ai][bj][m][1][0], acc[ai][bj][m][1][1]); w.w = pk2(acc[ai][bj][m][1][2], acc[ai][bj][m][1][3]);
                        *(uint4*)(dst + bj * 128) = w;
                    }
                }
                asm volatile("" ::: "memory");
            }
    }
};
DEVI void phase_combine(bf16_t* XB, const bf16_t* YS, float* rstd, float* xout, bool next) {
    const int tid = TIDX; const int bid = BIDX; const int lane = tid & 63, gw = bid * 8 + (tid >> 6), ngw = gridDim.x * 8;
    for (int m0 = gw * 2; m0 < MTOK; m0 += ngw * 2) {
        uint2 xv[2][4], a[2][4], b[2][4];
#pragma unroll
        for (int u = 0; u < 2; ++u) {
            const int m = m0 + u;
            const uint2* xr = (const uint2*)(XB + (size_t)m * DM) + lane;
            const uint2* y0 = (const uint2*)(YS + (size_t)(2 * m) * DM) + lane; const uint2* y1 = (const uint2*)(YS + (size_t)(2 * m + 1) * DM) + lane;
#pragma unroll
            for (int j = 0; j < 4; ++j) { xv[u][j] = xr[64 * j]; a[u][j] = y0[64 * j]; b[u][j] = y1[64 * j]; }
        }
#pragma unroll
        for (int u = 0; u < 2; ++u) {
            const int m = m0 + u;
            f32x4* xr = (f32x4*)(xout + (size_t)m * DM) + lane; uint2* xo = (uint2*)(XB + (size_t)m * DM) + lane;
            float s = 0.f;
#pragma unroll
            for (int j = 0; j < 4; ++j) {
                const uint2 xx = xv[u][j], aa = a[u][j], bb = b[u][j];
                f32x4 w;
                w[0] = __uint_as_float(xx.x << 16) + __uint_as_float(aa.x << 16) + __uint_as_float(bb.x << 16); w[1] = __uint_as_float(xx.x & 0xffff0000u) + __uint_as_float(aa.x & 0xffff0000u) + __uint_as_float(bb.x & 0xffff0000u);
                w[2] = __uint_as_float(xx.y << 16) + __uint_as_float(aa.y << 16) + __uint_as_float(bb.y << 16); w[3] = __uint_as_float(xx.y & 0xffff0000u) + __uint_as_float(aa.y & 0xffff0000u) + __uint_as_float(bb.y & 0xffff0000u);
                if (next) {
                    uint2 o; o.x = pk2(w[0], w[1]); o.y = pk2(w[2], w[3]); xo[64 * j] = o;
                    const float r0 = __uint_as_float(o.x << 16), r1 = __uint_as_float(o.x & 0xffff0000u), r2 = __uint_as_float(o.y << 16), r3 = __uint_as_float(o.y & 0xffff0000u);
                    s += r0 * r0 + r1 * r1 + r2 * r2 + r3 * r3;
                } else xr[64 * j] = w;
            }
            if (next) { s = wave_sum(s); if (lane == 0) rstd[m] = rsqrtf(s * (1.f / DM) + RMS_EPS); }
        }
    }
}
struct MoeOrder {
    const int* tb; int nsplit, G, c;
    DEVI bool next(int i, pg8::Unit& u) const {
        int rt0, ntile, j, per; moe_xcd(tb, G, c, rt0, ntile, j, per);
        const int L = i * per + j; if (L >= ntile * nsplit) return false;
        const int rt = rt0 + L / nsplit, part = L % nsplit;
        u.pm = rt; u.pn = tb[40 + rt] * nsplit + part; return true;
    }
};

DEVI void phase_gather(const bf16_t* XB, const float* SS, const int* cnt, const int* LIST, const float* RW, bf16_t* XG, int* TOKS, float* RWS, int* tb) {
    const int tid = TIDX; const int bid = BIDX; const int lane = tid & 63, gw = bid * 8 + (tid >> 6), ngw = gridDim.x * 8;
    if (tid == 0) { int a = 0; for (int e = 0; e < NEXP; ++e) { tb[e] = a; a += (cnt[e] + 255) >> 8; } tb[NEXP] = a; }
    __syncthreads();
    if (tid < 192) { int e = 0; for (int q = 1; q < NEXP; ++q) e += (tb[q] <= tid) ? 1 : 0; tb[40 + tid] = e; }
    __syncthreads();
    const int total = tb[NEXP] * 256;
    for (int rp0 = gw * 4; rp0 < total; rp0 += ngw * 4) {
        int slot[4]; bool ok[4];
#pragma unroll
        for (int q = 0; q < 4; ++q) {
            const int rp = rp0 + q, rt = rp >> 8;
            const int e = tb[40 + rt];
            const int r = rp - tb[e] * 256;
            ok[q] = r < cnt[e];
            slot[q] = ok[q] ? LIST[e * MTOK + r] : 0;
        }
        uint4 xr[4][2]; float rs[4], rw[4];
#pragma unroll
        for (int q = 0; q < 4; ++q) {
            const int tok = slot[q] >> 1;
            rs[q] = row_rstd16(SS + (size_t)tok * 16); rw[q] = RW[slot[q]];
            const uint4* xp = (const uint4*)(XB + (size_t)tok * DM) + lane;
            xr[q][0] = xp[0]; xr[q][1] = xp[64];
        }
#pragma unroll
        for (int q = 0; q < 4; ++q) {
            const int rp = rp0 + q;
            if (ok[q]) {
                uint4* xo = (uint4*)(XG + (size_t)rp * DM) + lane;
#pragma unroll
                for (int j = 0; j < 2; ++j) { float v[8]; unpack8(xr[q][j], v); const float s = rs[q]; uint4 o; o.x = pk2(v[0] * s, v[1] * s); o.y = pk2(v[2] * s, v[3] * s); o.z = pk2(v[4] * s, v[5] * s); o.w = pk2(v[6] * s, v[7] * s); xo[64 * j] = o; }
            }
            if (lane == 0) { TOKS[rp] = ok[q] ? slot[q] : -1; RWS[rp] = ok[q] ? rw[q] : 0.f; }
        }
    }
}

#ifndef NSA_FAST
#define NSA_FAST 1
#endif
DEVI void phase_qknorm(bf16_t* Y, const float* qn  , const float* kn  , int vb, int vg) {
    const int tid = TIDX; const int bid = vb; const int lane = tid & 63, gw = bid * 8 + (tid >> 6), ngw = vg * 8;
    const int sl = lane >> 4, e0 = (lane & 15) * 4;
    const int col2 = (sl < 2 ? OFF_KS + sl * 64 : OFF_KW + (sl - 2) * 64);
    const float* gn2 = kn + (sl < 2 ? 64 : 128);
    float g[3][4];
#pragma unroll
    for (int e = 0; e < 4; ++e) { g[0][e] = qn[e0 + e]; g[1][e] = g[0][e]; g[2][e] = gn2[e0 + e]; }
#if NSA_FAST
#pragma unroll
    for (int e = 0; e < 4; ++e) { g[0][e] *= 0.125f * 1.4426950408889634f; g[1][e] *= 0.125f * 1.4426950408889634f; }
#endif
    for (int m0 = gw * 2; m0 < MTOK; m0 += ngw * 2) {
        uint2 raw[2][3];
#pragma unroll
        for (int u = 0; u < 2; ++u) {
            bf16_t* row = Y + (size_t)(m0 + u) * LDY;
            raw[u][0] = *(const uint2*)(row + OFF_Q + sl * 64 + e0); raw[u][1] = *(const uint2*)(row + OFF_Q + (4 + sl) * 64 + e0); raw[u][2] = *(const uint2*)(row + col2 + e0);
        }
#pragma unroll
        for (int u = 0; u < 2; ++u) {
            bf16_t* row = Y + (size_t)(m0 + u) * LDY;
#pragma unroll
            for (int part = 0; part < 3; ++part) {
                const uint2 r = raw[u][part];
                const float v0 = __uint_as_float(r.x << 16), v1 = __uint_as_float(r.x & 0xffff0000u), v2 = __uint_as_float(r.y << 16), v3 = __uint_as_float(r.y & 0xffff0000u);
                float s = v0 * v0 + v1 * v1 + v2 * v2 + v3 * v3;
                s += shx(s, 1); s += shx(s, 2); s += shx(s, 4); s += shx(s, 8);
                const float rs = rsqrtf(s * (1.f / 64.f) + RMS_EPS);
                uint2 o; o.x = pk2(v0 * rs * g[part][0], v1 * rs * g[part][1]); o.y = pk2(v2 * rs * g[part][2], v3 * rs * g[part][3]);
                *(uint2*)(row + (part == 0 ? OFF_Q + sl * 64 : (part == 1 ? OFF_Q + (4 + sl) * 64 : col2)) + e0) = o;
            }
        }
    }
}

DEVI void phase_rglru1(const bf16_t* Y, const float* convw  , const float* convb, const float* wa  , const float* ba,
                       const float* wx, const float* bx, const float* lam, float* LA, bf16_t* VV, float* PA, float* PH, float* lds, int vb, int vg) {
    bf16_t* UB = (bf16_t*)lds;
    bf16_t* WT = UB + 64 * 72;
    float* SEG = (float*)(WT + 128 * 72);
    const int tid = TIDX;
    const int n = vb & 7;
    const int nper = vg >> 3;
    if ((vb >> 3) >= nper) return;
    __syncthreads();
    for (int e = tid; e < 8192; e += 512) {
        const int o = e & 127, i = e >> 7;
        WT[o * 72 + i] = f2bf(o < 64 ? wa[n * 4096 + i * 64 + o] : wx[n * 4096 + i * 64 + o - 64]);
    }
    const int j = tid & 63, tg = tid >> 6;
    const int lane = tid & 63, w = tid >> 6, mt = w & 3, cgp = w >> 2;
    const int chj = n * 64 + j;
    const float cw0 = convw[chj], cw1 = convw[512 + chj], cw2 = convw[1024 + chj], cw3 = convw[1536 + chj], cb = convb[chj];
    float bav[2], bxv[2], sp[2];
#pragma unroll
    for (int q = 0; q < 2; ++q) {
        const int ch = n * 64 + 16 * (cgp * 2 + q) + (lane & 15);
        bav[q] = ba[ch]; bxv[q] = bx[ch];
        const float ex = __expf(-lam[ch]);
        sp[q] = (ex < 0.03f) ? ex * (1.f - ex * (0.5f - ex * (0.33333334f - 0.25f * ex))) : __logf(1.f + ex);
    }
    float xin[2][11];
    const int c00 = vb >> 3;
#pragma unroll
    for (int u = 0; u < 2; ++u) {
        const int c = c00 + u * nper; const int tl0 = (c & 63) * 64; const size_t m0 = (size_t)c * 64;
#pragma unroll
        for (int i = 0; i < 11; ++i) { const int t = tg * 8 + i - 3; xin[u][i] = (c < 256 && tl0 + t >= 0) ? bf2f(Y[(m0 + t) * LDY + OFF_RX + chj]) : 0.f; }
    }
    bf16_t* UB1 = (bf16_t*)(SEG + 2 * 16 * 64 * 2);
    for (int c0 = c00; c0 < 256; c0 += 2 * nper) {
        __syncthreads();
#pragma unroll
        for (int u = 0; u < 2; ++u) {
            bf16_t* ub = u ? UB1 : UB;
#pragma unroll
            for (int q = 0; q < 8; ++q) ub[(tg * 8 + q) * 72 + j] = f2bf(cb + cw0 * xin[u][q] + cw1 * xin[u][q + 1] + cw2 * xin[u][q + 2] + cw3 * xin[u][q + 3]);
        }
#pragma unroll
        for (int u = 0; u < 2; ++u) {
            const int cn = c0 + (2 + u) * nper; const int tl0 = (cn & 63) * 64; const size_t mn = (size_t)cn * 64;
            if (cn < 256) {
#pragma unroll
                for (int i = 0; i < 11; ++i) { const int t = tg * 8 + i - 3; xin[u][i] = (tl0 + t >= 0) ? bf2f(Y[(mn + t) * LDY + OFF_RX + chj]) : 0.f; }
            }
        }
        __syncthreads();
#pragma unroll
        for (int u = 0; u < 2; ++u) {
            const int c = c0 + u * nper;
            if (c >= 256) continue;
            const bf16_t* ub = u ? UB1 : UB; float* seg = SEG + u * (16 * 64 * 2);
            const size_t m0 = (size_t)c * 64;
            f32x4 accr[2], acci[2];
#pragma unroll
            for (int q = 0; q < 2; ++q) { accr[q] = zero4(); acci[q] = zero4(); }
#pragma unroll
            for (int ks = 0; ks < 2; ++ks) {
                const bf16x8 af = *(const bf16x8*)(ub + (16 * mt + (lane & 15)) * 72 + 8 * (lane >> 4) + 32 * ks);
#pragma unroll
                for (int q = 0; q < 2; ++q) {
                    const int o = 16 * (cgp * 2 + q) + (lane & 15);
                    const bf16x8 br_ = *(const bf16x8*)(WT + o * 72 + 8 * (lane >> 4) + 32 * ks);
                    const bf16x8 bi_ = *(const bf16x8*)(WT + (64 + o) * 72 + 8 * (lane >> 4) + 32 * ks);
                    accr[q] = __builtin_amdgcn_mfma_f32_16x16x32_bf16(af, br_, accr[q], 0, 0, 0);
                    acci[q] = __builtin_amdgcn_mfma_f32_16x16x32_bf16(af, bi_, acci[q], 0, 0, 0);
                }
            }
#pragma unroll
            for (int q = 0; q < 2; ++q) {
                const int cl = 16 * (cgp * 2 + q) + (lane & 15), ch = n * 64 + cl;
                float hseg = 0.f, aseg = 1.f;
#pragma unroll
                for (int r = 0; r < 4; ++r) {
                    const int t = 16 * mt + 4 * (lane >> 4) + r;
                    const float rg = sigmoidf_(accr[q][r] + bav[q]), ig = sigmoidf_(acci[q][r] + bxv[q]);
                    const float la = -8.0f * rg * sp[q];
                    const float y2 = 2.f * la;
                    const float om = (y2 > -0.01f) ? -y2 * (1.f + y2 * (0.5f + y2 * 0.16666667f)) : 1.f - __expf(y2);
                    const bf16_t vb16 = f2bf(sqrtf(om) * ig * bf2f(ub[t * 72 + cl]));
                    LA[(m0 + t) * 512 + ch] = la; VV[(m0 + t) * 512 + ch] = vb16;
                    const float a = __expf(la);
                    hseg = a * hseg + bf2f(vb16); aseg *= a;
                }
                const int sg = 4 * mt + (lane >> 4);
                seg[(sg * 64 + cl) * 2] = aseg; seg[(sg * 64 + cl) * 2 + 1] = hseg;
            }
        }
        __syncthreads();
        if (tid < 128) {
            const int u = tid >> 6, cl = tid & 63, c = c0 + u * nper;
            if (c < 256) {
                const float* seg = SEG + u * (16 * 64 * 2);
                float h = 0.f, A = 1.f;
#pragma unroll
                for (int s = 0; s < 16; ++s) { const float a = seg[(s * 64 + cl) * 2]; h = a * h + seg[(s * 64 + cl) * 2 + 1]; A *= a; }
                PA[c * 512 + n * 64 + cl] = A; PH[c * 512 + n * 64 + cl] = h;
            }
        }
    }
    __syncthreads();
}

DEVI void phase_shortconv(bf16_t* Y, const float* w  , int vb, int vg) {
    const int tid = TIDX; const int bid = vb; const int gt = bid * 512 + tid, ngt = vg * 512;
    for (int it = gt; it < (MTOK / 8) * 64; it += ngt) {
        const int cg8 = (it & 63) * 8, m0 = (it >> 6) * 8, tl0 = m0 & (SEQ - 1);
        float wk[3][8];
#pragma unroll
        for (int k = 0; k < 3; ++k) load8f(w + k * 512 + cg8, wk[k]);
        uint4 rc[10], rh[10], rb[8];
#pragma unroll
        for (int i = 0; i < 10; ++i) {
            const int d = i - 2;
            if (tl0 + d >= 0) { const bf16_t* r = Y + (size_t)(m0 + d) * LDY; rc[i] = *(const uint4*)(r + OFF_SC + cg8); rh[i] = *(const uint4*)(r + OFF_SH + cg8); }
            else { rc[i] = make_uint4(0, 0, 0, 0); rh[i] = make_uint4(0, 0, 0, 0); }
        }
#pragma unroll
        for (int i = 0; i < 8; ++i) rb[i] = *(const uint4*)(Y + (size_t)(m0 + i) * LDY + OFF_SB + cg8);
        float p[10][8];
#pragma unroll
        for (int i = 0; i < 10; ++i) { float a[8], b2[8]; unpack8(rc[i], a); unpack8(rh[i], b2);
#pragma unroll
            for (int e = 0; e < 8; ++e) p[i][e] = a[e] * b2[e]; }
#pragma unroll
        for (int i = 0; i < 8; ++i) {
            float sb[8]; unpack8(rb[i], sb);
            float o[8];
#pragma unroll
            for (int e = 0; e < 8; ++e) o[e] = sb[e] * (wk[0][e] * p[i][e] + wk[1][e] * p[i + 1][e] + wk[2][e] * p[i + 2][e]);
            uint4 ow; ow.x = pk2(o[0], o[1]); ow.y = pk2(o[2], o[3]); ow.z = pk2(o[4], o[5]); ow.w = pk2(o[6], o[7]);
            *(uint4*)(Y + (size_t)(m0 + i) * LDY + OFF_SB + cg8) = ow;
        }
    }
}

DEVI void phase_cmp1(const bf16_t* Y, const float* pe  , const float* w1  , const float* b1  , float* HID, bf16_t* As, bf16_t* Bs) {
    const int tid = TIDX; const int bid = BIDX;
    for (int t = bid; t < 32; t += gridDim.x) {
        const int z = t >> 4, rt = t & 15;
        const int r = rt * 128 + (tid >> 2);
        const bool rv = r < NB * NCMP * 2;
        const int g = r & 1, bn_ = r >> 1, b = bn_ / NCMP, n = bn_ % NCMP;
        const bf16_t* abase = Y + (size_t)(b * SEQ + 16 * n) * LDY + (z ? OFF_VC : OFF_KC) + g * 64;
        const float* pez = pe + z * 2048;
        const float* wz = w1 + (size_t)z * 2048 * 128 + (tid & 15) * 8;
        f32x4 acc[2][4]; acc_zero(acc);
        gemm_tile(tid, acc, 2048, As, Bs,
                  [&](int k, float (&v)[8]) {
                      if (rv) { const int lp = k >> 6, d = k & 63; load8b(abase + (size_t)lp * LDY + d, v);
#pragma unroll
                          for (int j = 0; j < 8; ++j) v[j] += pez[k + j]; }
                      else zero8(v); },
                  [&](int k, float (&v)[8]) { load8f(wz + (size_t)k * 128, v); });
#pragma unroll
        for (int i = 0; i < 2; ++i) {
            const int rr = rt * 128 + ACC_ROW(i);
#pragma unroll
            for (int j = 0; j < 4; ++j) {
                const int c = ACC_COL(j);
                f32x4 o;
#pragma unroll
                for (int e = 0; e < 4; ++e) o[e] = gelu_tanh(acc[i][j][e] + b1[z * 128 + c + e]);
                *(f32x4*)(HID + ((size_t)z * 2048 + rr) * 128 + c) = o;
            }
        }
    }
}

DEVI void phase_cmp2_carry(const float* HID, const float* w2  , const float* b2  , const float* kn0  , float* KCMP, float* VCMP,
                           bf16_t* KCB, bf16_t* VCB) {
    const int tid = TIDX; const int bid = BIDX; const int lane = tid & 63, gw = bid * 8 + (tid >> 6), ngw = gridDim.x * 8;
    for (int it = gw; it < 2 * NB * NCMP * 2; it += ngw) {
        const int z = it / (NB * NCMP * 2), r = it % (NB * NCMP * 2);
        const float* h = HID + ((size_t)z * 2048 + r) * 128;
        const float* w = w2 + z * 8192 + lane;
        float acc = b2[z * 64 + lane];
        for (int j = 0; j < 128; ++j) acc += h[j] * w[j * 64];
        const int g = r & 1, bn_ = r >> 1, b = bn_ / NCMP, n = bn_ % NCMP;
        float* dst = (z ? VCMP : KCMP) + ((size_t)(b * 256 + n) * 2 + g) * 64 + lane;
        if (z == 0) { const float s = wave_sum(acc * acc); acc = acc * rsqrtf(s * (1.f / 64.f) + RMS_EPS) * kn0[lane]; }
        *dst = acc;
        (z ? VCB : KCB)[((size_t)((b * 2 + g) * 256) + n) * 64 + lane] = f2bf(acc);
    }
    if (gw < 16) { const int z = gw >> 3, bg = gw & 7; (z ? VCB : KCB)[((size_t)(bg * 256) + 255) * 64 + lane] = 0; }
}

DEVI void phase_rglru2(bf16_t* __restrict__ Y, const float* __restrict__ LA, const bf16_t* __restrict__ VV, const float* __restrict__ PA, const float* __restrict__ PH) {
    const int tid = TIDX; const int bid = BIDX; const int gt = bid * 512 + tid, ngt = gridDim.x * 512;
    for (int e = gt; e < 256 * 512; e += ngt) {
        const int c = e >> 9, ch = e & 511, cl = c & 63;
        const float* pa = PA + (size_t)(c - cl) * 512 + ch; const float* ph = PH + (size_t)(c - cl) * 512 + ch;
        float h = 0.f;
#pragma unroll 8
        for (int cc = 0; cc < cl; ++cc) h = pa[cc * 512] * h + ph[cc * 512];
        const size_t m0 = (size_t)c * 64;
#pragma unroll 1
        for (int t0 = 0; t0 < 64; t0 += 8) {
            float la[8], vv[8], ry[8];
#pragma unroll
            for (int i = 0; i < 8; ++i) { const size_t m = m0 + t0 + i; la[i] = LA[m * 512 + ch]; vv[i] = bf2f(VV[m * 512 + ch]); ry[i] = bf2f(Y[m * LDY + OFF_RY + ch]); }
#pragma unroll
            for (int i = 0; i < 8; ++i) { h = __expf(la[i]) * h + vv[i]; ry[i] *= h; }
#pragma unroll
            for (int i = 0; i < 8; ++i) Y[(m0 + t0 + i) * LDY + OFF_RY + ch] = f2bf(ry[i]);
        }
    }
}

DEVI void attend_block(const bf16_t* Y, int b, int g, int j, int t, int lo, int offk, int offv, const float* qs, float* ps, float (&mx)[4], float (&l)[4], float (&o)[4], int lane) {
    const int pos = 64 * j + lane;
    const bool valid = (pos <= t) && (pos >= lo);
    const bf16_t* kr = Y + (size_t)(b * SEQ + pos) * LDY + offk + g * 64;
    float s[4] = {0.f, 0.f, 0.f, 0.f};
#pragma unroll 2
    for (int d8 = 0; d8 < 8; ++d8) {
        float kv[8]; load8b(kr + d8 * 8, kv);
#pragma unroll
        for (int h = 0; h < 4; ++h) {
            const f32x4 qa = *(const f32x4*)(qs + h * 64 + d8 * 8), qb = *(const f32x4*)(qs + h * 64 + d8 * 8 + 4);
            s[h] += qa[0] * kv[0] + qa[1] * kv[1] + qa[2] * kv[2] + qa[3] * kv[3] + qb[0] * kv[4] + qb[1] * kv[5] + qb[2] * kv[6] + qb[3] * kv[7];
        }
    }
    LDS_FENCE();
#pragma unroll
    for (int h = 0; h < 4; ++h) {
        const float sv = valid ? s[h] : -1e30f;
        const float mn = fmaxf(mx[h], wave_max(sv));
        const float corr = __expf(mx[h] - mn);
        const float p = valid ? __expf(sv - mn) : 0.f;
        l[h] = l[h] * corr + wave_sum(p);
        o[h] *= corr; mx[h] = mn;
        ps[h * 64 + lane] = p;
    }
    LDS_FENCE();
    const bf16_t* vr = Y + (size_t)(b * SEQ + 64 * j) * LDY + offv + g * 64 + lane;
    for (int k = 0; k < 64; ++k) {
        const float v = bf2f(vr[(size_t)k * LDY]);
#pragma unroll
        for (int h = 0; h < 4; ++h) o[h] += ps[h * 64 + k] * v;
    }
    LDS_FENCE();
}

DEVI void phase_nsa(bf16_t* Y, const float* KCMP, const float* VCMP, float* lds) {
    const int tid = TIDX; const int bid = BIDX; const int lane = tid & 63, wv = tid >> 6, gw = bid * 8 + wv, ngw = gridDim.x * 8;
    float* qs = lds + wv * 1536;
    float* ps = qs + 256;
    float* pss = ps + 1024;
    for (int it = gw; it < MTOK * 2; it += ngw) {
        const int g = it & 1, m = it >> 1, b = m >> 12, t = m & (SEQ - 1);
        bf16_t* qrow = Y + (size_t)m * LDY + OFF_Q + g * 256;
        LDS_FENCE();
#pragma unroll
        for (int h = 0; h < 4; ++h) qs[h * 64 + lane] = bf2f(qrow[h * 64 + lane]) * 0.125f;
        LDS_FENCE();
        const int nvalid = (t >= 31) ? ((t - 31) / 16 + 1) : 0;
        float sc[4][4];
#pragma unroll
        for (int i = 0; i < 4; ++i) {
            const int n = lane + 64 * i;
#pragma unroll
            for (int h = 0; h < 4; ++h) sc[i][h] = -1e30f;
            if (n < nvalid) {
                const float* kp = KCMP + ((size_t)(b * 256 + n) * 2 + g) * 64;
                float s[4] = {0.f, 0.f, 0.f, 0.f};
#pragma unroll 4
                for (int d4 = 0; d4 < 16; ++d4) {
                    const f32x4 kv = *(const f32x4*)(kp + d4 * 4);
#pragma unroll
                    for (int h = 0; h < 4; ++h) { const f32x4 qa = *(const f32x4*)(qs + h * 64 + d4 * 4); s[h] += qa[0] * kv[0] + qa[1] * kv[1] + qa[2] * kv[2] + qa[3] * kv[3]; }
                }
#pragma unroll
                for (int h = 0; h < 4; ++h) sc[i][h] = s[h];
            }
        }
        float psum[4] = {0.f, 0.f, 0.f, 0.f};
#pragma unroll
        for (int h = 0; h < 4; ++h) {
            const float mxv = wave_max(fmaxf(fmaxf(sc[0][h], sc[1][h]), fmaxf(sc[2][h], sc[3][h])));
            float p[4], su = 0.f;
#pragma unroll
            for (int i = 0; i < 4; ++i) { p[i] = (lane + 64 * i < nvalid) ? __expf(sc[i][h] - mxv) : 0.f; su += p[i]; }
            su = wave_sum(su);
            const float inv = nvalid > 0 ? 1.f / su : 0.f;
#pragma unroll
            for (int i = 0; i < 4; ++i) { p[i] *= inv; ps[h * 256 + lane + 64 * i] = p[i]; psum[i] += p[i]; }
        }
#pragma unroll
        for (int i = 0; i < 4; ++i) pss[lane + 64 * i] = psum[i];
        LDS_FENCE();
        float oc[4] = {0.f, 0.f, 0.f, 0.f};
        for (int n = 0; n < nvalid; ++n) {
            const float v = VCMP[((size_t)(b * 256 + n) * 2 + g) * 64 + lane];
#pragma unroll
            for (int h = 0; h < 4; ++h) oc[h] += ps[h * 256 + n] * v;
        }
        const int j = lane, cur = t >> 6;
        float imp = pss[4 * j] + pss[4 * j + 1] + pss[4 * j + 2] + 0.5f * pss[4 * j + 3];
        if (j >= 1) imp += 0.5f * pss[4 * j - 1];
        LDS_FENCE();
        const bool forced = (j == 0) || (j == cur) || (j + 1 == cur);
        const bool cand = (j >= 1) && (j + 2 <= cur);
        const int nforced = cur == 0 ? 1 : (cur == 1 ? 2 : 3), quota = 16 - nforced;
        bool sel;
        if (cur - 2 <= quota) sel = forced || cand;
        else {
            int rank = 0;
            for (int jj = 1; jj <= cur - 2; ++jj) { const float v = __shfl(imp, jj); rank += ((v > imp) || (v == imp && jj < j)) ? 1 : 0; }
            sel = forced || (cand && rank < quota);
        }
        unsigned long long mask = __ballot(sel);
        float ms[4], ls[4], os[4];
#pragma unroll
        for (int h = 0; h < 4; ++h) { ms[h] = -1e30f; ls[h] = 0.f; os[h] = 0.f; }
        while (mask) {
            const int jb = __builtin_ctzll(mask); mask &= mask - 1;
            attend_block(Y, b, g, jb, t, 0, OFF_KS, OFF_VS, qs, ps, ms, ls, os, lane);
        }
        float mw[4], lw[4], ow[4];
#pragma unroll
        for (int h = 0; h < 4; ++h) { mw[h] = -1e30f; lw[h] = 0.f; ow[h] = 0.f; }
        const int lo = t - 511 > 0 ? t - 511 : 0;
        for (int jb = lo >> 6; jb <= cur; ++jb) attend_block(Y, b, g, jb, t, lo, OFF_KW, OFF_VW, qs, ps, mw, lw, ow, lane);
        const bf16_t* gp = Y + (size_t)m * LDY + OFF_NG + g * 12;
#pragma unroll
        for (int h = 0; h < 4; ++h) {
            const float gc = bf2f(gp[h * 3]), gs = bf2f(gp[h * 3 + 1]), gwn = bf2f(gp[h * 3 + 2]);
            const float o = gc * oc[h] + gs * os[h] / ls[h] + gwn * ow[h] / lw[h];
            qrow[h * 64 + lane] = f2bf(o);
        }
    }
}

DEVI float ld_sc1(const float* p) { return __hip_atomic_load(p, __ATOMIC_RELAXED, __HIP_MEMORY_SCOPE_AGENT); }
DEVI void router_finalize(int m, int t, const float* LOG, const float* bg, const float* be, int* cnt  , int* LIST, float* RW, volatile int* hist  ) {
    const float* lg = LOG + (size_t)m * 64;
    float gl[4];
#pragma unroll
    for (int o = 0; o < 4; ++o) gl[o] = ld_sc1(lg + o) + bg[o];
    int grp = 0; float gmax = gl[0];
#pragma unroll
    for (int o = 1; o < 4; ++o) if (gl[o] > gmax) { gmax = gl[o]; grp = o; }
    float gs = 0.f;
#pragma unroll
    for (int o = 0; o < 4; ++o) gs += __expf(gl[o] - gmax);
    const float pgrp = 1.f / gs;
    float el[8];
#pragma unroll
    for (int i = 0; i < 8; ++i) el[i] = ld_sc1(lg + 4 + grp * 8 + i) + be[grp * 8 + i];
    int i0 = 0; float m0 = el[0];
#pragma unroll
    for (int i = 1; i < 8; ++i) if (el[i] > m0) { m0 = el[i]; i0 = i; }
    int i1 = -1; float m1 = -3.0e38f;
#pragma unroll
    for (int i = 0; i < 8; ++i) if (i != i0 && el[i] > m1) { m1 = el[i]; i1 = i; }
    const float e1 = __expf(m1 - m0);
    const float w0 = pgrp / (1.f + e1), w1 = pgrp * e1 / (1.f + e1);
    const int ea = grp * 8 + i0, eb = grp * 8 + i1;
    if (t < 32) hist[t] = 0;
    __syncthreads();
    const bool act = t < 256;
    int ra = 0, rb = 0;
    if (act) { ra = atomicAdd((int*)hist + ea, 1); rb = atomicAdd((int*)hist + eb, 1); }
    __syncthreads();
    if (t < 32) hist[32 + t] = atomicAdd(cnt + t, hist[t]);
    __syncthreads();
    if (act) {
        LIST[ea * MTOK + hist[32 + ea] + ra] = m * 2;
        LIST[eb * MTOK + hist[32 + eb] + rb] = m * 2 + 1;
        RW[m * 2] = w0; RW[m * 2 + 1] = w1;
    }
}


struct NsaCtx {
    LAS3 unsigned char* lds;
    int tid, lane, r32, hi, w;
    unsigned okY, ovY, okC, ovC;
};
DEVI void nsa_dma(const NsaCtx& c, int slot, const bf16_t* kbase, const bf16_t* vbase, unsigned ok, unsigned ov) {
    __builtin_amdgcn_global_load_lds((const unsigned*)((const char*)kbase + ok), (LAS3 unsigned*)(c.lds + slot * 16384 + c.w * 1024), 16, 0, 0);
    __builtin_amdgcn_global_load_lds((const unsigned*)((const char*)vbase + ov), (LAS3 unsigned*)(c.lds + slot * 16384 + 8192 + c.w * 1024), 16, 0, 0);
}
#define NSA_WAIT_BAR(N) do { asm volatile("s_waitcnt vmcnt(" #N ")" ::: "memory"); __builtin_amdgcn_s_barrier(); asm volatile("" ::: "memory"); } while (0)
template <class NextFn, class SrcFn, class BodyFn>
DEVI void nsa_run(const NsaCtx& c, int& slot, int first, unsigned ok, unsigned ov, NextFn next, SrcFn srcf, BodyFn body) {
    int t0 = first, t1 = next(t0);
    { const bf16_t* kb; const bf16_t* vb; srcf(t0, kb, vb); nsa_dma(c, slot, kb, vb, ok, ov); }
    if (t1 >= 0) { const bf16_t* kb; const bf16_t* vb; srcf(t1, kb, vb); nsa_dma(c, slot == 2 ? 0 : slot + 1, kb, vb, ok, ov); }
#pragma unroll 1
    while (t0 >= 0) {
        if (t1 >= 0) NSA_WAIT_BAR(2); else NSA_WAIT_BAR(0);
        const int t2 = (t1 >= 0) ? next(t1) : -1;
        if (t2 >= 0) { const bf16_t* kb; const bf16_t* vb; srcf(t2, kb, vb); nsa_dma(c, slot == 0 ? 2 : slot - 1, kb, vb, ok, ov); }
        body(t0, slot);
        t0 = t1; t1 = t2; slot = slot == 2 ? 0 : slot + 1;
    }
}
DEVI void nsa_scores(const NsaCtx& c, int buf, const f32x16& z, f32x16& p0, f32x16& p1) {
    const LAS3 bf16x8* qfl = (const LAS3 bf16x8*)(c.lds + NSA_QF) + c.tid;
    const LAS3 unsigned char* kb = c.lds + buf * 16384 + c.r32 * 128;
    const int sw = (c.r32 >> 1) & 7;
#pragma unroll
    for (int s = 0; s < 4; ++s) {
        const bf16x8 k0 = *(const LAS3 bf16x8*)(kb + (((2 * s + c.hi) ^ sw) * 16));
        const bf16x8 k1 = *(const LAS3 bf16x8*)(kb + 4096 + (((2 * s + c.hi) ^ sw) * 16));
        if (s == 0) {
            const bf16x8 q = qfl[0]; p0 = __builtin_amdgcn_mfma_f32_32x32x16_bf16(k0, q, z, 0, 0, 0); p1 = __builtin_amdgcn_mfma_f32_32x32x16_bf16(k1, q, z, 0, 0, 0); }
        else { const bf16x8 q = qfl[s * 512]; p0 = __builtin_amdgcn_mfma_f32_32x32x16_bf16(k0, q, p0, 0, 0, 0); p1 = __builtin_amdgcn_mfma_f32_32x32x16_bf16(k1, q, p1, 0, 0, 0); }
    }
}
DEVI unsigned nsa_pk(float lo, float hi) { return pg8::cvt_pk_bf16(lo, hi); }
DEVI void nsa_pack(const f32x16& p0, const f32x16& p1, bf16x8 (&pa)[4]) {
#pragma unroll
    for (int s = 0; s < 4; ++s) {
        const f32x16& p = (s < 2) ? p0 : p1; const int b = (s & 1) * 8;
        uint4 w; w.x = nsa_pk(p[b], p[b + 1]); w.y = nsa_pk(p[b + 2], p[b + 3]); w.z = nsa_pk(p[b + 4], p[b + 5]); w.w = nsa_pk(p[b + 6], p[b + 7]);
        pa[s] = __builtin_bit_cast(bf16x8, w);
    }
}
DEVI void nsa_pv(const NsaCtx& c, int buf, const bf16x8 (&pa)[4], f32x16 (&o)[2]) {
    const unsigned vb = (unsigned)(uintptr_t)(c.lds + buf * 16384 + 8192 + (4 * c.hi + ((c.lane & 15) >> 2)) * 64 + ((c.lane >> 4) & 1) * 32 + (c.lane & 3) * 8);
#pragma unroll
    for (int d0 = 0; d0 < 2; ++d0) {
        s16x4 lo[4], hi[4];
#pragma unroll
        for (int s = 0; s < 4; ++s) {
            asm volatile("ds_read_b64_tr_b16 %0, %1 offset:%c2" : "=&v"(lo[s]) : "v"(vb), "i"(d0 * 4096 + s * 1024) : "memory");
            asm volatile("ds_read_b64_tr_b16 %0, %1 offset:%c2" : "=&v"(hi[s]) : "v"(vb), "i"(d0 * 4096 + s * 1024 + 512) : "memory");
        }
        asm volatile("s_waitcnt lgkmcnt(0)" ::: "memory");
        __builtin_amdgcn_sched_barrier(0);
#pragma unroll
        for (int s = 0; s < 4; ++s)
            o[d0] = __builtin_amdgcn_mfma_f32_32x32x16_bf16((bf16x8){lo[s][0], lo[s][1], lo[s][2], lo[s][3], hi[s][0], hi[s][1], hi[s][2], hi[s][3]}, pa[s], o[d0], 0, 0, 0);
    }
}
typedef float f32x2v __attribute__((ext_vector_type(2)));
DEVI void nsa_exp_all(f32x16& p0, f32x16& p1) {
#pragma unroll
    for (int r = 0; r < 16; ++r) { p0[r] = __builtin_amdgcn_exp2f(p0[r]); p1[r] = __builtin_amdgcn_exp2f(p1[r]); }
}
DEVI float nsa_rowsum(const f32x16& p0, const f32x16& p1) {
    f32x2v a = {p0[0], p0[1]}, b = {p1[0], p1[1]};
#pragma unroll
    for (int r = 2; r < 16; r += 2) { a += (f32x2v){p0[r], p0[r + 1]}; b += (f32x2v){p1[r], p1[r + 1]}; }
    a += b; return a[0] + a[1];
}
DEVI void nsa_fill(f32x16& z, float v) {
#pragma unroll
    for (int r = 0; r < 16; ++r) z[r] = v;
    asm volatile("" : "+v"(z));
}
DEVI float nsa_msel(bool dead, float e) { return __uint_as_float(__float_as_uint(e) & (dead ? 0u : 0xffffffffu)); }
DEVI void nsa_unit(bf16_t* Y, const bf16_t* KCB, const bf16_t* VCB, int b, int g, int qt, const NsaCtx& c, const float (&bnd)[3], int& slot) {
    const int w = c.w, tq = 8 * w + (c.r32 >> 2), head = c.r32 & 3, t = 64 * qt + tq;
    const size_t m = (size_t)b * SEQ + t;
    bf16_t* qrow = Y + m * LDY + OFF_Q + (g * 4 + head) * 64;
    {   LAS3 bf16x8* qfl = (LAS3 bf16x8*)(c.lds + NSA_QF) + c.tid;
#pragma unroll
        for (int s = 0; s < 4; ++s) qfl[s * 512] = *(const bf16x8*)(qrow + 16 * s + 8 * c.hi);
    }
    const bf16_t* gp = Y + m * LDY + OFF_NG + (g * 4 + head) * 3;
    const float gate_c = bf2f(gp[0]), gate_s = bf2f(gp[1]), gate_w = bf2f(gp[2]);
    LAS3 float* outl = (LAS3 float*)(c.lds + NSA_OUT) + c.tid;
    f32x16 p0, p1, o[2]; bf16x8 pa[4];

    const int nmax = (t - 31) >> 4;
    const int ntc = (((64 * qt + 32) >> 4) >> 6) + 1;
    const bf16_t* kc = KCB + (size_t)((b * 2 + g) * 256) * 64; const bf16_t* vc = VCB + (size_t)((b * 2 + g) * 256) * 64;
    auto cmp_next = [&](int ct) { return ct + 1 < ntc ? ct + 1 : -1; };
    auto cmp_src = [&](int ct, const bf16_t*& kb, const bf16_t*& vb) { kb = kc + (size_t)ct * 4096; vb = vc + (size_t)ct * 4096; };
    float lc = 0.f;
#pragma unroll
    for (int d0 = 0; d0 < 2; ++d0)
#pragma unroll
        for (int r = 0; r < 16; ++r) o[d0][r] = 0.f;
    f32x16 zb; nsa_fill(zb, -bnd[0]);
    nsa_run(c, slot, 0, c.okC, c.ovC, cmp_next, cmp_src, [&](int ct, int buf) {
        nsa_scores(c, buf, zb, p0, p1);
        nsa_exp_all(p0, p1);
        if (!__all(64 * ct + 63 <= nmax)) {
#pragma unroll
            for (int r = 0; r < 16; ++r) { const int n0 = 64 * ct + crow16(r, c.hi); p0[r] = nsa_msel(n0 > nmax, p0[r]); p1[r] = nsa_msel(n0 + 32 > nmax, p1[r]); }
        }
        lc += nsa_rowsum(p0, p1);
        nsa_pack(p0, p1, pa);
        nsa_pv(c, buf, pa, o);
    });
    lc = half_sum(lc);
    const float invc = lc > 0.f ? 1.f / lc : 0.f;
    {   const float sc_ = gate_c * invc;
#pragma unroll
        for (int d0 = 0; d0 < 2; ++d0)
#pragma unroll
            for (int r = 0; r < 16; ++r) outl[(d0 * 16 + r) * 512] = o[d0][r] * sc_;
    }
    unsigned msk0, msk1;
    if (qt < 16) { msk0 = (2u << qt) - 1u; msk1 = 0u; }
    else {
#pragma unroll
        for (int d0 = 0; d0 < 2; ++d0)
#pragma unroll
            for (int r = 0; r < 16; ++r) o[d0][r] = 0.f;
        nsa_run(c, slot, 0, c.okC, c.ovC, cmp_next, cmp_src, [&](int ct, int buf) {
            nsa_scores(c, buf, zb, p0, p1);
            nsa_exp_all(p0, p1);
            if (!__all(64 * ct + 63 <= nmax)) {
#pragma unroll
                for (int r = 0; r < 16; ++r) { const int n0 = 64 * ct + crow16(r, c.hi); p0[r] = nsa_msel(n0 > nmax, p0[r]); p1[r] = nsa_msel(n0 + 32 > nmax, p1[r]); }
            }
            nsa_pack(p0, p1, pa);
#pragma unroll
            for (int s = 0; s < 4; ++s)
#pragma unroll
                for (int jb = 0; jb < 2; ++jb) {
                    if (!(jb == (ct >> 1) || (s == 3 && (ct & 1) && jb == (ct >> 1) + 1))) continue;
                    const int j = 32 * jb + c.r32, jn0 = 16 * ct + 4 * s + c.hi, jn1 = jn0 + 2;
                    uint4 wv;
                    wv.x = (jn0 == j) ? 0x3F803F80u : 0u; wv.y = (jn0 == j) ? 0x3F003F80u : ((jn0 + 1 == j) ? 0x3F000000u : 0u);
                    wv.z = (jn1 == j) ? 0x3F803F80u : 0u; wv.w = (jn1 == j) ? 0x3F003F80u : ((jn1 + 1 == j) ? 0x3F000000u : 0u);
                    o[jb] = __builtin_amdgcn_mfma_f32_32x32x16_bf16(__builtin_bit_cast(bf16x8, wv), pa[s], o[jb], 0, 0, 0);
                }
        });
        unsigned key[2][16];
#pragma unroll
        for (int jb = 0; jb < 2; ++jb)
#pragma unroll
            for (int r = 0; r < 16; ++r) {
                float v = o[jb][r] * invc;
                v += shx(v, 1); v += shx(v, 2);
                const int j = 32 * jb + crow16(r, c.hi);
                const bool cand = (j >= 1) && (j + 2 <= qt);
                key[jb][r] = cand ? ((__float_as_uint(fmaxf(v, 0.f)) & ~63u) | (unsigned)(63 - j)) : 0u;
            }
        unsigned thr = 0u;
#pragma unroll 1
        for (int bit = 30; bit >= 0; --bit) {
            const unsigned tt = thr | (1u << bit);
            int cnt = 0;
#pragma unroll
            for (int jb = 0; jb < 2; ++jb)
#pragma unroll
                for (int r = 0; r < 16; ++r) cnt += (key[jb][r] >= tt) ? 1 : 0;
            cnt = half_addi(cnt);
            thr = (cnt >= 13) ? tt : thr;
        }
        unsigned w0 = 0u, w1 = 0u;
#pragma unroll
        for (int r = 0; r < 16; ++r) {
            const int bitpos = (r & 3) + 8 * (r >> 2);
            w0 |= ((key[0][r] != 0u && key[0][r] >= thr) ? 1u : 0u) << bitpos;
            w1 |= ((key[1][r] != 0u && key[1][r] >= thr) ? 1u : 0u) << bitpos;
        }
        w0 <<= 4 * c.hi; w1 <<= 4 * c.hi;
        msk0 = half_or(w0); msk1 = half_or(w1);
        msk0 |= 1u;
        if (qt < 32) msk0 |= (3u << (qt - 1)); else if (qt == 32) { msk0 |= 0x80000000u; msk1 |= 1u; } else msk1 |= (3u << (qt - 33));
    }
    unsigned u0 = msk0, u1 = msk1;
    u0 |= shxu(u0, 4); u1 |= shxu(u1, 4); u0 |= shxu(u0, 8); u1 |= shxu(u1, 8); u0 |= shxu(u0, 16); u1 |= shxu(u1, 16);
    LAS3 unsigned* misc = (LAS3 unsigned*)(c.lds + NSA_MISC);
    if (c.lane == 0) { misc[2 * w] = u0; misc[2 * w + 1] = u1; }
    asm volatile("s_waitcnt lgkmcnt(0)" ::: "memory"); __builtin_amdgcn_s_barrier(); asm volatile("" ::: "memory");
    u0 = 0u; u1 = 0u;
#pragma unroll
    for (int i = 0; i < 8; ++i) { u0 |= misc[2 * i]; u1 |= misc[2 * i + 1]; }
    const unsigned long long um = ((unsigned long long)(unsigned)__builtin_amdgcn_readfirstlane(u1) << 32) | (unsigned)__builtin_amdgcn_readfirstlane(u0);
    const unsigned long long mym = ((unsigned long long)msk1 << 32) | msk0;

    {
        const bf16_t* kb0 = Y + (size_t)b * SEQ * LDY + OFF_KS + g * 64; const bf16_t* vb0 = Y + (size_t)b * SEQ * LDY + OFF_VS + g * 64;
        float ls = 0.f;
#pragma unroll
        for (int d0 = 0; d0 < 2; ++d0)
#pragma unroll
            for (int r = 0; r < 16; ++r) o[d0][r] = 0.f;
        nsa_fill(zb, -bnd[1]);
        nsa_run(c, slot, 0, c.okY, c.ovY,
                [&](int j) { const unsigned long long rest = (j >= 63) ? 0ull : (um >> (j + 1)); return rest ? j + 1 + (int)__builtin_ctzll(rest) : -1; },
                [&](int j, const bf16_t*& kb, const bf16_t*& vb) { kb = kb0 + (size_t)j * 64 * LDY; vb = vb0 + (size_t)j * 64 * LDY; },
                [&](int j, int buf) {
            nsa_scores(c, buf, zb, p0, p1);
            nsa_exp_all(p0, p1);
            const bool keep = (mym >> j) & 1ull;
            if (j == qt) {
#pragma unroll
                for (int r = 0; r < 16; ++r) { const int kv = crow16(r, c.hi); p0[r] = nsa_msel(kv > tq, p0[r]); p1[r] = nsa_msel(kv + 32 > tq, p1[r]); }
            }
            ls += keep ? nsa_rowsum(p0, p1) : 0.f;
            nsa_pack(p0, p1, pa);
            {   const unsigned km = keep ? 0xffffffffu : 0u;
#pragma unroll
                for (int s = 0; s < 4; ++s) { uint4 w = __builtin_bit_cast(uint4, pa[s]); w.x &= km; w.y &= km; w.z &= km; w.w &= km; pa[s] = __builtin_bit_cast(bf16x8, w); }
            }
            nsa_pv(c, buf, pa, o);
        });
        ls = half_sum(ls);
        const float sc_ = ls > 0.f ? gate_s / ls : 0.f;
#pragma unroll
        for (int d0 = 0; d0 < 2; ++d0)
#pragma unroll
            for (int r = 0; r < 16; ++r) outl[(d0 * 16 + r) * 512] += o[d0][r] * sc_;
    }
    {
        const bf16_t* kb0 = Y + (size_t)b * SEQ * LDY + OFF_KW + g * 64; const bf16_t* vb0 = Y + (size_t)b * SEQ * LDY + OFF_VW + g * 64;
        float lw = 0.f;
#pragma unroll
        for (int d0 = 0; d0 < 2; ++d0)
#pragma unroll
            for (int r = 0; r < 16; ++r) o[d0][r] = 0.f;
        const int jlo = qt - 8 > 0 ? qt - 8 : 0;
        nsa_fill(zb, -bnd[2]);
        nsa_run(c, slot, qt, c.okY, c.ovY,
                [&](int j) { return j > jlo ? j - 1 : -1; },
                [&](int j, const bf16_t*& kb, const bf16_t*& vb) { kb = kb0 + (size_t)j * 64 * LDY; vb = vb0 + (size_t)j * 64 * LDY; },
                [&](int j, int buf) {
            nsa_scores(c, buf, zb, p0, p1);
            nsa_exp_all(p0, p1);
            if (j == qt || j == qt - 8) {
                const int hi_lim = (j == qt) ? tq : 64, lo_lim = (j == qt - 8) ? tq + 1 : 0;
#pragma unroll
                for (int r = 0; r < 16; ++r) { const int kv = crow16(r, c.hi); p0[r] = nsa_msel((kv > hi_lim) || (kv < lo_lim), p0[r]); p1[r] = nsa_msel((kv + 32 > hi_lim) || (kv + 32 < lo_lim), p1[r]); }
            }
            lw += nsa_rowsum(p0, p1);
            nsa_pack(p0, p1, pa);
            nsa_pv(c, buf, pa, o);
        });
        lw = half_sum(lw);
        const float sc_ = lw > 0.f ? gate_w / lw : 0.f;
#pragma unroll
        for (int d0 = 0; d0 < 2; ++d0)
#pragma unroll
            for (int r = 0; r < 16; ++r) o[d0][r] = outl[(d0 * 16 + r) * 512] + o[d0][r] * sc_;
    }
#pragma unroll
    for (int d0 = 0; d0 < 2; ++d0)
#pragma unroll
        for (int gi = 0; gi < 4; ++gi) {
            uint2 wv; wv.x = pk2(o[d0][4 * gi], o[d0][4 * gi + 1]); wv.y = pk2(o[d0][4 * gi + 2], o[d0][4 * gi + 3]);
            *(uint2*)(qrow + (OFF_RX - OFF_Q) + 32 * d0 + 8 * gi + 4 * c.hi) = wv;
        }
}

DEVI void phase_nsa_fast(bf16_t* Y, const bf16_t* KCB, const bf16_t* VCB, const float* qn  , const float* kn  , LAS3 unsigned char* lds) {
    float bnd[3];
    {   const int l0 = TIDX & 63;
        const float gq = wave_max(fabsf(qn[l0]));
#pragma unroll
        for (int i = 0; i < 3; ++i) bnd[i] = __uint_as_float(__builtin_amdgcn_readfirstlane(__float_as_uint(64.f * 1.02f * 0.125f * 1.4426950408889634f * gq * wave_max(fabsf(kn[i * 64 + l0])))));
    }
    NsaCtx c; c.lds = lds; c.tid = TIDX; c.lane = c.tid & 63; c.r32 = c.lane & 31; c.hi = c.lane >> 5; c.w = __builtin_amdgcn_readfirstlane(c.tid >> 6);
    {   const int l = c.lane, w = c.w;
        const int rk = 8 * w + (l >> 3), ck = (l & 7) ^ ((rk >> 1) & 7);
        const int rv = 16 * (w & 3) + (l >> 2), cv = (w >> 2) * 4 + (l & 3);
        c.okY = (unsigned)(rk * LDY + ck * 8) * 2u; c.ovY = (unsigned)(rv * LDY + cv * 8) * 2u;
        c.okC = (unsigned)(rk * 64 + ck * 8) * 2u;  c.ovC = (unsigned)(rv * 64 + cv * 8) * 2u;
    }
    const int bid = BIDX;
    int slot = 0;
    for (int u0 = bid; u0 < 256; u0 += gridDim.x) {
        const int u = (gridDim.x == 256) ? ((u0 & 7) * 32 + (u0 >> 3)) : u0;
        const int bg = u >> 5, k = u & 31;
#pragma unroll 1
        for (int h2 = 0; h2 < 2; ++h2) nsa_unit(Y, KCB, VCB, bg >> 1, bg & 1, h2 ? k : 63 - k, c, bnd, slot);
    }
    asm volatile("s_waitcnt vmcnt(0) lgkmcnt(0)" ::: "memory"); __builtin_amdgcn_s_barrier();
}

#define XB_TMO      128
#define XB_XCNT(j)  (256  + 64 * (j))
#define XB_XSUB(j)  (1280 + 64 * (j))
#define XB_XGEN(j)  (2304 + 64 * (j))
#define XB_TOP      3328
#define XB_TOPGEN   3392
#define XCD_BAR_WORDS 3456
#define XB_SPIN_CAP (1u << 18)
DEVI unsigned xb_ld(unsigned* p)              { return __hip_atomic_load(p, __ATOMIC_RELAXED, __HIP_MEMORY_SCOPE_AGENT); }
DEVI unsigned xb_add(unsigned* p, unsigned v) { return __hip_atomic_fetch_add(p, v, __ATOMIC_RELAXED, __HIP_MEMORY_SCOPE_AGENT); }
DEVI unsigned xb_xcc_id() { return (unsigned)__builtin_amdgcn_s_getreg((3 << 11) | 20) & 0xFu; }
#define XB_SPIN(cond, bar) do { unsigned _sp = 0; while (cond) { __builtin_amdgcn_s_sleep(1); \
    if ((++_sp & 255u) == 0u) { if (xb_ld(&(bar)[XB_TMO])) break; if (_sp > XB_SPIN_CAP) { atomicAdd(&(bar)[XB_TMO], 1u); break; } } } } while (0)
struct XcdBarrier { unsigned* bar; unsigned x; volatile LAS3 unsigned* st; };
DEVI XcdBarrier xcd_barrier_post(unsigned* bar, volatile LAS3 unsigned* st) {
    XcdBarrier b; b.bar = bar; b.x = xb_xcc_id(); b.st = st;
    if (threadIdx.x == 0) (void)xb_add(&bar[XB_XCNT(b.x)], 1u);
    return b;
}
DEVI void xcd_barrier_complete(unsigned* bar, unsigned x, unsigned& nloc, unsigned& nx) {
    const unsigned G = gridDim.x * gridDim.y * gridDim.z;
    unsigned sum, cnt, mine, sp = 0u;
    for (;;) {
        sum = 0u; cnt = 0u; mine = 0u;
#pragma unroll
        for (unsigned j = 0; j < 16; ++j) { const unsigned c = xb_ld(&bar[XB_XCNT(j)]); sum += c; cnt += (c > 0u) ? 1u : 0u; mine = (j == x) ? c : mine; }
        if (sum == G) break;
        __builtin_amdgcn_s_sleep(1);
        if ((++sp & 255u) == 0u) { if (xb_ld(&bar[XB_TMO])) break; if (sp > XB_SPIN_CAP) { atomicAdd(&bar[XB_TMO], 1u); break; } }
    }
    nloc = mine > 0u ? mine : 1u; nx = cnt > 0u ? cnt : 1u;
}
DEVI void xcd_barrier(const XcdBarrier& b) {
    asm volatile("s_waitcnt vmcnt(0)" ::: "memory");
    __syncthreads();
    if (threadIdx.x == 0) {
        unsigned* bar = b.bar;
        __builtin_amdgcn_s_waitcnt(0);
        unsigned nloc = b.st[0], nx = b.st[1];
        if (nloc == 0u) { xcd_barrier_complete(bar, b.x, nloc, nx); b.st[0] = nloc; b.st[1] = nx; }
        const unsigned old = xb_add(&bar[XB_XSUB(b.x)], 1u);
        const unsigned gen = old / nloc;
        if (old + 1u == (gen + 1u) * nloc) {
            __builtin_amdgcn_fence(__ATOMIC_RELEASE, "agent");
            asm volatile("s_waitcnt vmcnt(0)" ::: "memory");
            const unsigned og = xb_add(&bar[XB_TOP], 1u);
            const unsigned tg = og / nx;
            if (og + 1u == (tg + 1u) * nx) xb_add(&bar[XB_TOPGEN], 1u);
            else XB_SPIN(xb_ld(&bar[XB_TOPGEN]) == tg, bar);
            __builtin_amdgcn_fence(__ATOMIC_ACQUIRE, "agent");
            xb_add(&bar[XB_XGEN(b.x)], 1u);
            asm volatile("s_waitcnt vmcnt(0)" ::: "memory");
        } else {
            XB_SPIN(xb_ld(&bar[XB_XGEN(b.x)]) == gen, bar);
            __builtin_amdgcn_fence(__ATOMIC_ACQUIRE, "agent");
            asm volatile("s_waitcnt vmcnt(0)" ::: "memory");
        }
    }
    __syncthreads();
}

constexpr int LDS_BYTES = 160 * 1024;
constexpr int LDS_PTRS = 151552;
DEVI const void* lds_ptr(const LAS3 unsigned char* lds, int i) {
    const unsigned long long v = ((const LAS3 unsigned long long*)(lds + LDS_PTRS))[i];
    const unsigned lo = __builtin_amdgcn_readfirstlane((unsigned)v), hi = __builtin_amdgcn_readfirstlane((unsigned)(v >> 32));
    return (const void*)(((unsigned long long)hi << 32) | lo);
}
#ifndef PHMASK
#define PHMASK 0xffffffffu
#endif
__global__ void __launch_bounds__(512, 2) fwd_kernel(Params p) {
    extern __shared__ __attribute__((aligned(16))) unsigned char lds[];
    cg::grid_group grid = cg::this_grid();
    unsigned char* ws = p.ws;
    int* CNT = (int*)(ws + WS_CNT);
    float* RSTD = (float*)(ws + WS_RSTD); float* SS = (float*)(ws + WS_SS); float* LOG = (float*)(ws + WS_LOG); bf16_t* WRT = (bf16_t*)(ws + WS_WRT); bf16_t* W1T = (bf16_t*)(ws + WS_W1T); bf16_t* W2T = (bf16_t*)(ws + WS_W2T); float* BPE = (float*)(ws + WS_BPE);
    float* PA = (float*)(ws + WS_PA); float* PH = (float*)(ws + WS_PH);
    float* KCMP = (float*)(ws + WS_KCMP); float* VCMP = (float*)(ws + WS_VCMP); float* HID = (float*)(ws + WS_HID);
    float* RW = (float*)(ws + WS_RW); int* LIST = (int*)(ws + WS_LIST);
    bf16_t* KCB = (bf16_t*)(ws + WS_KCB); bf16_t* VCB = (bf16_t*)(ws + WS_VCB);
    bf16_t* WIN = (bf16_t*)(ws + WS_WIN); bf16_t* WBR = (bf16_t*)(ws + WS_WBR); bf16_t* WO = (bf16_t*)(ws + WS_WO);
    bf16_t* Y = (bf16_t*)(ws + WS_Y); float* LA = (float*)p.out; bf16_t* VV = (bf16_t*)((unsigned char*)p.out + 32 * MiB); bf16_t* KVC = (bf16_t*)((unsigned char*)p.out + 48 * MiB);
    bf16_t* XB = (bf16_t*)(ws + WS_XB);
    bf16_t* WGU = (bf16_t*)(ws + WS_WGU); bf16_t* WD = (bf16_t*)(ws + WS_WD); bf16_t* XG = (bf16_t*)(ws + WS_XG); bf16_t* HM = (bf16_t*)(ws + WS_HM);
    int* TOKS = (int*)(ws + WS_TOKS); float* RWS = (float*)(ws + WS_RWS); bf16_t* YS = (bf16_t*)(ws + WS_YS);
    bf16_t* As = (bf16_t*)lds; bf16_t* Bs = As + 128 * GLD;
    float* ldsf = (float*)lds;
    int* tb = (int*)(lds + 131072);
    LAS3 unsigned char* lds3 = (LAS3 unsigned char*)lds;
    const int G = gridDim.x;
    {   LAS3 unsigned long long* ptab = (LAS3 unsigned long long*)(lds3 + LDS_PTRS);
        if (threadIdx.x == 0) {
#pragma unroll
            for (int i = 0; i < 30; ++i) ptab[i] = (unsigned long long)p.in[i];
            ptab[30] = (unsigned long long)p.out;
        }
        if (threadIdx.x == 0) { ((volatile LAS3 unsigned*)(lds3 + LDS_PTRS + 256))[0] = 0u; ((volatile LAS3 unsigned*)(lds3 + LDS_PTRS + 256))[1] = 0u; }
        __syncthreads();
    }
    const XcdBarrier xbar = xcd_barrier_post((unsigned*)(ws + WS_BAR), (volatile LAS3 unsigned*)(lds3 + LDS_PTRS + 256));
#define INP(i) ((const float*)lds_ptr(lds3, (i)))
#define OUTP ((float*)lds_ptr(lds3, 30))

    if (PHMASK & (1u << 0)) phase_prep(p, WIN, WBR, WO, WRT, W1T, W2T, BPE, ldsf);

    for (int l = 0; l < DEPTH; ++l) {
        if (l == 0) { if (PHMASK & (1u << 1)) phase_xb(INP(0), RSTD, XB); }
        if (l == 0) grid.sync();
        if (PHMASK & (1u << 2)) { pg8::Gemm g{XB, WIN + (size_t)l * LDY * DM, DM, DM, DM}; pg8::StaticOrder S; S.init(MTOK, LDY, G, BIDX); EpiInproj E{Y, RSTD, INP(15) + l * 64, INP(16) + l * 192, KVC};
          pg8::gemm_phase<EpiInproj, pg8::StaticOrder>(lds3, g, S, E);
        }
        xcd_barrier(xbar);
        {
            const int bid_ = BIDX;
            if (bid_ < 16) {
                pg8::Gemm g{KVC, W1T + (size_t)l * 256 * 2048, 2048, 16 * 256, 2048, 256 * 2, 128}; CmpOrder S{G, bid_}; EpiCmp1 E{(bf16_t*)HID, BPE + l * 256};
                pg8::gemm_phase<EpiCmp1, CmpOrder>(lds3, g, S, E);
                asm volatile("s_waitcnt vmcnt(0)" ::: "memory"); __syncthreads();
                cmp2_unit((const bf16_t*)HID, W2T + (size_t)l * 2 * 64 * 128, INP(14) + l * 128, INP(16) + l * 192, KCB, VCB, bid_ >> 3, (bid_ >> 2) & 1, bid_ & 3);
            } else {
                phase_rglru1(Y, INP(3) + l * 2048, INP(4) + l * 512, INP(5) + l * 32768, INP(6) + l * 512, INP(7) + l * 32768, INP(8) + l * 512, INP(9) + l * 512,
                             LA, VV, PA, PH, ldsf, bid_ - 16, G - 16);
                phase_shortconv(Y, INP(17) + l * 1536, bid_ - 16, G - 16);
            }
        }
        xcd_barrier(xbar);
        if (PHMASK & (1u << 8)) phase_rglru2(Y, LA, VV, PA, PH);
#if NSA_FAST
        if (PHMASK & (1u << 9)) phase_nsa_fast(Y, KCB, VCB, INP(15) + l * 64, INP(16) + l * 192, lds3);
#else
        if (PHMASK & (1u << 9)) phase_nsa(Y, KCMP, VCMP, ldsf);
#endif
        xcd_barrier(xbar);
        if (PHMASK & (1u << 10)) {
            pg8::Gemm g{Y, WBR + (size_t)l * 3 * DM * 512, 512, LDY, 512}; MergeOrder S; S.so.init(MTOK, DM, G, BIDX); EpiMerge E{Y};
            pg8::gemm_phase<EpiMerge, MergeOrder>(lds3, g, S, E);
        }
        xcd_barrier(xbar);
        if (PHMASK & (1u << 11)) { pg8::Gemm g{Y + OFF_SC, WO + (size_t)l * DM * DM, DM, LDY, DM}; pg8::StaticOrder S; S.init(MTOK, DM, G, BIDX); EpiOut E{XB, SS + (size_t)l * MTOK * 16};
          pg8::gemm_phase<EpiOut, pg8::StaticOrder>(lds3, g, S, E); }
        xcd_barrier(xbar);
        if (PHMASK & (1u << 12)) {
            pg8::Gemm g{XB, WRT + (size_t)l * 256 * DM, DM, DM, DM}; pg8::StaticOrder S; S.init(MTOK, 256, G, BIDX); EpiRouter E{LOG, SS + (size_t)l * MTOK * 16};
            pg8::gemm_phase<EpiRouter, pg8::StaticOrder>(lds3, g, S, E);
            pg8::Unit u;
            if (S.next(0, u)) {
                asm volatile("s_waitcnt vmcnt(0)" ::: "memory"); __syncthreads();
                const int t_ = TIDX;
                router_finalize(u.pm * 256 + (t_ & 255), t_, LOG, INP(24) + l * 4, INP(26) + l * 32, CNT + l * 32, LIST, RW, (volatile int*)(lds + LDS_ROWT));
            }
        }
        if (PHMASK & (1u << 13)) phase_moe_prep(INP(27) + (size_t)l * NEXP * DM * 256, INP(28) + (size_t)l * NEXP * DM * 256, INP(29) + (size_t)l * NEXP * 256 * DM, INP(22) + l * DM, WGU, WD, ldsf);
        xcd_barrier(xbar);
        if (PHMASK & (1u << 15)) {
            int* tokl = (int*)(lds + LDS_ROWT); float* wl = (float*)(lds + LDS_ROWT + 2048); float* rsl = (float*)(lds + LDS_ROWT + 4096);
            const int bid_ = BIDX;
            moe_tables(CNT + l * 32, tb);
            const int R = moe_rounds(tb, G, 2);
#pragma unroll 1
            for (int r = 0; r < R; ++r) {
                MoeUpOrder S{tb, G, bid_, r, tokl};
                moe_up_setup(CNT + l * 32, LIST, RW, SS + (size_t)l * MTOK * 16, TOKS, S, tokl, wl, rsl);
                pg8::Gemm g{XB, WGU, DM, DM, DM}; EpiMoeUp E{HM, wl, rsl};
                pg8::gemm_phase<EpiMoeUp, MoeUpOrder, true>(lds3, g, S, E);
            }
        }
        xcd_barrier(xbar);
        if (PHMASK & (1u << 16)) { pg8::Gemm g{HM, WD, 256, 256, 256}; MoeOrder S{tb, 4, G, BIDX}; EpiMoeDown E{YS, TOKS};
          pg8::gemm_phase<EpiMoeDown, MoeOrder>(lds3, g, S, E); }
        xcd_barrier(xbar);
        if (PHMASK & (1u << 17)) phase_combine(XB, YS, RSTD, OUTP, l + 1 < DEPTH);
        if (l + 1 < DEPTH) xcd_barrier(xbar);
    }
}

extern "C" void kernel_launch(void* const* d_in, const int* in_sizes, int n_in, void* d_out, int out_size, void* d_ws, size_t ws_size, hipStream_t stream) {
    static int grid = 0;
    if (grid == 0) {
        if (n_in != 30 || out_size != MTOK * DM || ws_size < WS_TOTAL) { fprintf(stderr, "kernel_launch: unexpected sizes n_in=%d out=%d ws=%zu\n", n_in, out_size, ws_size); grid = -1; return; }
        int dev = 0, cus = 0, per_cu = 0;
        hipGetDevice(&dev);
        hipDeviceGetAttribute(&cus, hipDeviceAttributeMultiprocessorCount, dev);
        hipFuncSetAttribute((const void*)fwd_kernel, hipFuncAttributeMaxDynamicSharedMemorySize, LDS_BYTES);
        hipOccupancyMaxActiveBlocksPerMultiprocessor(&per_cu, (const void*)fwd_kernel, 512, LDS_BYTES);
        (void)hipGetLastError();
        if (per_cu < 1) { fprintf(stderr, "kernel_launch: occupancy query says %d blocks/CU\n", per_cu); grid = -1; return; }
        grid = cus;
    }
    if (grid < 0) return;
    hipMemsetAsync(d_ws, 0, WS_ZERO_BYTES, stream);
    Params p{};
    for (int i = 0; i < 30; ++i) p.in[i] = (const float*)d_in[i];
    p.out = (float*)d_out; p.ws = (unsigned char*)d_ws;
    void* args[] = {&p};
    hipError_t e = hipLaunchCooperativeKernel((const void*)fwd_kernel, dim3(grid), dim3(512), args, LDS_BYTES, stream);
    if (e != hipSuccess) fprintf(stderr, "cooperative launch failed: %s (grid %d)\n", hipGetErrorString(e), grid);
}
```

```cpp
#include <hip/hip_runtime.h>
#include <hip/hip_cooperative_groups.h>
#include <cstdio>
#include <cstdint>
namespace cg = cooperative_groups;

typedef unsigned short bf16_t;
typedef short bf16x8 __attribute__((ext_vector_type(8)));
typedef float f32x4 __attribute__((ext_vector_type(4)));
#define DEVI __device__ __forceinline__

constexpr int DM = 1024, NB = 4, SEQ = 4096, MTOK = NB * SEQ, DEPTH = 2;
constexpr int INW = 6936;
constexpr int NPROJ = 7168;
constexpr int LDY = 3968;
constexpr int OFF_RX = 0, OFF_RY = 512, OFF_Q = 1024, OFF_KC = 1536, OFF_VC = 1664, OFF_KS = 1792, OFF_VS = 1920,
              OFF_KW = 2048, OFF_VW = 2176, OFF_SB = 2304, OFF_SC = 2816, OFF_SH = 3328, OFF_MG = 3840, OFF_NG = 6912, OFF_END = 6936, OFF_NGY = 3840;
constexpr int NCMP = 255;
constexpr float RMS_EPS = 1e-6f;
constexpr int NEXP = 32;

constexpr size_t KiB = 1024, MiB = 1024 * 1024;
constexpr size_t WS_CNT = 0;
constexpr size_t WS_BAR = 16 * KiB;
constexpr size_t WS_ZERO_BYTES = 32 * KiB;
constexpr size_t WS_SS = 13 * MiB;
constexpr size_t WS_RSTD = 192 * KiB;
constexpr size_t WS_PA = 512 * KiB;
constexpr size_t WS_PH = 1024 * KiB;
constexpr size_t WS_KCMP = 2 * MiB;
constexpr size_t WS_VCMP = 2 * MiB + 512 * KiB;
constexpr size_t WS_HID = 3 * MiB;
constexpr size_t WS_RW = 5 * MiB;
constexpr size_t WS_LIST = 6 * MiB;
constexpr size_t WS_KCB = 8 * MiB;
constexpr size_t WS_VCB = 8 * MiB + 256 * KiB;
constexpr size_t WS_LOG = 9 * MiB;
constexpr size_t WS_WIN = 16 * MiB;
constexpr size_t WS_WBR = 44 * MiB;
constexpr size_t WS_WO = 50 * MiB;
constexpr size_t WS_W1T = 54 * MiB;
constexpr size_t WS_W2T = 320 * KiB;
constexpr size_t WS_BPE = 256 * KiB;
constexpr size_t WS_WRT = 15 * MiB;
constexpr size_t WS_Y = 56 * MiB;
constexpr size_t WS_G8 = WS_Y + 136 * MiB;
constexpr size_t WS_LA = 280 * MiB;
constexpr size_t WS_VV = 312 * MiB;
constexpr size_t WS_XB = 280 * MiB;
constexpr size_t WS_WGU = WS_Y;
constexpr size_t WS_WD = WS_Y + 32 * MiB;
constexpr size_t WS_XG = WS_Y + 48 * MiB;
constexpr size_t WS_HM = WS_Y + 128 * MiB;
constexpr size_t WS_TOKS = WS_Y + 148 * MiB;
constexpr size_t WS_RWS = WS_Y + 148 * MiB + 256 * KiB;
constexpr size_t WS_YS = WS_Y + 152 * MiB;
constexpr size_t WS_TOTAL = 328 * MiB;
constexpr int MOE_ROWS = 40960;

struct Params {
    const float* in[30];
    float* out;
    unsigned char* ws;
};

DEVI float bf2f(bf16_t v) { return __uint_as_float(((unsigned)v) << 16); }
DEVI bf16_t f2bf(float f) { unsigned u = __float_as_uint(f); return (bf16_t)((u + 0x7fffu + ((u >> 16) & 1u)) >> 16); }
DEVI unsigned pk2(float lo, float hi) { return (unsigned)f2bf(lo) | ((unsigned)f2bf(hi) << 16); }
DEVI int launder_v0(int v) { asm volatile("" : "+v"(v)); return v; }
DEVI float shx(float v, int o) { const int lane = launder_v0((int)threadIdx.x) & 63; return __int_as_float(__builtin_amdgcn_ds_bpermute((lane ^ o) << 2, __float_as_int(v))); }
DEVI unsigned shxu(unsigned v, int o) { const int lane = launder_v0((int)threadIdx.x) & 63; return (unsigned)__builtin_amdgcn_ds_bpermute((lane ^ o) << 2, (int)v); }
DEVI float wave_sum(float v) {
#pragma unroll
    for (int o = 1; o < 64; o <<= 1) v += shx(v, o);
    return v;
}
DEVI float wave_max(float v) {
#pragma unroll
    for (int o = 1; o < 64; o <<= 1) v = fmaxf(v, shx(v, o));
    return v;
}
DEVI float sigmoidf_(float x) { return __builtin_amdgcn_rcpf(1.f + __builtin_amdgcn_exp2f(-1.4426950408889634f * x)); }
DEVI float gelu_tanh(float x) { const float u = 0.7978845608028654f * (x + 0.044715f * x * x * x); return x * __builtin_amdgcn_rcpf(1.f + __builtin_amdgcn_exp2f(-2.8853900817779268f * u)); }
DEVI int launder_v(int v) { asm volatile("" : "+v"(v)); return v; }
DEVI int launder_s(int v) { asm volatile("" : "+s"(v)); return v; }
#define TIDX launder_v((int)threadIdx.x)
#define BIDX launder_s((int)blockIdx.x)
DEVI f32x4 zero4() { float z = 0.f; asm volatile("" : "+v"(z)); return (f32x4){z, z, z, z}; }
#define LDS_FENCE() asm volatile("s_waitcnt lgkmcnt(0)" ::: "memory")

constexpr int GLD = 40;
template <class LA, class LB>
DEVI void gemm_tile(const int tid, f32x4 (&acc)[2][4], int K, bf16_t* As, bf16_t* Bs, LA la, LB lb) {
    const int lane = tid & 63, wave = tid >> 6, wm = wave >> 1, wn = wave & 1;
    const int ar = tid >> 2, ak = (tid & 3) * 8;
    const int bk = tid >> 4, bn = (tid & 15) * 8;
    for (int k0 = 0; k0 < K; k0 += 32) {
        float av[8], bv[8];
        la(k0 + ak, av);
        lb(k0 + bk, bv);
        __syncthreads();
        uint4 pa; pa.x = pk2(av[0], av[1]); pa.y = pk2(av[2], av[3]); pa.z = pk2(av[4], av[5]); pa.w = pk2(av[6], av[7]);
        *(uint4*)(As + ar * GLD + ak) = pa;
#pragma unroll
        for (int j = 0; j < 8; ++j) Bs[(bn + j) * GLD + bk] = f2bf(bv[j]);
        __syncthreads();
        bf16x8 af[2], bfr[4];
#pragma unroll
        for (int i = 0; i < 2; ++i) af[i] = *(const bf16x8*)(As + (wm * 32 + i * 16 + (lane & 15)) * GLD + (lane >> 4) * 8);
#pragma unroll
        for (int j = 0; j < 4; ++j) bfr[j] = *(const bf16x8*)(Bs + (wn * 64 + j * 16 + (lane & 15)) * GLD + (lane >> 4) * 8);
#pragma unroll
        for (int i = 0; i < 2; ++i)
#pragma unroll
            for (int j = 0; j < 4; ++j) acc[i][j] = __builtin_amdgcn_mfma_f32_16x16x32_bf16(bfr[j], af[i], acc[i][j], 0, 0, 0);
    }
    __syncthreads();
}
DEVI void acc_zero(f32x4 (&acc)[2][4]) {
#pragma unroll
    for (int i = 0; i < 2; ++i)
#pragma unroll
        for (int j = 0; j < 4; ++j) acc[i][j] = zero4();
}
#define ACC_ROW(i) (((tid >> 7) * 32) + (i) * 16 + (tid & 15))
#define ACC_COL(j) ((((tid >> 6) & 1) * 64) + (j) * 16 + (((tid & 63) >> 4) * 4))

DEVI void load8f(const float* p, float (&v)[8]) {
    const f32x4 a = *(const f32x4*)p, b = *(const f32x4*)(p + 4);
    v[0] = a[0]; v[1] = a[1]; v[2] = a[2]; v[3] = a[3]; v[4] = b[0]; v[5] = b[1]; v[6] = b[2]; v[7] = b[3];
}
DEVI void load8b(const bf16_t* p, float (&v)[8]) {
    const uint4 a = *(const uint4*)p;
    v[0] = __uint_as_float(a.x << 16); v[1] = __uint_as_float(a.x & 0xffff0000u);
    v[2] = __uint_as_float(a.y << 16); v[3] = __uint_as_float(a.y & 0xffff0000u);
    v[4] = __uint_as_float(a.z << 16); v[5] = __uint_as_float(a.z & 0xffff0000u);
    v[6] = __uint_as_float(a.w << 16); v[7] = __uint_as_float(a.w & 0xffff0000u);
}
DEVI void unpack8(const uint4 a, float (&v)[8]) {
    v[0] = __uint_as_float(a.x << 16); v[1] = __uint_as_float(a.x & 0xffff0000u);
    v[2] = __uint_as_float(a.y << 16); v[3] = __uint_as_float(a.y & 0xffff0000u);
    v[4] = __uint_as_float(a.z << 16); v[5] = __uint_as_float(a.z & 0xffff0000u);
    v[6] = __uint_as_float(a.w << 16); v[7] = __uint_as_float(a.w & 0xffff0000u);
}
DEVI void zero8(float (&v)[8]) {
#pragma unroll
    for (int j = 0; j < 8; ++j) v[j] = 0.f;
}

#define LAS3 __attribute__((address_space(3)))
DEVI int orig_col(int c) { return c < 2304 ? c : (c < OFF_NG ? c + 24 : (c < OFF_END ? c - 4608 : -1)); }
DEVI bool head_tile(int pn) { return pn == 4 || pn == 5 || pn == 7 || pn == 8; }
DEVI int phys2logical(int c) {
    const int pn = c >> 8;
    if (!head_tile(pn)) return c;
    const int p = c & 255, bj = p >> 7, wc = (p >> 5) & 3, i = p & 31;
    return (pn << 8) + wc * 64 + bj * 32 + i;
}
namespace pg8 {
#define PG8_LAS __attribute__((address_space(3)))
typedef unsigned u32x4 __attribute__((ext_vector_type(4)));
constexpr int BM = 256, BK = 64, HALF = 128, HTB = HALF * BK * 2, STAGE_BYTES = 8 * HTB, NXCD = 8, WGM = 8;
DEVI int lds_byte(int r, int c) { const int st = (r >> 4) * 2 + (c >> 5), rr = r & 15, cc = c & 31, ob = rr * 64 + cc * 2; return st * 1024 + (ob ^ (((ob >> 9) & 1) << 5)); }
DEVI void stage_rc(int b, int& R, int& C) { const int st = b / 1024, sb = b % 1024, swz = sb ^ (((sb >> 9) & 1) << 5); R = (st >> 1) * 16 + swz / 64; C = (st & 1) * 32 + (swz % 64) / 2; }
DEVI int perm32(int rho) { const int n = rho >> 4, i = rho & 15; return 8 * (i >> 2) + 4 * n + (i & 3); }
struct Unit { int pm, pn, ao = 0, aux = 0; };
struct Gemm { const bf16_t* A; const bf16_t* Bt; int K, lda, ldb; int kstepA = BK * 2, kstepB = BK * 2; };
struct StaticOrder {
    int nM, nN, nwg, G, c;
    DEVI void init(int M, int N, int G_, int c_) { nM = M / BM; nN = N / BM; nwg = nM * nN; G = G_; c = c_; }
    DEVI bool next(int i, Unit& u) const {
        const long L = (long)i * G + c; if (L >= nwg) return false;
        int wgid = (int)L; { const int q = nwg / NXCD, r = nwg % NXCD, xcd = wgid % NXCD, off = wgid / NXCD; wgid = (xcd < r ? xcd * (q + 1) : r * (q + 1) + (xcd - r) * q) + off; }
        const int nig = WGM * nN, gid = wgid / nig, fm = gid * WGM, gsz = (nM - fm) < WGM ? (nM - fm) : WGM;
        u.pm = fm + ((wgid % nig) % gsz); u.pn = (wgid % nig) / gsz; return true;
    }
};
DEVI unsigned cvt_pk_bf16(float lo, float hi) { unsigned r; asm volatile("v_cvt_pk_bf16_f32 %0, %1, %2" : "=v"(r) : "v"(lo), "v"(hi)); return r; }

template <class Epi, class Sched, bool GATHER = false, bool ALIGN_EPI = true, bool SP2 = true>
DEVI void gemm_phase(PG8_LAS unsigned char* lds, const Gemm g, const Sched& S, const Epi& E) {
    const int tid = TIDX; const int wid = __builtin_amdgcn_readfirstlane(tid >> 6), lane = tid & 63, wr = wid >> 2, wc = wid & 3, fr = lane & 15, fq = lane >> 4;
    const int K = launder_s(g.K), nt = K / BK;
    unsigned voffA[2][2], voffAn[2][2], voffB[2];
    const size_t kstepA = (size_t)g.kstepA, kstepB = (size_t)g.kstepB;
    const size_t hstepA = (size_t)HALF * g.lda * 2, hstepB = (size_t)HALF * g.ldb * 2;
    const size_t tstepA = 2 * hstepA, tstepB = 2 * hstepB;
#pragma unroll
    for (int i = 0; i < 2; ++i) { int R, C; stage_rc(tid * 16 + i * 8192, R, C); const int Rb = Epi::PERM ? ((R & ~31) + perm32(R & 31)) : R;
        voffB[i] = (unsigned)(Rb * g.ldb + C) * 2u;
        if constexpr (GATHER) {
#pragma unroll
            for (int h = 0; h < 2; ++h) { voffA[h][i] = (unsigned)(S.a_row(0, h * HALF + R) * g.lda + C) * 2u; voffAn[h][i] = (unsigned)(S.a_row(1, h * HALF + R) * g.lda + C) * 2u; }
        } else {
#pragma unroll
            for (int h = 0; h < 2; ++h) { voffA[h][i] = (unsigned)(R * g.lda + C) * 2u + (unsigned)(h * hstepA); voffAn[h][i] = voffA[h][i]; }
        } }
    const unsigned ldsw = (unsigned)wid * 1024u;
    const int aoff = lds_byte(wr * 64 + fr, fq * 8), boff = lds_byte(wc * 32 + fr, fq * 8);
#define PG8_SA(b, h) (((b) * 2 + (h)) * HTB)
#define PG8_SB(b, h) ((4 + (b) * 2 + (h)) * HTB)
#define PG8_STAGE(bufoff, gbase, voff) do { _Pragma("unroll") for (int _i = 0; _i < 2; ++_i) \
        __builtin_amdgcn_global_load_lds((const unsigned*)((const char*)(gbase) + (voff)[_i]), (PG8_LAS unsigned*)(lds + (bufoff) + ldsw + _i * 8192), 16, 0, 0); } while (0)
#define PG8_LDA(dst, b, h) do { _Pragma("unroll") for (int m = 0; m < 4; ++m) _Pragma("unroll") for (int k = 0; k < 2; ++k) dst[m][k] = *(const PG8_LAS bf16x8*)(lds + PG8_SA(b, h) + aoff + m * 2048 + k * 1024); } while (0)
#define PG8_LDB(dst, b, h) do { _Pragma("unroll") for (int n = 0; n < 2; ++n) _Pragma("unroll") for (int k = 0; k < 2; ++k) dst[n][k] = *(const PG8_LAS bf16x8*)(lds + PG8_SB(b, h) + boff + n * 2048 + k * 1024); } while (0)
#define PG8_MMA(ai, bj, At, Bt) do { __builtin_amdgcn_s_setprio(1); _Pragma("unroll") for (int m = 0; m < 4; ++m) _Pragma("unroll") for (int n = 0; n < 2; ++n) _Pragma("unroll") for (int k = 0; k < 2; ++k) \
        acc[ai][bj][m][n] = __builtin_amdgcn_mfma_f32_16x16x32_bf16(Bt[n][k], At[m][k], acc[ai][bj][m][n], 0, 0, 0); __builtin_amdgcn_s_setprio(0); } while (0)
#define PG8_WAIT_V(n) asm volatile("s_waitcnt vmcnt(" #n ")" ::: "memory")
#define PG8_WAIT_L(n) asm volatile("s_waitcnt lgkmcnt(" #n ")" ::: "memory")
#define PG8_BAR __builtin_amdgcn_s_barrier()
#define PG8_SCHED __builtin_amdgcn_sched_barrier(0)
    Unit cur, nxt; int ui = 0;
    if (!S.next(0, cur)) return;
    f32x4 acc[2][2][4][2];
#pragma unroll
    for (int a = 0; a < 2; ++a)
#pragma unroll
        for (int b = 0; b < 2; ++b)
#pragma unroll
            for (int m = 0; m < 4; ++m)
#pragma unroll
                for (int n = 0; n < 2; ++n) acc[a][b][m][n] = zero4();
    bf16x8 At[4][2], B0[2][2], B1[2][2];
    const char* cA = GATHER ? (const char*)g.A : (const char*)g.A + (size_t)cur.pm * tstepA + (size_t)cur.ao * 2; const char* cB = (const char*)g.Bt + (size_t)cur.pn * tstepB;
    if constexpr (SP2) {
        PG8_STAGE(PG8_SB(0, 0), cB, voffB); PG8_STAGE(PG8_SB(0, 1), cB + hstepB, voffB); PG8_STAGE(PG8_SA(0, 0), cA, voffA[0]); PG8_STAGE(PG8_SA(0, 1), cA, voffA[1]);
        if (wr == 1) PG8_BAR;
        PG8_WAIT_V(2); PG8_BAR;
        PG8_STAGE(PG8_SB(1, 0), cB + kstepB, voffB); PG8_STAGE(PG8_SA(1, 0), cA + kstepA, voffA[0]); PG8_STAGE(PG8_SB(1, 1), cB + hstepB + kstepB, voffB);
        PG8_WAIT_V(6); PG8_BAR;
    } else {
        PG8_STAGE(PG8_SB(0, 0), cB, voffB); PG8_STAGE(PG8_SA(0, 0), cA, voffA[0]); PG8_STAGE(PG8_SB(0, 1), cB + hstepB, voffB); PG8_STAGE(PG8_SA(0, 1), cA, voffA[1]);
        if (wr == 1) PG8_BAR;
        PG8_WAIT_V(4); PG8_BAR;
        PG8_STAGE(PG8_SB(1, 0), cB + kstepB, voffB); PG8_STAGE(PG8_SA(1, 0), cA + kstepA, voffA[0]); PG8_STAGE(PG8_SB(1, 1), cB + hstepB + kstepB, voffB);
        PG8_WAIT_V(6); PG8_BAR;
    }
    for (;;) {
        const bool has_next = S.next(ui + 1, nxt);
        const char* nA = GATHER ? (const char*)g.A : (has_next ? (const char*)g.A + (size_t)nxt.pm * tstepA + (size_t)nxt.ao * 2 : cA); const char* nB = has_next ? (const char*)g.Bt + (size_t)nxt.pn * tstepB : cB;
        for (int t = 0; t < nt; t += 2) {
            const bool last = (t == nt - 2);
            const char* a1 = cA + (size_t)(t + 1) * kstepA;
            const char* a2 = last ? nA : cA + (size_t)(t + 2) * kstepA; const char* b2 = last ? nB : cB + (size_t)(t + 2) * kstepB;
            const char* a3 = a2 + kstepA; const char* b3 = b2 + kstepB;
            unsigned vA2[2][2];
#pragma unroll
            for (int h = 0; h < 2; ++h)
#pragma unroll
                for (int i = 0; i < 2; ++i) vA2[h][i] = last ? voffAn[h][i] : voffA[h][i];
            if constexpr (SP2) {
            PG8_LDB(B0, 0, 0); PG8_LDB(B1, 0, 1); PG8_SCHED; PG8_LDA(At, 0, 0); PG8_STAGE(PG8_SA(1, 1), a1, voffA[1]);
            PG8_WAIT_V(8); PG8_WAIT_L(0); PG8_BAR; PG8_MMA(0, 0, At, B0); PG8_MMA(0, 1, At, B1); PG8_BAR; PG8_SCHED;
            PG8_LDA(At, 0, 1); PG8_STAGE(PG8_SB(0, 0), b2, voffB); PG8_STAGE(PG8_SB(0, 1), b2 + hstepB, voffB); PG8_STAGE(PG8_SA(0, 0), a2, vA2[0]);
            PG8_WAIT_V(8); PG8_WAIT_L(0); PG8_BAR; PG8_MMA(1, 0, At, B0); PG8_MMA(1, 1, At, B1); PG8_BAR; PG8_SCHED;
            PG8_LDB(B0, 1, 0); PG8_LDB(B1, 1, 1); PG8_SCHED; PG8_LDA(At, 1, 0); PG8_STAGE(PG8_SA(0, 1), a2, vA2[1]);
            PG8_WAIT_V(8); PG8_WAIT_L(0); PG8_BAR; PG8_MMA(0, 0, At, B0); PG8_MMA(0, 1, At, B1); PG8_BAR; PG8_SCHED;
            PG8_LDA(At, 1, 1); PG8_STAGE(PG8_SB(1, 0), b3, voffB); PG8_STAGE(PG8_SB(1, 1), b3 + hstepB, voffB); PG8_STAGE(PG8_SA(1, 0), a3, vA2[0]);
            PG8_WAIT_V(8); PG8_WAIT_L(0); PG8_BAR; PG8_MMA(1, 0, At, B0); PG8_MMA(1, 1, At, B1); PG8_BAR; PG8_SCHED;
            } else {
            PG8_LDB(B0, 0, 0); PG8_SCHED; PG8_LDA(At, 0, 0); PG8_STAGE(PG8_SA(1, 1), a1, voffA[1]);
            PG8_WAIT_L(8); PG8_BAR; PG8_WAIT_L(0); PG8_MMA(0, 0, At, B0); PG8_BAR; PG8_SCHED;
            PG8_LDB(B1, 0, 1); PG8_STAGE(PG8_SB(0, 0), b2, voffB);
            PG8_BAR; PG8_WAIT_L(0); PG8_MMA(0, 1, At, B1); PG8_BAR;
            PG8_LDA(At, 0, 1); PG8_STAGE(PG8_SA(0, 0), a2, vA2[0]);
            PG8_BAR; PG8_WAIT_L(0); PG8_MMA(1, 0, At, B0); PG8_BAR; PG8_SCHED;
            PG8_STAGE(PG8_SB(0, 1), b2 + hstepB, voffB);
            PG8_WAIT_V(6); PG8_BAR; PG8_MMA(1, 1, At, B1); PG8_BAR;
            PG8_LDB(B0, 1, 0); PG8_SCHED; PG8_LDA(At, 1, 0); PG8_STAGE(PG8_SA(0, 1), a2, vA2[1]);
            PG8_WAIT_L(8); PG8_BAR; PG8_WAIT_L(0); PG8_MMA(0, 0, At, B0); PG8_BAR; PG8_SCHED;
            PG8_LDB(B1, 1, 1); PG8_STAGE(PG8_SB(1, 0), b3, voffB);
            PG8_BAR; PG8_WAIT_L(0); PG8_MMA(0, 1, At, B1); PG8_BAR;
            PG8_LDA(At, 1, 1); PG8_STAGE(PG8_SA(1, 0), a3, vA2[0]);
            PG8_BAR; PG8_WAIT_L(0); PG8_MMA(1, 0, At, B0); PG8_BAR; PG8_SCHED;
            PG8_STAGE(PG8_SB(1, 1), b3 + hstepB, voffB);
            PG8_WAIT_V(6); PG8_BAR; PG8_MMA(1, 1, At, B1); PG8_BAR;
            }
        }
        if constexpr (ALIGN_EPI) { if (wr == 0) PG8_BAR; }
        bool keep = false;
        if constexpr (Epi::CHAIN) keep = E.chain(acc, cur, wr, wc, fr, fq);
        else E(acc, cur, wr, wc, fr, fq);
        if (!has_next) break;
        if (!keep) {
#pragma unroll
        for (int a = 0; a < 2; ++a)
#pragma unroll
            for (int b = 0; b < 2; ++b)
#pragma unroll
                for (int m = 0; m < 4; ++m)
#pragma unroll
                    for (int n = 0; n < 2; ++n) acc[a][b][m][n] = zero4();
        }
        cur = nxt; cA = nA; cB = nB; ++ui;
        if constexpr (GATHER) {
#pragma unroll
            for (int h = 0; h < 2; ++h)
#pragma unroll
                for (int i = 0; i < 2; ++i) voffA[h][i] = voffAn[h][i]; }
        if constexpr (ALIGN_EPI) { if (wr == 1) PG8_BAR; }
    }
    PG8_WAIT_V(0);
    if constexpr (!ALIGN_EPI) { if (wr == 0) PG8_BAR; }
    PG8_BAR;
#undef PG8_SA
#undef PG8_SB
#undef PG8_STAGE
#undef PG8_LDA
#undef PG8_LDB
#undef PG8_MMA
#undef PG8_WAIT_V
#undef PG8_WAIT_L
#undef PG8_BAR
#undef PG8_SCHED
}
}

typedef float f32x16 __attribute__((ext_vector_type(16)));
typedef unsigned u32x4v __attribute__((ext_vector_type(4)));
typedef short s16x4 __attribute__((ext_vector_type(4)));
constexpr int NSA_MISC = 49152, NSA_OUT = 53248, NSA_QF = 118784;
constexpr float NSA_NEG = -1e30f, NSA_M0 = -1e20f;
DEVI int crow16(int r, int hi) { return (r & 3) + 8 * (r >> 2) + 4 * hi; }
DEVI float half_max(float v) { auto rr = __builtin_amdgcn_permlane32_swap(__float_as_uint(v), __float_as_uint(v), false, false); return fmaxf(__uint_as_float(rr[0]), __uint_as_float(rr[1])); }
DEVI float half_sum(float v) { auto rr = __builtin_amdgcn_permlane32_swap(__float_as_uint(v), __float_as_uint(v), false, false); return __uint_as_float(rr[0]) + __uint_as_float(rr[1]); }
DEVI unsigned half_or(unsigned v) { auto rr = __builtin_amdgcn_permlane32_swap(v, v, false, false); return rr[0] | rr[1]; }
DEVI int half_addi(int v) { auto rr = __builtin_amdgcn_permlane32_swap((unsigned)v, (unsigned)v, false, false); return (int)(rr[0] + rr[1]); }

template <class LD>
DEVI void tr_item_f(LD ld, bf16_t* dst, int ldd, float* scr, int lane) {
#pragma unroll 8
    for (int i = 0; i < 32; ++i) { const int kk = 2 * i + (lane >> 5); scr[kk * 33 + (lane & 31)] = ld(kk); }
    LDS_FENCE();
    const int c = lane & 7;
#pragma unroll
    for (int j = 0; j < 4; ++j) {
        const int n = (lane >> 3) + 8 * j; const float* s = scr + (8 * c) * 33 + n;
        uint4 o; o.x = pk2(s[0], s[33]); o.y = pk2(s[66], s[99]); o.z = pk2(s[132], s[165]); o.w = pk2(s[198], s[231]);
        *(uint4*)(dst + (size_t)n * ldd + 8 * c) = o;
    }
    LDS_FENCE();
}
DEVI void tr_item(const float* srck0, int ldsrc, int col0, int nvalid, const float* ks, bf16_t* dst, int ldd, float* scr, int lane) {
    const int r8 = lane >> 3, c4 = (lane & 7) * 4;
    const bool ok = (col0 >= 0 && c4 < nvalid);
    const int col = ok ? col0 + c4 : 0;
    const float msk = ok ? 1.f : 0.f;
    f32x4 v[8];
#pragma unroll
    for (int i = 0; i < 8; ++i) v[i] = *(const f32x4*)(srck0 + (size_t)(8 * i + r8) * ldsrc + col);
#pragma unroll
    for (int i = 0; i < 8; ++i) {
        const int kk = 8 * i + r8;
        const float s = ks ? ks[kk] * msk : msk;
        *(f32x4*)(scr + kk * 36 + c4) = v[i] * s;
    }
    LDS_FENCE();
    const int c = lane & 7;
#pragma unroll
    for (int j = 0; j < 4; ++j) {
        const int n = (lane >> 3) + 8 * j; const float* s = scr + (8 * c) * 36 + n;
        uint4 o; o.x = pk2(s[0], s[36]); o.y = pk2(s[72], s[108]); o.z = pk2(s[144], s[180]); o.w = pk2(s[216], s[252]);
        *(uint4*)(dst + (size_t)n * ldd + 8 * c) = o;
    }
    LDS_FENCE();
}
DEVI void phase_prep(const Params& p, bf16_t* WIN, bf16_t* WBR, bf16_t* WO, bf16_t* WRT, bf16_t* W1T, bf16_t* W2T, float* BPE, float* ldsf) {
    const int tid = TIDX; const int bid = BIDX; const int lane = tid & 63, wv = tid >> 6, gw = bid * 8 + wv, ngw = gridDim.x * 8;
    float* scr = ldsf + wv * 2304;
    for (int e = gw * 64 + lane; e < 2 * 2 * 64 * 128; e += ngw * 64) {
        const int lz = e >> 13, d = (e >> 7) & 63, j = e & 127;
        W2T[e] = f2bf(p.in[13][(size_t)lz * 8192 + j * 64 + d]);
    }
    for (int it = gw; it < 2 * 2 * 128; it += ngw) {
        const int lz = it >> 7, j = it & 127;
        const float* pe = p.in[10] + (size_t)lz * 2048; const float* w1 = p.in[11] + (size_t)lz * 2048 * 128 + j;
        float s = 0.f;
#pragma unroll 8
        for (int i = 0; i < 32; ++i) { const int k = lane + 64 * i; s += pe[k] * w1[(size_t)k * 128]; }
        s = wave_sum(s);
        if (lane == 0) BPE[it] = s + p.in[12][it];
    }
    for (int it = gw; it < 2 * 2 * 128; it += ngw) {
        const int lz = it >> 7, r = it & 127, kb = r >> 2, nb = r & 3, k0 = kb * 64, n0 = nb * 32;
        tr_item(p.in[11] + (size_t)lz * 2048 * 128 + (size_t)k0 * 128, 128, n0, 32, nullptr, W1T + ((size_t)lz * 128 + n0) * 2048 + k0, 2048, scr, lane);
    }
    constexpr int I_IN = 16 * 224, I_BR = 8 * 32, I_O = 16 * 32, I_R = 16 * 8, I_L = I_IN + 3 * I_BR + I_O + I_R;
    for (int it = gw; it < 2 * I_L; it += ngw) {
        const int l = it / I_L; int r = it % I_L;
        if (r >= I_L - I_R) {
            r -= I_L - I_R; const int kb = r / 8, nb = r % 8, k0 = kb * 64, n0 = nb * 32, n = n0 + (lane & 31);
            const float* wg = p.in[23] + (size_t)l * DM * 4 + (size_t)k0 * 4; const float* we = p.in[25] + (size_t)l * DM * 32 + (size_t)k0 * 32; const float* gn = p.in[22] + l * DM + k0;
            tr_item_f([&](int kk) { return (n < 4 ? wg[kk * 4 + n] : (n < 36 ? we[kk * 32 + n - 4] : 0.f)) * gn[kk]; }, WRT + ((size_t)l * 256 + n0) * DM + k0, DM, scr, lane);
        } else if (r < I_IN) {
            const int kb = r / 224, nb = r % 224, k0 = kb * 64, n0 = nb * 32;
            tr_item(p.in[2] + (size_t)l * DM * INW + (size_t)k0 * INW, INW, orig_col(phys2logical(n0)), n0 == OFF_NG ? 24 : 32, p.in[1] + l * DM + k0, WIN + ((size_t)l * NPROJ + n0) * DM + k0, DM, scr, lane);
        } else if (r < I_IN + 3 * I_BR) {
            r -= I_IN; const int br = r / I_BR, rr = r % I_BR, kb = rr / 32, nb = rr % 32, k0 = kb * 64, n0 = nb * 32;
            const float* W = (br == 0 ? p.in[18] : (br == 1 ? p.in[19] : p.in[20])) + (size_t)l * 512 * DM;
            tr_item(W + (size_t)k0 * DM, DM, n0, 32, nullptr, WBR + ((size_t)(l * 3 + br) * DM + n0) * 512 + k0, 512, scr, lane);
        } else {
            r -= I_IN + 3 * I_BR; const int kb = r / 32, nb = r % 32, k0 = kb * 64, n0 = nb * 32;
            tr_item(p.in[21] + (size_t)l * DM * DM + (size_t)k0 * DM, DM, n0, 32, nullptr, WO + ((size_t)l * DM + n0) * DM + k0, DM, scr, lane);
        }
    }
}
DEVI void phase_moe_prep(const float* Wg, const float* Wu, const float* Wd, const float* gain, bf16_t* WGU, bf16_t* WD, float* ldsf) {
    const int tid = TIDX; const int bid = BIDX; const int lane = tid & 63, wv = tid >> 6, gw = bid * 8 + wv, ngw = gridDim.x * 8;
    float* scr = ldsf + wv * 2304;
    constexpr int I_GU = 16 * 16, I_D = 4 * 32, I_E = I_GU + I_D;
    int it0, it1;
    if (gridDim.x == 256) { if (bid >= 64) { const int v = (bid - 64) * 8 + wv; it0 = 8 * v; it1 = it0 + 8; } else { it0 = 0; it1 = 0; } }
    else { it0 = gw; it1 = NEXP * I_E; }
    const int istep = (gridDim.x == 256) ? 1 : ngw;
    for (int it = it0; it < it1; it += istep) {
        const int e = it / I_E; int r = it % I_E;
        if (r < I_GU) {
            const int kb = r / 16, nb = r % 16, k0 = kb * 64, n0 = nb * 32;
            const int half = n0 >> 8, isup = (n0 >> 7) & 1, i0 = n0 & 127;
            const float* W = (isup ? Wu : Wg) + (size_t)e * DM * 256 + (size_t)k0 * 256;
            tr_item(W, 256, half * 128 + i0, 32, gain + k0, WGU + ((size_t)e * 512 + n0) * DM + k0, DM, scr, lane);
        } else {
            r -= I_GU; const int kb = r / 32, nb = r % 32, k0 = kb * 64, n0 = nb * 32;
            tr_item(Wd + (size_t)e * 256 * DM + (size_t)k0 * DM, DM, n0, 32, nullptr, WD + ((size_t)e * DM + n0) * 256 + k0, 256, scr, lane);
        }
    }
}

DEVI void phase_xb(const float* x, float* rstd, bf16_t* XB) {
    const int tid = TIDX; const int bid = BIDX; const int lane = tid & 63, gw = bid * 8 + (tid >> 6), ngw = gridDim.x * 8;
    for (int m = gw; m < MTOK; m += ngw) {
        const f32x4* xr = (const f32x4*)(x + (size_t)m * DM) + lane;
        uint2* xo = (uint2*)(XB + (size_t)m * DM) + lane;
        float s = 0.f;
#pragma unroll
        for (int j = 0; j < 4; ++j) { const f32x4 v = xr[64 * j]; s += v[0] * v[0] + v[1] * v[1] + v[2] * v[2] + v[3] * v[3];
            uint2 o; o.x = pk2(v[0], v[1]); o.y = pk2(v[2], v[3]); xo[64 * j] = o; }
        s = wave_sum(s);
        if (lane == 0) rstd[m] = rsqrtf(s * (1.f / DM) + RMS_EPS);
    }
}

struct EpiInproj {
    static constexpr bool PERM = true, CHAIN = false;
    bf16_t* Y; const float* rstd; const float* qn; const float* kn; bf16_t* KVC; unsigned char* G8;
    DEVI void operator()(const f32x4 (&acc)[2][2][4][2], const pg8::Unit& u, int wr, int wc, int fr, int fq) const {
        const int row0 = u.pm * 256 + wr * 64 + fr;
        float rsv[8];
#pragma unroll
        for (int i = 0; i < 8; ++i) rsv[i] = rstd[row0 + (i >> 2) * 128 + (i & 3) * 16];
        __builtin_amdgcn_sched_barrier(0);
        if (head_tile(u.pn)) {
            const bool isq = u.pn < 6, normed = isq || wc < 2;
            const float* gp = isq ? qn : kn + (u.pn == 7 ? 64 : 128);
            float gn[2][8];
#pragma unroll
            for (int bj = 0; bj < 2; ++bj)
#pragma unroll
                for (int e = 0; e < 8; ++e) gn[bj][e] = normed ? gp[32 * bj + 8 * fq + e] * (isq ? 0.125f * 1.4426950408889634f : 1.f) : 1.f;
#pragma unroll
            for (int ai = 0; ai < 2; ++ai)
#pragma unroll
                for (int m = 0; m < 4; ++m) {
                    const int row = row0 + ai * 128 + m * 16; const float rs = rsv[ai * 4 + m];
                    f32x4 v[2][2]; float ss = 0.f;
#pragma unroll
                    for (int bj = 0; bj < 2; ++bj)
#pragma unroll
                        for (int n = 0; n < 2; ++n) { v[bj][n] = acc[ai][bj][m][n] * rs; ss += v[bj][n][0] * v[bj][n][0] + v[bj][n][1] * v[bj][n][1] + v[bj][n][2] * v[bj][n][2] + v[bj][n][3] * v[bj][n][3]; }
                    ss += shx(ss, 16); ss += shx(ss, 32);
                    const float hs = normed ? rsqrtf(ss * (1.f / 64.f) + RMS_EPS) : 1.f;
#pragma unroll
                    for (int bj = 0; bj < 2; ++bj) {
                        uint4 w;
                        w.x = pk2(v[bj][0][0] * hs * gn[bj][0], v[bj][0][1] * hs * gn[bj][1]); w.y = pk2(v[bj][0][2] * hs * gn[bj][2], v[bj][0][3] * hs * gn[bj][3]);
                        w.z = pk2(v[bj][1][0] * hs * gn[bj][4], v[bj][1][1] * hs * gn[bj][5]); w.w = pk2(v[bj][1][2] * hs * gn[bj][6], v[bj][1][3] * hs * gn[bj][7]);
                        *(uint4*)(Y + (size_t)row * LDY + u.pn * 256 + wc * 64 + 32 * bj + 8 * fq) = w;
                    }
                }
            return;
        }
        const int col0 = u.pn * 256 + wc * 32 + 8 * fq;
#pragma unroll
        for (int ai = 0; ai < 2; ++ai)
#pragma unroll
            for (int m = 0; m < 4; ++m) {
                const int row = row0 + ai * 128 + m * 16; const float rs = rsv[ai * 4 + m];
#pragma unroll
                for (int bj = 0; bj < 2; ++bj) {
                    const int col = col0 + bj * 128;
                    if (col >= OFF_END) continue;
                    f32x4 v0 = acc[ai][bj][m][0] * rs, v1 = acc[ai][bj][m][1] * rs;
                    if (col >= OFF_RY && col < OFF_Q) {
#pragma unroll
                        for (int e = 0; e < 4; ++e) { v0[e] = gelu_tanh(v0[e]); v1[e] = gelu_tanh(v1[e]); }
                    } else if (col >= OFF_MG) {
#pragma unroll
                        for (int e = 0; e < 4; ++e) { v0[e] = sigmoidf_(v0[e]); v1[e] = sigmoidf_(v1[e]); }
                        if (col < OFF_NG) {
                            uint2 w8;
                            w8.x = (unsigned)(v0[0] * 255.f + 0.5f) | ((unsigned)(v0[1] * 255.f + 0.5f) << 8) | ((unsigned)(v0[2] * 255.f + 0.5f) << 16) | ((unsigned)(v0[3] * 255.f + 0.5f) << 24);
                            w8.y = (unsigned)(v1[0] * 255.f + 0.5f) | ((unsigned)(v1[1] * 255.f + 0.5f) << 8) | ((unsigned)(v1[2] * 255.f + 0.5f) << 16) | ((unsigned)(v1[3] * 255.f + 0.5f) << 24);
                            const int T = u.pm * 12 + (u.pn - 15), s_ = (ai * 4 + m) * 2 + bj, tid_ = (wr * 4 + wc) * 64 + fq * 16 + fr;
                            *(uint2*)(G8 + ((size_t)(T * 16 + s_) * 512 + tid_) * 8) = w8;
                            continue;
                        }
                    }
                    uint4 w; w.x = pk2(v0[0], v0[1]); w.y = pk2(v0[2], v0[3]); w.z = pk2(v1[0], v1[1]); w.w = pk2(v1[2], v1[3]);
                    if (u.pn == 6) *(uint4*)(KVC + (size_t)row * 256 + (col - OFF_KC)) = w;
                    else *(uint4*)(Y + (size_t)row * LDY + (col >= OFF_NG ? col - OFF_NG + OFF_NGY : col)) = w;
                }
            }
    }
};
DEVI void gate8(const uint2 w, float (&g)[8]) {
#pragma unroll
    for (int e = 0; e < 4; ++e) { g[e] = (float)((w.x >> (8 * e)) & 255u) * (1.f / 255.f); g[4 + e] = (float)((w.y >> (8 * e)) & 255u) * (1.f / 255.f); }
}
struct MergeOrder {
    pg8::StaticOrder so;
    DEVI bool next(int i, pg8::Unit& u) const {
        pg8::Unit t; if (!so.next(i / 3, t)) return false;
        const int br = i % 3;
        u.pm = t.pm; u.pn = br * 4 + t.pn; u.ao = br == 0 ? OFF_RY : (br == 1 ? OFF_RX : OFF_SB); return true;
    }
};
struct EpiMerge {
    static constexpr bool PERM = true, CHAIN = true;
    bf16_t* Y; const unsigned char* G8;
    DEVI void operator()(const f32x4 (&)[2][2][4][2], const pg8::Unit&, int, int, int, int) const {}
    DEVI bool chain(f32x4 (&acc)[2][2][4][2], const pg8::Unit& u, int wr, int wc, int fr, int fq) const {
        const int br = u.pn >> 2;
        const int row0 = u.pm * 256 + wr * 64 + fr, col0 = (u.pn & 3) * 256 + wc * 32 + 8 * fq;
        const int tid_ = (wr * 4 + wc) * 64 + fq * 16 + fr;
        const unsigned char* gp0 = G8 + ((size_t)((u.pm * 12 + br * 4 + (u.pn & 3)) * 16) * 512 + tid_) * 8;
        if (br < 2) {
#pragma unroll
            for (int ai = 0; ai < 2; ++ai) {
                uint2 wg[8], wn[8];
#pragma unroll
                for (int s = 0; s < 8; ++s) { wg[s] = *(const uint2*)(gp0 + (ai * 8 + s) * 4096); wn[s] = *(const uint2*)(gp0 + (ai * 8 + s) * 4096 + 4 * 16 * 4096); }
                __builtin_amdgcn_sched_barrier(0);
#pragma unroll
                for (int s = 0; s < 8; ++s) {
                    const int m = s >> 1, bj = s & 1;
                    float g[8], gnx[8]; gate8(wg[s], g); gate8(wn[s], gnx);
#pragma unroll
                    for (int e = 0; e < 8; ++e) { const float r = fmaxf(g[e], 9.5367431640625e-7f) * __builtin_amdgcn_rcpf(fmaxf(gnx[e], 9.5367431640625e-7f)); acc[ai][bj][m][e >> 2][e & 3] *= r; }
                }
            }
        } else {
#pragma unroll
            for (int ai = 0; ai < 2; ++ai) {
                uint2 wg[8];
#pragma unroll
                for (int s = 0; s < 8; ++s) wg[s] = *(const uint2*)(gp0 + (ai * 8 + s) * 4096);
                __builtin_amdgcn_sched_barrier(0);
#pragma unroll
                for (int s = 0; s < 8; ++s) {
                    const int m = s >> 1, bj = s & 1;
                    const int row = row0 + ai * 128 + m * 16;
                    float g[8]; gate8(wg[s], g);
#pragma unroll
                    for (int e = 0; e < 8; ++e) g[e] = fmaxf(g[e], 9.5367431640625e-7f);
                    uint4 w;
                    w.x = pk2(g[0] * acc[ai][bj][m][0][0], g[1] * acc[ai][bj][m][0][1]); w.y = pk2(g[2] * acc[ai][bj][m][0][2], g[3] * acc[ai][bj][m][0][3]);
                    w.z = pk2(g[4] * acc[ai][bj][m][1][0], g[5] * acc[ai][bj][m][1][1]); w.w = pk2(g[6] * acc[ai][bj][m][1][2], g[7] * acc[ai][bj][m][1][3]);
                    *(uint4*)(Y + (size_t)row * LDY + OFF_SC + col0 + bj * 128) = w;
                }
            }
        }
        return br < 2;
    }
};
DEVI float row_rstd16(const float* ssp) {
    const f32x4 a = *(const f32x4*)ssp, b = *(const f32x4*)(ssp + 4), c = *(const f32x4*)(ssp + 8), d = *(const f32x4*)(ssp + 12);
    const float s = ((a[0] + a[1]) + (a[2] + a[3])) + ((b[0] + b[1]) + (b[2] + b[3])) + ((c[0] + c[1]) + (c[2] + c[3])) + ((d[0] + d[1]) + (d[2] + d[3]));
    return rsqrtf(s * (1.f / DM) + RMS_EPS);
}
struct EpiOut {
    static constexpr bool PERM = false, CHAIN = false;
    bf16_t* XB; float* SS;
    DEVI void operator()(const f32x4 (&acc)[2][2][4][2], const pg8::Unit& u, int wr, int wc, int fr, int fq) const {
        const int row0 = u.pm * 256 + wr * 64 + fr, col0 = u.pn * 256 + wc * 32 + 4 * fq;
#pragma unroll
        for (int ai = 0; ai < 2; ++ai) {
            uint2 xin[4][4];
#pragma unroll
            for (int m = 0; m < 4; ++m)
#pragma unroll
                for (int q = 0; q < 4; ++q) xin[m][q] = *(const uint2*)(XB + (size_t)(row0 + ai * 128 + m * 16) * DM + col0 + (q >> 1) * 128 + (q & 1) * 16);
            __builtin_amdgcn_sched_barrier(0);
#pragma unroll
            for (int m = 0; m < 4; ++m) {
                const int row = row0 + ai * 128 + m * 16;
                const size_t ro = (size_t)row * DM + col0;
                float s = 0.f;
#pragma unroll
                for (int bj = 0; bj < 2; ++bj)
#pragma unroll
                    for (int n = 0; n < 2; ++n) {
                        const size_t off = ro + bj * 128 + n * 16;
                        const uint2 xr = xin[m][bj * 2 + n];
                        f32x4 v = acc[ai][bj][m][n];
                        v[0] += __uint_as_float(xr.x << 16); v[1] += __uint_as_float(xr.x & 0xffff0000u); v[2] += __uint_as_float(xr.y << 16); v[3] += __uint_as_float(xr.y & 0xffff0000u);
                        uint2 w; w.x = pk2(v[0], v[1]); w.y = pk2(v[2], v[3]);
                        *(uint2*)(XB + off) = w;
                        const float r0 = __uint_as_float(w.x << 16), r1 = __uint_as_float(w.x & 0xffff0000u), r2 = __uint_as_float(w.y << 16), r3 = __uint_as_float(w.y & 0xffff0000u);
                        s += r0 * r0 + r1 * r1 + r2 * r2 + r3 * r3;
                    }
                s += shx(s, 16); s += shx(s, 32);
                if (fq == 0) SS[(size_t)row * 16 + u.pn * 4 + wc] = s;
            }
        }
    }
};
struct CmpOrder {
    int G, c;
    DEVI bool next(int i, pg8::Unit& u) const {
        const int L = i * G + c; if (L >= 16) return false;
        const int z = L >> 3, g = (L >> 2) & 1, b = L & 3;
        u.pm = b; u.pn = 0; u.ao = z * 128 + g * 64; return true;
    }
};
struct EpiCmp1 {
    static constexpr bool PERM = false, CHAIN = false;
    bf16_t* HID; const float* BPE;
    DEVI void operator()(const f32x4 (&acc)[2][2][4][2], const pg8::Unit& u, int wr, int wc, int fr, int fq) const {
        const int z = u.ao >> 7, g = (u.ao >> 6) & 1, b = u.pm;
        const int col0 = wc * 32 + 4 * fq;
        const f32x4 bb0 = *(const f32x4*)(BPE + z * 128 + col0), bb1 = *(const f32x4*)(BPE + z * 128 + col0 + 16);
#pragma unroll
        for (int ai = 0; ai < 2; ++ai)
#pragma unroll
            for (int m = 0; m < 4; ++m) {
                const int n = ai * 128 + wr * 64 + m * 16 + fr;
                if (n >= NCMP) continue;
                bf16_t* dst = HID + ((size_t)z * 2048 + (size_t)(b * NCMP + n) * 2 + g) * 128 + col0;
#pragma unroll
                for (int nn = 0; nn < 2; ++nn) {
                    const f32x4 a = z ? acc[ai][1][m][nn] : acc[ai][0][m][nn];
                    const f32x4 bb = nn ? bb1 : bb0;
                    uint2 o; o.x = pk2(gelu_tanh(a[0] + bb[0]), gelu_tanh(a[1] + bb[1])); o.y = pk2(gelu_tanh(a[2] + bb[2]), gelu_tanh(a[3] + bb[3]));
                    *(uint2*)(dst + nn * 16) = o;
                }
            }
    }
};
DEVI void cmp2_unit(const bf16_t* HID, const bf16_t* W2T  , const float* b2  , const float* kn0  , bf16_t* KCB, bf16_t* VCB, int z, int g, int b) {
    const int tid = TIDX; const int lane = tid & 63, w = tid >> 6, r32 = lane & 31, hi = lane >> 5;
    const int n = 32 * w + r32;
    const bf16_t* hrow = HID + ((size_t)z * 2048 + (size_t)(b * NCMP + (n < NCMP ? n : 0)) * 2 + g) * 128;
    f32x16 acc[2];
#pragma unroll
    for (int blk = 0; blk < 2; ++blk)
#pragma unroll
        for (int r = 0; r < 16; ++r) acc[blk][r] = 0.f;
#pragma unroll
    for (int sh = 0; sh < 2; ++sh) {
        bf16x8 hf[4], wf[4][2];
#pragma unroll
        for (int s = 0; s < 4; ++s) {
            hf[s] = *(const bf16x8*)(hrow + 16 * (4 * sh + s) + 8 * hi);
#pragma unroll
            for (int blk = 0; blk < 2; ++blk) wf[s][blk] = *(const bf16x8*)(W2T + ((size_t)z * 64 + 32 * blk + r32) * 128 + 16 * (4 * sh + s) + 8 * hi);
        }
        __builtin_amdgcn_sched_barrier(0);
#pragma unroll
        for (int s = 0; s < 4; ++s)
#pragma unroll
            for (int blk = 0; blk < 2; ++blk) acc[blk] = __builtin_amdgcn_mfma_f32_32x32x16_bf16(wf[s][blk], hf[s], acc[blk], 0, 0, 0);
    }
    float ss = 0.f;
#pragma unroll
    for (int blk = 0; blk < 2; ++blk)
#pragma unroll
        for (int r = 0; r < 16; ++r) { acc[blk][r] += b2[z * 64 + 32 * blk + crow16(r, hi)]; ss += acc[blk][r] * acc[blk][r]; }
    ss = half_sum(ss);
    const float rs = (z == 0) ? rsqrtf(ss * (1.f / 64.f) + RMS_EPS) : 1.f;
    bf16_t* dst = (z ? VCB : KCB) + ((size_t)((b * 2 + g) * 256) + n) * 64;
#pragma unroll
    for (int blk = 0; blk < 2; ++blk)
#pragma unroll
        for (int gi = 0; gi < 4; ++gi) {
            const int d0 = 32 * blk + 8 * gi + 4 * hi;
            float o[4];
#pragma unroll
            for (int e = 0; e < 4; ++e) o[e] = (n < NCMP) ? acc[blk][4 * gi + e] * rs * (z == 0 ? kn0[d0 + e] : 1.f) : 0.f;
            uint2 wv; wv.x = pk2(o[0], o[1]); wv.y = pk2(o[2], o[3]);
            *(uint2*)(dst + d0) = wv;
        }
}
struct EpiRouter {
    static constexpr bool PERM = false, CHAIN = false;
    float* LOG; const float* SS;
    DEVI void operator()(const f32x4 (&acc)[2][2][4][2], const pg8::Unit& u, int wr, int wc, int fr, int fq) const {
        if (wc >= 2) return;
        const int row0 = u.pm * 256 + wr * 64 + fr, col0 = wc * 32 + 4 * fq;
#pragma unroll
        for (int ai = 0; ai < 2; ++ai)
#pragma unroll
            for (int m = 0; m < 4; ++m) {
                const int row = row0 + ai * 128 + m * 16;
                const float rs = row_rstd16(SS + (size_t)row * 16);
#pragma unroll
                for (int n = 0; n < 2; ++n) *(f32x4*)(LOG + (size_t)row * 64 + col0 + n * 16) = acc[ai][0][m][n] * rs;
            }
    }
};
constexpr int LDS_ROWT = 132096;
struct EpiMoeUp {
    static constexpr bool PERM = true, CHAIN = false;
    bf16_t* HM; const float* wl; const float* rsl;
    DEVI void operator()(const f32x4 (&acc)[2][2][4][2], const pg8::Unit& u, int wr, int wc, int fr, int fq) const {
        const int rl0 = wr * 64 + fr, col0 = (u.pn & 1) * 128 + wc * 32 + 8 * fq;
#pragma unroll
        for (int ai = 0; ai < 2; ++ai)
#pragma unroll
            for (int m = 0; m < 4; ++m) {
                const int rl = rl0 + ai * 128 + m * 16; const float w = wl[u.aux * 256 + rl], rs = rsl[u.aux * 256 + rl];
                float h[8];
#pragma unroll
                for (int n = 0; n < 2; ++n)
#pragma unroll
                    for (int q = 0; q < 4; ++q) { const float g = acc[ai][0][m][n][q] * rs; h[n * 4 + q] = g * sigmoidf_(g) * (acc[ai][1][m][n][q] * rs) * w; }
                uint4 o; o.x = pk2(h[0], h[1]); o.y = pk2(h[2], h[3]); o.z = pk2(h[4], h[5]); o.w = pk2(h[6], h[7]);
                *(uint4*)(HM + (size_t)(u.pm * 256 + rl) * 256 + col0) = o;
            }
    }
};
DEVI void moe_xcd(const int* tb, int G, int bid, int& rt0, int& ntile, int& j, int& per) {
    if ((G & 7) == 0) { const int x = bid & 7; rt0 = tb[4 * x]; ntile = tb[4 * x + 4] - rt0; j = bid >> 3; per = G >> 3; }
    else { rt0 = 0; ntile = tb[NEXP]; j = bid; per = G; }
}
DEVI int moe_rounds(const int* tb, int G, int nsplit) {
    int r = 0;
    if ((G & 7) == 0) { for (int x = 0; x < 8; ++x) { const int u = (tb[4 * x + 4] - tb[4 * x]) * nsplit, q = (u + (G >> 3) - 1) / (G >> 3); r = q > r ? q : r; } }
    else r = (tb[NEXP] * nsplit + G - 1) / G;
    return r;
}
struct MoeUpOrder {
    const int* tb; int G, c, r; const int* tokl;
    DEVI bool unit(int& rt, int& part) const {
        int rt0, ntile, j, per; moe_xcd(tb, G, c, rt0, ntile, j, per);
        const int u = r * per + j; if (u >= ntile * 2) return false;
        rt = rt0 + (u >> 1); part = u & 1; return true;
    }
    DEVI bool next(int i, pg8::Unit& u) const {
        int rt, part; if (i >= 1 || !unit(rt, part)) return false;
        u.pm = rt; u.pn = tb[40 + rt] * 2 + part; u.aux = 0; return true;
    }
    DEVI int a_row(int ord, int r_) const { return tokl[r_]; }
};
DEVI void moe_tables(const int* cnt, int* tb) {
    const int tid = TIDX;
    __syncthreads();
    if (tid == 0) { int a = 0; for (int e = 0; e < NEXP; ++e) { tb[e] = a; a += (cnt[e] + 255) >> 8; } tb[NEXP] = a; }
    __syncthreads();
    if (tid < 192) { int e = 0; for (int q = 1; q < NEXP; ++q) e += (tb[q] <= tid) ? 1 : 0; tb[40 + tid] = e; }
    __syncthreads();
}
DEVI void moe_up_setup(const int* cnt, const int* LIST, const float* RW, const float* SS, int* TOKS, const MoeUpOrder& S, int* tokl, float* wl, float* rsl) {
    const int tid = TIDX;
    __syncthreads();
    if (tid < 256) {
        const int rl = tid;
        int tok = 0; float w = 0.f, rs = 0.f;
        int rt, part;
        if (S.unit(rt, part)) {
            const int e = S.tb[40 + rt], r = (rt - S.tb[e]) * 256 + rl;
            int slot = -1;
            if (r < cnt[e]) { slot = LIST[e * MTOK + r]; tok = slot >> 1; w = RW[slot]; rs = row_rstd16(SS + (size_t)tok * 16); }
            TOKS[rt * 256 + rl] = slot;
        }
        tokl[tid] = tok; wl[tid] = w; rsl[tid] = rs;
    }
    __syncthreads();
}
struct EpiMoeDown {
    static constexpr bool PERM = true, CHAIN = false;
    bf16_t* YS; const int* SLOTS;
    DEVI void operator()(const f32x4 (&acc)[2][2][4][2], const pg8::Unit& u, int wr, int wc, int fr, int fq) const {
        const int row0 = u.pm * 256 + wr * 64 + fr, col0 = (u.pn & 3) * 256 + wc * 32 + 8 * fq;
        int slv[8];
#pragma unroll
        for (int i = 0; i < 8; ++i) slv[i] = SLOTS[row0 + (i >> 2) * 128 + (i & 3) * 16];
        __builtin_amdgcn_sched_barrier(0);
#pragma unroll
        for (int ai = 0; ai < 2; ++ai)
#pragma unroll
            for (int m = 0; m < 4; ++m) {
                const int slot = slv[ai * 4 + m];
                if (slot >= 0) {
                    bf16_t* dst = YS + (size_t)slot * DM + col0;
#pragma unroll
                    for (int bj = 0; bj < 2; ++bj) {
                        uint4 w; w.x = pk2(acc[ai][bj][m][0][0], acc[ai][bj][m][0][1]); w.y = pk2(acc[ai][bj][m][0][2], acc[ai][bj][m][0][3]);
                        w.z = pk2(acc[ai][bj][m][1][0], acc[ai][bj][m][1][1]); w.w = pk2(acc[ai][bj][m][1][2], acc[ai][bj][m][1][3]);
                        *(uint4*)(dst + bj * 128) = w;
                    }
                }
                asm volatile("" ::: "memory");
            }
    }
};
DEVI void phase_combine(bf16_t* XB, const bf16_t* YS, float* rstd, float* xout, bool next) {
    const int tid = TIDX; const int bid = BIDX; const int lane = tid & 63, gw = bid * 8 + (tid >> 6), ngw = gridDim.x * 8;
    for (int m0 = gw * 2; m0 < MTOK; m0 += ngw * 2) {
        uint2 xv[2][4], a[2][4], b[2][4];
#pragma unroll
        for (int u = 0; u < 2; ++u) {
            const int m = m0 + u;
            const uint2* xr = (const uint2*)(XB + (size_t)m * DM) + lane;
            const uint2* y0 = (const uint2*)(YS + (size_t)(2 * m) * DM) + lane; const uint2* y1 = (const uint2*)(YS + (size_t)(2 * m + 1) * DM) + lane;
#pragma unroll
            for (int j = 0; j < 4; ++j) { xv[u][j] = xr[64 * j]; a[u][j] = y0[64 * j]; b[u][j] = y1[64 * j]; }
        }
#pragma unroll
        for (int u = 0; u < 2; ++u) {
            const int m = m0 + u;
            f32x4* xr = (f32x4*)(xout + (size_t)m * DM) + lane; uint2* xo = (uint2*)(XB + (size_t)m * DM) + lane;
            float s = 0.f;
#pragma unroll
            for (int j = 0; j < 4; ++j) {
                const uint2 xx = xv[u][j], aa = a[u][j], bb = b[u][j];
                f32x4 w;
                w[0] = __uint_as_float(xx.x << 16) + __uint_as_float(aa.x << 16) + __uint_as_float(bb.x << 16); w[1] = __uint_as_float(xx.x & 0xffff0000u) + __uint_as_float(aa.x & 0xffff0000u) + __uint_as_float(bb.x & 0xffff0000u);
                w[2] = __uint_as_float(xx.y << 16) + __uint_as_float(aa.y << 16) + __uint_as_float(bb.y << 16); w[3] = __uint_as_float(xx.y & 0xffff0000u) + __uint_as_float(aa.y & 0xffff0000u) + __uint_as_float(bb.y & 0xffff0000u);
                if (next) {
                    uint2 o; o.x = pk2(w[0], w[1]); o.y = pk2(w[2], w[3]); xo[64 * j] = o;
                    const float r0 = __uint_as_float(o.x << 16), r1 = __uint_as_float(o.x & 0xffff0000u), r2 = __uint_as_float(o.y << 16), r3 = __uint_as_float(o.y & 0xffff0000u);
                    s += r0 * r0 + r1 * r1 + r2 * r2 + r3 * r3;
                } else xr[64 * j] = w;
            }
            if (next) { s = wave_sum(s); if (lane == 0) rstd[m] = rsqrtf(s * (1.f / DM) + RMS_EPS); }
        }
    }
}
struct MoeOrder {
    const int* tb; int nsplit, G, c;
    DEVI bool next(int i, pg8::Unit& u) const {
        int rt0, ntile, j, per; moe_xcd(tb, G, c, rt0, ntile, j, per);
        const int L = i * per + j; if (L >= ntile * nsplit) return false;
        const int rt = rt0 + L / nsplit, part = L % nsplit;
        u.pm = rt; u.pn = tb[40 + rt] * nsplit + part; return true;
    }
};

DEVI void phase_gather(const bf16_t* XB, const float* SS, const int* cnt, const int* LIST, const float* RW, bf16_t* XG, int* TOKS, float* RWS, int* tb) {
    const int tid = TIDX; const int bid = BIDX; const int lane = tid & 63, gw = bid * 8 + (tid >> 6), ngw = gridDim.x * 8;
    if (tid == 0) { int a = 0; for (int e = 0; e < NEXP; ++e) { tb[e] = a; a += (cnt[e] + 255) >> 8; } tb[NEXP] = a; }
    __syncthreads();
    if (tid < 192) { int e = 0; for (int q = 1; q < NEXP; ++q) e += (tb[q] <= tid) ? 1 : 0; tb[40 + tid] = e; }
    __syncthreads();
    const int total = tb[NEXP] * 256;
    for (int rp0 = gw * 4; rp0 < total; rp0 += ngw * 4) {
        int slot[4]; bool ok[4];
#pragma unroll
        for (int q = 0; q < 4; ++q) {
            const int rp = rp0 + q, rt = rp >> 8;
            const int e = tb[40 + rt];
            const int r = rp - tb[e] * 256;
            ok[q] = r < cnt[e];
            slot[q] = ok[q] ? LIST[e * MTOK + r] : 0;
        }
        uint4 xr[4][2]; float rs[4], rw[4];
#pragma unroll
        for (int q = 0; q < 4; ++q) {
            const int tok = slot[q] >> 1;
            rs[q] = row_rstd16(SS + (size_t)tok * 16); rw[q] = RW[slot[q]];
            const uint4* xp = (const uint4*)(XB + (size_t)tok * DM) + lane;
            xr[q][0] = xp[0]; xr[q][1] = xp[64];
        }
#pragma unroll
        for (int q = 0; q < 4; ++q) {
            const int rp = rp0 + q;
            if (ok[q]) {
                uint4* xo = (uint4*)(XG + (size_t)rp * DM) + lane;
#pragma unroll
                for (int j = 0; j < 2; ++j) { float v[8]; unpack8(xr[q][j], v); const float s = rs[q]; uint4 o; o.x = pk2(v[0] * s, v[1] * s); o.y = pk2(v[2] * s, v[3] * s); o.z = pk2(v[4] * s, v[5] * s); o.w = pk2(v[6] * s, v[7] * s); xo[64 * j] = o; }
            }
            if (lane == 0) { TOKS[rp] = ok[q] ? slot[q] : -1; RWS[rp] = ok[q] ? rw[q] : 0.f; }
        }
    }
}

#ifndef NSA_FAST
#define NSA_FAST 1
#endif
DEVI void phase_qknorm(bf16_t* Y, const float* qn  , const float* kn  , int vb, int vg) {
    const int tid = TIDX; const int bid = vb; const int lane = tid & 63, gw = bid * 8 + (tid >> 6), ngw = vg * 8;
    const int sl = lane >> 4, e0 = (lane & 15) * 4;
    const int col2 = (sl < 2 ? OFF_KS + sl * 64 : OFF_KW + (sl - 2) * 64);
    const float* gn2 = kn + (sl < 2 ? 64 : 128);
    float g[3][4];
#pragma unroll
    for (int e = 0; e < 4; ++e) { g[0][e] = qn[e0 + e]; g[1][e] = g[0][e]; g[2][e] = gn2[e0 + e]; }
#if NSA_FAST
#pragma unroll
    for (int e = 0; e < 4; ++e) { g[0][e] *= 0.125f * 1.4426950408889634f; g[1][e] *= 0.125f * 1.4426950408889634f; }
#endif
    for (int m0 = gw * 2; m0 < MTOK; m0 += ngw * 2) {
        uint2 raw[2][3];
#pragma unroll
        for (int u = 0; u < 2; ++u) {
            bf16_t* row = Y + (size_t)(m0 + u) * LDY;
            raw[u][0] = *(const uint2*)(row + OFF_Q + sl * 64 + e0); raw[u][1] = *(const uint2*)(row + OFF_Q + (4 + sl) * 64 + e0); raw[u][2] = *(const uint2*)(row + col2 + e0);
        }
#pragma unroll
        for (int u = 0; u < 2; ++u) {
            bf16_t* row = Y + (size_t)(m0 + u) * LDY;
#pragma unroll
            for (int part = 0; part < 3; ++part) {
                const uint2 r = raw[u][part];
                const float v0 = __uint_as_float(r.x << 16), v1 = __uint_as_float(r.x & 0xffff0000u), v2 = __uint_as_float(r.y << 16), v3 = __uint_as_float(r.y & 0xffff0000u);
                float s = v0 * v0 + v1 * v1 + v2 * v2 + v3 * v3;
                s += shx(s, 1); s += shx(s, 2); s += shx(s, 4); s += shx(s, 8);
                const float rs = rsqrtf(s * (1.f / 64.f) + RMS_EPS);
                uint2 o; o.x = pk2(v0 * rs * g[part][0], v1 * rs * g[part][1]); o.y = pk2(v2 * rs * g[part][2], v3 * rs * g[part][3]);
                *(uint2*)(row + (part == 0 ? OFF_Q + sl * 64 : (part == 1 ? OFF_Q + (4 + sl) * 64 : col2)) + e0) = o;
            }
        }
    }
}

DEVI void phase_rglru1(const bf16_t* Y, const float* convw  , const float* convb, const float* wa  , const float* ba,
                       const float* wx, const float* bx, const float* lam, float* LA, bf16_t* VV, float* PA, float* PH, float* lds, int vb, int vg) {
    bf16_t* UB = (bf16_t*)lds;
    bf16_t* WT = UB + 64 * 72;
    float* SEG = (float*)(WT + 128 * 72);
    const int tid = TIDX;
    const int n = vb & 7;
    const int nper = vg >> 3;
    if ((vb >> 3) >= nper) return;
    __syncthreads();
    for (int e = tid; e < 8192; e += 512) {
        const int o = e & 127, i = e >> 7;
        WT[o * 72 + i] = f2bf(o < 64 ? wa[n * 4096 + i * 64 + o] : wx[n * 4096 + i * 64 + o - 64]);
    }
    const int j = tid & 63, tg = tid >> 6;
    const int lane = tid & 63, w = tid >> 6, mt = w & 3, cgp = w >> 2;
    const int chj = n * 64 + j;
    const float cw0 = convw[chj], cw1 = convw[512 + chj], cw2 = convw[1024 + chj], cw3 = convw[1536 + chj], cb = convb[chj];
    float bav[2], bxv[2], sp[2];
#pragma unroll
    for (int q = 0; q < 2; ++q) {
        const int ch = n * 64 + 16 * (cgp * 2 + q) + (lane & 15);
        bav[q] = ba[ch]; bxv[q] = bx[ch];
        const float ex = __expf(-lam[ch]);
        sp[q] = (ex < 0.03f) ? ex * (1.f - ex * (0.5f - ex * (0.33333334f - 0.25f * ex))) : __logf(1.f + ex);
    }
    float xin[2][11];
    const int c00 = vb >> 3;
#pragma unroll
    for (int u = 0; u < 2; ++u) {
        const int c = c00 + u * nper; const int tl0 = (c & 63) * 64; const size_t m0 = (size_t)c * 64;
#pragma unroll
        for (int i = 0; i < 11; ++i) {
            const int t = tg * 8 + i - 3; const bool ok = c < 256 && tl0 + t >= 0;
            const float v = bf2f(Y[(ok ? m0 + t : (size_t)0) * LDY + OFF_RX + chj]); xin[u][i] = ok ? v : 0.f;
        }
    }
    bf16_t* UB1 = (bf16_t*)(SEG + 2 * 16 * 64 * 2);
    for (int c0 = c00; c0 < 256; c0 += 2 * nper) {
        __syncthreads();
#pragma unroll
        for (int u = 0; u < 2; ++u) {
            bf16_t* ub = u ? UB1 : UB;
#pragma unroll
            for (int q = 0; q < 8; ++q) ub[(tg * 8 + q) * 72 + j] = f2bf(cb + cw0 * xin[u][q] + cw1 * xin[u][q + 1] + cw2 * xin[u][q + 2] + cw3 * xin[u][q + 3]);
        }
#pragma unroll
        for (int u = 0; u < 2; ++u) {
            const int cn = c0 + (2 + u) * nper; const int tl0 = (cn & 63) * 64; const size_t mn = (size_t)cn * 64;
#pragma unroll
            for (int i = 0; i < 11; ++i) {
                const int t = tg * 8 + i - 3; const bool ok = cn < 256 && tl0 + t >= 0;
                const float v = bf2f(Y[(ok ? mn + t : (size_t)0) * LDY + OFF_RX + chj]); xin[u][i] = ok ? v : 0.f;
            }
        }
        __syncthreads();
#pragma unroll
        for (int u = 0; u < 2; ++u) {
            const int c = c0 + u * nper;
            if (c >= 256) continue;
            const bf16_t* ub = u ? UB1 : UB; float* seg = SEG + u * (16 * 64 * 2);
            const size_t m0 = (size_t)c * 64;
            f32x4 accr[2], acci[2];
#pragma unroll
            for (int q = 0; q < 2; ++q) { accr[q] = zero4(); acci[q] = zero4(); }
#pragma unroll
            for (int ks = 0; ks < 2; ++ks) {
                const bf16x8 af = *(const bf16x8*)(ub + (16 * mt + (lane & 15)) * 72 + 8 * (lane >> 4) + 32 * ks);
#pragma unroll
                for (int q = 0; q < 2; ++q) {
                    const int o = 16 * (cgp * 2 + q) + (lane & 15);
                    const bf16x8 br_ = *(const bf16x8*)(WT + o * 72 + 8 * (lane >> 4) + 32 * ks);
                    const bf16x8 bi_ = *(const bf16x8*)(WT + (64 + o) * 72 + 8 * (lane >> 4) + 32 * ks);
                    accr[q] = __builtin_amdgcn_mfma_f32_16x16x32_bf16(af, br_, accr[q], 0, 0, 0);
                    acci[q] = __builtin_amdgcn_mfma_f32_16x16x32_bf16(af, bi_, acci[q], 0, 0, 0);
                }
            }
#pragma unroll
            for (int q = 0; q < 2; ++q) {
                const int cl = 16 * (cgp * 2 + q) + (lane & 15), ch = n * 64 + cl;
                float hseg = 0.f, aseg = 1.f;
#pragma unroll
                for (int r = 0; r < 4; ++r) {
                    const int t = 16 * mt + 4 * (lane >> 4) + r;
                    const float rg = sigmoidf_(accr[q][r] + bav[q]), ig = sigmoidf_(acci[q][r] + bxv[q]);
                    const float la = -8.0f * rg * sp[q];
                    const float y2 = 2.f * la;
                    const float om = (y2 > -0.01f) ? -y2 * (1.f + y2 * (0.5f + y2 * 0.16666667f)) : 1.f - __expf(y2);
                    const bf16_t vb16 = f2bf(sqrtf(om) * ig * bf2f(ub[t * 72 + cl]));
                    LA[(m0 + t) * 512 + ch] = la; VV[(m0 + t) * 512 + ch] = vb16;
                    const float a = __expf(la);
                    hseg = a * hseg + bf2f(vb16); aseg *= a;
                }
                const int sg = 4 * mt + (lane >> 4);
                seg[(sg * 64 + cl) * 2] = aseg; seg[(sg * 64 + cl) * 2 + 1] = hseg;
            }
        }
        __syncthreads();
        if (tid < 128) {
            const int u = tid >> 6, cl = tid & 63, c = c0 + u * nper;
            if (c < 256) {
                const float* seg = SEG + u * (16 * 64 * 2);
                float h = 0.f, A = 1.f;
#pragma unroll
                for (int s = 0; s < 16; ++s) { const float a = seg[(s * 64 + cl) * 2]; h = a * h + seg[(s * 64 + cl) * 2 + 1]; A *= a; }
                PA[c * 512 + n * 64 + cl] = A; PH[c * 512 + n * 64 + cl] = h;
            }
        }
    }
    __syncthreads();
}

DEVI void phase_shortconv(bf16_t* Y, const float* w  , int vb, int vg) {
    const int tid = TIDX; const int bid = vb; const int gt = bid * 512 + tid, ngt = vg * 512;
    for (int it = gt; it < (MTOK / 8) * 64; it += ngt) {
        const int cg8 = (it & 63) * 8, m0 = (it >> 6) * 8, tl0 = m0 & (SEQ - 1);
        float wk[3][8];
#pragma unroll
        for (int k = 0; k < 3; ++k) load8f(w + k * 512 + cg8, wk[k]);
        uint4 rc[10], rh[10], rb[8];
#pragma unroll
        for (int i = 0; i < 10; ++i) {
            const int d = i - 2;
            if (tl0 + d >= 0) { const bf16_t* r = Y + (size_t)(m0 + d) * LDY; rc[i] = *(const uint4*)(r + OFF_SC + cg8); rh[i] = *(const uint4*)(r + OFF_SH + cg8); }
            else { rc[i] = make_uint4(0, 0, 0, 0); rh[i] = make_uint4(0, 0, 0, 0); }
        }
#pragma unroll
        for (int i = 0; i < 8; ++i) rb[i] = *(const uint4*)(Y + (size_t)(m0 + i) * LDY + OFF_SB + cg8);
        float p[10][8];
#pragma unroll
        for (int i = 0; i < 10; ++i) { float a[8], b2[8]; unpack8(rc[i], a); unpack8(rh[i], b2);
#pragma unroll
            for (int e = 0; e < 8; ++e) p[i][e] = a[e] * b2[e]; }
#pragma unroll
        for (int i = 0; i < 8; ++i) {
            float sb[8]; unpack8(rb[i], sb);
            float o[8];
#pragma unroll
            for (int e = 0; e < 8; ++e) o[e] = sb[e] * (wk[0][e] * p[i][e] + wk[1][e] * p[i + 1][e] + wk[2][e] * p[i + 2][e]);
            uint4 ow; ow.x = pk2(o[0], o[1]); ow.y = pk2(o[2], o[3]); ow.z = pk2(o[4], o[5]); ow.w = pk2(o[6], o[7]);
            *(uint4*)(Y + (size_t)(m0 + i) * LDY + OFF_SB + cg8) = ow;
        }
    }
}

DEVI void phase_cmp1(const bf16_t* Y, const float* pe  , const float* w1  , const float* b1  , float* HID, bf16_t* As, bf16_t* Bs) {
    const int tid = TIDX; const int bid = BIDX;
    for (int t = bid; t < 32; t += gridDim.x) {
        const int z = t >> 4, rt = t & 15;
        const int r = rt * 128 + (tid >> 2);
        const bool rv = r < NB * NCMP * 2;
        const int g = r & 1, bn_ = r >> 1, b = bn_ / NCMP, n = bn_ % NCMP;
        const bf16_t* abase = Y + (size_t)(b * SEQ + 16 * n) * LDY + (z ? OFF_VC : OFF_KC) + g * 64;
        const float* pez = pe + z * 2048;
        const float* wz = w1 + (size_t)z * 2048 * 128 + (tid & 15) * 8;
        f32x4 acc[2][4]; acc_zero(acc);
        gemm_tile(tid, acc, 2048, As, Bs,
                  [&](int k, float (&v)[8]) {
                      if (rv) { const int lp = k >> 6, d = k & 63; load8b(abase + (size_t)lp * LDY + d, v);
#pragma unroll
                          for (int j = 0; j < 8; ++j) v[j] += pez[k + j]; }
                      else zero8(v); },
                  [&](int k, float (&v)[8]) { load8f(wz + (size_t)k * 128, v); });
#pragma unroll
        for (int i = 0; i < 2; ++i) {
            const int rr = rt * 128 + ACC_ROW(i);
#pragma unroll
            for (int j = 0; j < 4; ++j) {
                const int c = ACC_COL(j);
                f32x4 o;
#pragma unroll
                for (int e = 0; e < 4; ++e) o[e] = gelu_tanh(acc[i][j][e] + b1[z * 128 + c + e]);
                *(f32x4*)(HID + ((size_t)z * 2048 + rr) * 128 + c) = o;
            }
        }
    }
}

DEVI void phase_cmp2_carry(const float* HID, const float* w2  , const float* b2  , const float* kn0  , float* KCMP, float* VCMP,
                           bf16_t* KCB, bf16_t* VCB) {
    const int tid = TIDX; const int bid = BIDX; const int lane = tid & 63, gw = bid * 8 + (tid >> 6), ngw = gridDim.x * 8;
    for (int it = gw; it < 2 * NB * NCMP * 2; it += ngw) {
        const int z = it / (NB * NCMP * 2), r = it % (NB * NCMP * 2);
        const float* h = HID + ((size_t)z * 2048 + r) * 128;
        const float* w = w2 + z * 8192 + lane;
        float acc = b2[z * 64 + lane];
        for (int j = 0; j < 128; ++j) acc += h[j] * w[j * 64];
        const int g = r & 1, bn_ = r >> 1, b = bn_ / NCMP, n = bn_ % NCMP;
        float* dst = (z ? VCMP : KCMP) + ((size_t)(b * 256 + n) * 2 + g) * 64 + lane;
        if (z == 0) { const float s = wave_sum(acc * acc); acc = acc * rsqrtf(s * (1.f / 64.f) + RMS_EPS) * kn0[lane]; }
        *dst = acc;
        (z ? VCB : KCB)[((size_t)((b * 2 + g) * 256) + n) * 64 + lane] = f2bf(acc);
    }
    if (gw < 16) { const int z = gw >> 3, bg = gw & 7; (z ? VCB : KCB)[((size_t)(bg * 256) + 255) * 64 + lane] = 0; }
}

DEVI void phase_rglru2(bf16_t* __restrict__ Y, const float* __restrict__ LA, const bf16_t* __restrict__ VV, const float* __restrict__ PA, const float* __restrict__ PH) {
    const int tid = TIDX; const int bid = BIDX; const int gt = bid * 512 + tid, ngt = gridDim.x * 512;
    for (int e = gt; e < 256 * 512; e += ngt) {
        const int c = e >> 9, ch = e & 511, cl = c & 63;
        const float* pa = PA + (size_t)(c - cl) * 512 + ch; const float* ph = PH + (size_t)(c - cl) * 512 + ch;
        float h = 0.f;
#pragma unroll 1
        for (int c0 = 0; c0 < cl; c0 += 16) {
            float a16[16], p16[16];
#pragma unroll
            for (int i = 0; i < 16; ++i) { const int ci = (c0 + i < cl) ? c0 + i : c0; a16[i] = pa[ci * 512]; p16[i] = ph[ci * 512]; }
#pragma unroll
            for (int i = 0; i < 16; ++i) h = (c0 + i < cl) ? a16[i] * h + p16[i] : h;
        }
        const size_t m0 = (size_t)c * 64;
#pragma unroll 1
        for (int t0 = 0; t0 < 64; t0 += 8) {
            float la[8], vv[8], ry[8];
#pragma unroll
            for (int i = 0; i < 8; ++i) { const size_t m = m0 + t0 + i; la[i] = LA[m * 512 + ch]; vv[i] = bf2f(VV[m * 512 + ch]); ry[i] = bf2f(Y[m * LDY + OFF_RY + ch]); }
#pragma unroll
            for (int i = 0; i < 8; ++i) { h = __expf(la[i]) * h + vv[i]; ry[i] *= h; }
#pragma unroll
            for (int i = 0; i < 8; ++i) Y[(m0 + t0 + i) * LDY + OFF_RY + ch] = f2bf(ry[i]);
        }
    }
}

DEVI void attend_block(const bf16_t* Y, int b, int g, int j, int t, int lo, int offk, int offv, const float* qs, float* ps, float (&mx)[4], float (&l)[4], float (&o)[4], int lane) {
    const int pos = 64 * j + lane;
    const bool valid = (pos <= t) && (pos >= lo);
    const bf16_t* kr = Y + (size_t)(b * SEQ + pos) * LDY + offk + g * 64;
    float s[4] = {0.f, 0.f, 0.f, 0.f};
#pragma unroll 2
    for (int d8 = 0; d8 < 8; ++d8) {
        float kv[8]; load8b(kr + d8 * 8, kv);
#pragma unroll
        for (int h = 0; h < 4; ++h) {
            const f32x4 qa = *(const f32x4*)(qs + h * 64 + d8 * 8), qb = *(const f32x4*)(qs + h * 64 + d8 * 8 + 4);
            s[h] += qa[0] * kv[0] + qa[1] * kv[1] + qa[2] * kv[2] + qa[3] * kv[3] + qb[0] * kv[4] + qb[1] * kv[5] + qb[2] * kv[6] + qb[3] * kv[7];
        }
    }
    LDS_FENCE();
#pragma unroll
    for (int h = 0; h < 4; ++h) {
        const float sv = valid ? s[h] : -1e30f;
        const float mn = fmaxf(mx[h], wave_max(sv));
        const float corr = __expf(mx[h] - mn);
        const float p = valid ? __expf(sv - mn) : 0.f;
        l[h] = l[h] * corr + wave_sum(p);
        o[h] *= corr; mx[h] = mn;
        ps[h * 64 + lane] = p;
    }
    LDS_FENCE();
    const bf16_t* vr = Y + (size_t)(b * SEQ + 64 * j) * LDY + offv + g * 64 + lane;
    for (int k = 0; k < 64; ++k) {
        const float v = bf2f(vr[(size_t)k * LDY]);
#pragma unroll
        for (int h = 0; h < 4; ++h) o[h] += ps[h * 64 + k] * v;
    }
    LDS_FENCE();
}

DEVI void phase_nsa(bf16_t* Y, const float* KCMP, const float* VCMP, float* lds) {
    const int tid = TIDX; const int bid = BIDX; const int lane = tid & 63, wv = tid >> 6, gw = bid * 8 + wv, ngw = gridDim.x * 8;
    float* qs = lds + wv * 1536;
    float* ps = qs + 256;
    float* pss = ps + 1024;
    for (int it = gw; it < MTOK * 2; it += ngw) {
        const int g = it & 1, m = it >> 1, b = m >> 12, t = m & (SEQ - 1);
        bf16_t* qrow = Y + (size_t)m * LDY + OFF_Q + g * 256;
        LDS_FENCE();
#pragma unroll
        for (int h = 0; h < 4; ++h) qs[h * 64 + lane] = bf2f(qrow[h * 64 + lane]) * 0.125f;
        LDS_FENCE();
        const int nvalid = (t >= 31) ? ((t - 31) / 16 + 1) : 0;
        float sc[4][4];
#pragma unroll
        for (int i = 0; i < 4; ++i) {
            const int n = lane + 64 * i;
#pragma unroll
            for (int h = 0; h < 4; ++h) sc[i][h] = -1e30f;
            if (n < nvalid) {
                const float* kp = KCMP + ((size_t)(b * 256 + n) * 2 + g) * 64;
                float s[4] = {0.f, 0.f, 0.f, 0.f};
#pragma unroll 4
                for (int d4 = 0; d4 < 16; ++d4) {
                    const f32x4 kv = *(const f32x4*)(kp + d4 * 4);
#pragma unroll
                    for (int h = 0; h < 4; ++h) { const f32x4 qa = *(const f32x4*)(qs + h * 64 + d4 * 4); s[h] += qa[0] * kv[0] + qa[1] * kv[1] + qa[2] * kv[2] + qa[3] * kv[3]; }
                }
#pragma unroll
                for (int h = 0; h < 4; ++h) sc[i][h] = s[h];
            }
        }
        float psum[4] = {0.f, 0.f, 0.f, 0.f};
#pragma unroll
        for (int h = 0; h < 4; ++h) {
            const float mxv = wave_max(fmaxf(fmaxf(sc[0][h], sc[1][h]), fmaxf(sc[2][h], sc[3][h])));
            float p[4], su = 0.f;
#pragma unroll
            for (int i = 0; i < 4; ++i) { p[i] = (lane + 64 * i < nvalid) ? __expf(sc[i][h] - mxv) : 0.f; su += p[i]; }
            su = wave_sum(su);
            const float inv = nvalid > 0 ? 1.f / su : 0.f;
#pragma unroll
            for (int i = 0; i < 4; ++i) { p[i] *= inv; ps[h * 256 + lane + 64 * i] = p[i]; psum[i] += p[i]; }
        }
#pragma unroll
        for (int i = 0; i < 4; ++i) pss[lane + 64 * i] = psum[i];
        LDS_FENCE();
        float oc[4] = {0.f, 0.f, 0.f, 0.f};
        for (int n = 0; n < nvalid; ++n) {
            const float v = VCMP[((size_t)(b * 256 + n) * 2 + g) * 64 + lane];
#pragma unroll
            for (int h = 0; h < 4; ++h) oc[h] += ps[h * 256 + n] * v;
        }
        const int j = lane, cur = t >> 6;
        float imp = pss[4 * j] + pss[4 * j + 1] + pss[4 * j + 2] + 0.5f * pss[4 * j + 3];
        if (j >= 1) imp += 0.5f * pss[4 * j - 1];
        LDS_FENCE();
        const bool forced = (j == 0) || (j == cur) || (j + 1 == cur);
        const bool cand = (j >= 1) && (j + 2 <= cur);
        const int nforced = cur == 0 ? 1 : (cur == 1 ? 2 : 3), quota = 16 - nforced;
        bool sel;
        if (cur - 2 <= quota) sel = forced || cand;
        else {
            int rank = 0;
            for (int jj = 1; jj <= cur - 2; ++jj) { const float v = __shfl(imp, jj); rank += ((v > imp) || (v == imp && jj < j)) ? 1 : 0; }
            sel = forced || (cand && rank < quota);
        }
        unsigned long long mask = __ballot(sel);
        float ms[4], ls[4], os[4];
#pragma unroll
        for (int h = 0; h < 4; ++h) { ms[h] = -1e30f; ls[h] = 0.f; os[h] = 0.f; }
        while (mask) {
            const int jb = __builtin_ctzll(mask); mask &= mask - 1;
            attend_block(Y, b, g, jb, t, 0, OFF_KS, OFF_VS, qs, ps, ms, ls, os, lane);
        }
        float mw[4], lw[4], ow[4];
#pragma unroll
        for (int h = 0; h < 4; ++h) { mw[h] = -1e30f; lw[h] = 0.f; ow[h] = 0.f; }
        const int lo = t - 511 > 0 ? t - 511 : 0;
        for (int jb = lo >> 6; jb <= cur; ++jb) attend_block(Y, b, g, jb, t, lo, OFF_KW, OFF_VW, qs, ps, mw, lw, ow, lane);
        const bf16_t* gp = Y + (size_t)m * LDY + OFF_NGY + g * 12;
#pragma unroll
        for (int h = 0; h < 4; ++h) {
            const float gc = bf2f(gp[h * 3]), gs = bf2f(gp[h * 3 + 1]), gwn = bf2f(gp[h * 3 + 2]);
            const float o = gc * oc[h] + gs * os[h] / ls[h] + gwn * ow[h] / lw[h];
            qrow[h * 64 + lane] = f2bf(o);
        }
    }
}

DEVI float ld_sc1(const float* p) { return __hip_atomic_load(p, __ATOMIC_RELAXED, __HIP_MEMORY_SCOPE_AGENT); }
DEVI void router_finalize(int m, int t, const float* LOG, const float* bg, const float* be, int* cnt  , int* LIST, float* RW, volatile int* hist  ) {
    const float* lg = LOG + (size_t)m * 64;
    float gl[4];
#pragma unroll
    for (int o = 0; o < 4; ++o) gl[o] = ld_sc1(lg + o) + bg[o];
    int grp = 0; float gmax = gl[0];
#pragma unroll
    for (int o = 1; o < 4; ++o) if (gl[o] > gmax) { gmax = gl[o]; grp = o; }
    float gs = 0.f;
#pragma unroll
    for (int o = 0; o < 4; ++o) gs += __expf(gl[o] - gmax);
    const float pgrp = 1.f / gs;
    float el[8];
#pragma unroll
    for (int i = 0; i < 8; ++i) el[i] = ld_sc1(lg + 4 + grp * 8 + i) + be[grp * 8 + i];
    int i0 = 0; float m0 = el[0];
#pragma unroll
    for (int i = 1; i < 8; ++i) if (el[i] > m0) { m0 = el[i]; i0 = i; }
    int i1 = -1; float m1 = -3.0e38f;
#pragma unroll
    for (int i = 0; i < 8; ++i) if (i != i0 && el[i] > m1) { m1 = el[i]; i1 = i; }
    const float e1 = __expf(m1 - m0);
    const float w0 = pgrp / (1.f + e1), w1 = pgrp * e1 / (1.f + e1);
    const int ea = grp * 8 + i0, eb = grp * 8 + i1;
    if (t < 32) hist[t] = 0;
    __syncthreads();
    const bool act = t < 256;
    int ra = 0, rb = 0;
    if (act) { ra = atomicAdd((int*)hist + ea, 1); rb = atomicAdd((int*)hist + eb, 1); }
    __syncthreads();
    if (t < 32) hist[32 + t] = atomicAdd(cnt + t, hist[t]);
    __syncthreads();
    if (act) {
        LIST[ea * MTOK + hist[32 + ea] + ra] = m * 2;
        LIST[eb * MTOK + hist[32 + eb] + rb] = m * 2 + 1;
        RW[m * 2] = w0; RW[m * 2 + 1] = w1;
    }
}


struct NsaCtx {
    LAS3 unsigned char* lds;
    int tid, lane, r32, hi, w;
    unsigned okY, ovY, okC, ovC;
};
DEVI void nsa_dma(const NsaCtx& c, int slot, const bf16_t* kbase, const bf16_t* vbase, unsigned ok, unsigned ov) {
    __builtin_amdgcn_global_load_lds((const unsigned*)((const char*)kbase + ok), (LAS3 unsigned*)(c.lds + slot * 16384 + c.w * 1024), 16, 0, 0);
    __builtin_amdgcn_global_load_lds((const unsigned*)((const char*)vbase + ov), (LAS3 unsigned*)(c.lds + slot * 16384 + 8192 + c.w * 1024), 16, 0, 0);
}
#define NSA_WAIT_BAR(N) do { asm volatile("s_waitcnt vmcnt(" #N ")" ::: "memory"); __builtin_amdgcn_s_barrier(); asm volatile("" ::: "memory"); } while (0)
template <class NextFn, class SrcFn, class BodyFn>
DEVI void nsa_run(const NsaCtx& c, int& slot, int first, unsigned ok, unsigned ov, NextFn next, SrcFn srcf, BodyFn body) {
    int t0 = first, t1 = next(t0);
    { const bf16_t* kb; const bf16_t* vb; srcf(t0, kb, vb); nsa_dma(c, slot, kb, vb, ok, ov); }
    if (t1 >= 0) { const bf16_t* kb; const bf16_t* vb; srcf(t1, kb, vb); nsa_dma(c, slot == 2 ? 0 : slot + 1, kb, vb, ok, ov); }
#pragma unroll 1
    while (t0 >= 0) {
        if (t1 >= 0) NSA_WAIT_BAR(2); else NSA_WAIT_BAR(0);
        const int t2 = (t1 >= 0) ? next(t1) : -1;
        if (t2 >= 0) { const bf16_t* kb; const bf16_t* vb; srcf(t2, kb, vb); nsa_dma(c, slot == 0 ? 2 : slot - 1, kb, vb, ok, ov); }
        body(t0, slot);
        t0 = t1; t1 = t2; slot = slot == 2 ? 0 : slot + 1;
    }
}
DEVI void nsa_scores(const NsaCtx& c, int buf, const f32x16& z, f32x16& p0, f32x16& p1) {
    const LAS3 bf16x8* qfl = (const LAS3 bf16x8*)(c.lds + NSA_QF) + c.tid;
    const LAS3 unsigned char* kb = c.lds + buf * 16384 + c.r32 * 128;
    const int sw = (c.r32 >> 1) & 7;
#pragma unroll
    for (int s = 0; s < 4; ++s) {
        const bf16x8 k0 = *(const LAS3 bf16x8*)(kb + (((2 * s + c.hi) ^ sw) * 16));
        const bf16x8 k1 = *(const LAS3 bf16x8*)(kb + 4096 + (((2 * s + c.hi) ^ sw) * 16));
        if (s == 0) {
            const bf16x8 q = qfl[0]; p0 = __builtin_amdgcn_mfma_f32_32x32x16_bf16(k0, q, z, 0, 0, 0); p1 = __builtin_amdgcn_mfma_f32_32x32x16_bf16(k1, q, z, 0, 0, 0); }
        else { const bf16x8 q = qfl[s * 512]; p0 = __builtin_amdgcn_mfma_f32_32x32x16_bf16(k0, q, p0, 0, 0, 0); p1 = __builtin_amdgcn_mfma_f32_32x32x16_bf16(k1, q, p1, 0, 0, 0); }
    }
}
DEVI unsigned nsa_pk(float lo, float hi) { return pg8::cvt_pk_bf16(lo, hi); }
DEVI void nsa_pack(const f32x16& p0, const f32x16& p1, bf16x8 (&pa)[4]) {
#pragma unroll
    for (int s = 0; s < 4; ++s) {
        const f32x16& p = (s < 2) ? p0 : p1; const int b = (s & 1) * 8;
        uint4 w; w.x = nsa_pk(p[b], p[b + 1]); w.y = nsa_pk(p[b + 2], p[b + 3]); w.z = nsa_pk(p[b + 4], p[b + 5]); w.w = nsa_pk(p[b + 6], p[b + 7]);
        pa[s] = __builtin_bit_cast(bf16x8, w);
    }
}
DEVI void nsa_pv(const NsaCtx& c, int buf, const bf16x8 (&pa)[4], f32x16 (&o)[2]) {
    const unsigned vb = (unsigned)(uintptr_t)(c.lds + buf * 16384 + 8192 + (4 * c.hi + ((c.lane & 15) >> 2)) * 64 + ((c.lane >> 4) & 1) * 32 + (c.lane & 3) * 8);
#pragma unroll
    for (int d0 = 0; d0 < 2; ++d0) {
        s16x4 lo[4], hi[4];
#pragma unroll
        for (int s = 0; s < 4; ++s) {
            asm volatile("ds_read_b64_tr_b16 %0, %1 offset:%c2" : "=&v"(lo[s]) : "v"(vb), "i"(d0 * 4096 + s * 1024) : "memory");
            asm volatile("ds_read_b64_tr_b16 %0, %1 offset:%c2" : "=&v"(hi[s]) : "v"(vb), "i"(d0 * 4096 + s * 1024 + 512) : "memory");
        }
        asm volatile("s_waitcnt lgkmcnt(0)" ::: "memory");
        __builtin_amdgcn_sched_barrier(0);
#pragma unroll
        for (int s = 0; s < 4; ++s)
            o[d0] = __builtin_amdgcn_mfma_f32_32x32x16_bf16((bf16x8){lo[s][0], lo[s][1], lo[s][2], lo[s][3], hi[s][0], hi[s][1], hi[s][2], hi[s][3]}, pa[s], o[d0], 0, 0, 0);
    }
}
typedef float f32x2v __attribute__((ext_vector_type(2)));
DEVI void nsa_exp_all(f32x16& p0, f32x16& p1) {
#pragma unroll
    for (int r = 0; r < 16; ++r) { p0[r] = __builtin_amdgcn_exp2f(p0[r]); p1[r] = __builtin_amdgcn_exp2f(p1[r]); }
}
DEVI float nsa_rowsum(const f32x16& p0, const f32x16& p1) {
    f32x2v a = {p0[0], p0[1]}, b = {p1[0], p1[1]};
#pragma unroll
    for (int r = 2; r < 16; r += 2) { a += (f32x2v){p0[r], p0[r + 1]}; b += (f32x2v){p1[r], p1[r + 1]}; }
    a += b; return a[0] + a[1];
}
DEVI void nsa_fill(f32x16& z, float v) {
#pragma unroll
    for (int r = 0; r < 16; ++r) z[r] = v;
    asm volatile("" : "+v"(z));
}
DEVI float nsa_msel(bool dead, float e) { return __uint_as_float(__float_as_uint(e) & (dead ? 0u : 0xffffffffu)); }
DEVI void nsa_unit(bf16_t* Y, const bf16_t* KCB, const bf16_t* VCB, int b, int g, int qt, const NsaCtx& c, const float (&bnd)[3], int& slot) {
    const int w = c.w, tq = 8 * w + (c.r32 >> 2), head = c.r32 & 3, t = 64 * qt + tq;
    const unsigned qoff = (unsigned)((b * SEQ + t) * LDY + OFF_Q + (g * 4 + head) * 64);
    {   LAS3 bf16x8* qfl = (LAS3 bf16x8*)(c.lds + NSA_QF) + c.tid;
#pragma unroll
        for (int s = 0; s < 4; ++s) qfl[s * 512] = *(const bf16x8*)(Y + (qoff + (unsigned)(16 * s + 8 * c.hi)));
    }
    const unsigned goff = (unsigned)((b * SEQ + t) * LDY + OFF_NGY + (g * 4 + head) * 3);
    const float gate_c = bf2f(Y[goff]), gate_s = bf2f(Y[goff + 1]), gate_w = bf2f(Y[goff + 2]);
    LAS3 float* outl = (LAS3 float*)(c.lds + NSA_OUT) + c.tid;
    f32x16 p0, p1, o[2]; bf16x8 pa[4];

    const int nmax = (t - 31) >> 4;
    const int ntc = (((64 * qt + 32) >> 4) >> 6) + 1;
    const bf16_t* kc = KCB + (size_t)((b * 2 + g) * 256) * 64; const bf16_t* vc = VCB + (size_t)((b * 2 + g) * 256) * 64;
    auto cmp_next = [&](int ct) { return ct + 1 < ntc ? ct + 1 : -1; };
    auto cmp_src = [&](int ct, const bf16_t*& kb, const bf16_t*& vb) { kb = kc + (size_t)ct * 4096; vb = vc + (size_t)ct * 4096; };
    float lc = 0.f;
#pragma unroll
    for (int d0 = 0; d0 < 2; ++d0)
#pragma unroll
        for (int r = 0; r < 16; ++r) o[d0][r] = 0.f;
    f32x16 zb; nsa_fill(zb, -bnd[0]);
    nsa_run(c, slot, 0, c.okC, c.ovC, cmp_next, cmp_src, [&](int ct, int buf) {
        nsa_scores(c, buf, zb, p0, p1);
        nsa_exp_all(p0, p1);
        if (!__all(64 * ct + 63 <= nmax)) {
#pragma unroll
            for (int r = 0; r < 16; ++r) { const int n0 = 64 * ct + crow16(r, c.hi); p0[r] = nsa_msel(n0 > nmax, p0[r]); p1[r] = nsa_msel(n0 + 32 > nmax, p1[r]); }
        }
        lc += nsa_rowsum(p0, p1);
        nsa_pack(p0, p1, pa);
        nsa_pv(c, buf, pa, o);
    });
    lc = half_sum(lc);
    const float invc = lc > 0.f ? 1.f / lc : 0.f;
    {   const float sc_ = gate_c * invc;
#pragma unroll
        for (int d0 = 0; d0 < 2; ++d0)
#pragma unroll
            for (int r = 0; r < 16; ++r) outl[(d0 * 16 + r) * 512] = o[d0][r] * sc_;
    }
    unsigned msk0, msk1;
    if (qt < 16) { msk0 = (2u << qt) - 1u; msk1 = 0u; }
    else {
#pragma unroll
        for (int d0 = 0; d0 < 2; ++d0)
#pragma unroll
            for (int r = 0; r < 16; ++r) o[d0][r] = 0.f;
        nsa_run(c, slot, 0, c.okC, c.ovC, cmp_next, cmp_src, [&](int ct, int buf) {
            nsa_scores(c, buf, zb, p0, p1);
            nsa_exp_all(p0, p1);
            if (!__all(64 * ct + 63 <= nmax)) {
#pragma unroll
                for (int r = 0; r < 16; ++r) { const int n0 = 64 * ct + crow16(r, c.hi); p0[r] = nsa_msel(n0 > nmax, p0[r]); p1[r] = nsa_msel(n0 + 32 > nmax, p1[r]); }
            }
            nsa_pack(p0, p1, pa);
#pragma unroll
            for (int s = 0; s < 4; ++s)
#pragma unroll
                for (int jb = 0; jb < 2; ++jb) {
                    if (!(jb == (ct >> 1) || (s == 3 && (ct & 1) && jb == (ct >> 1) + 1))) continue;
                    const int j = 32 * jb + c.r32, jn0 = 16 * ct + 4 * s + c.hi, jn1 = jn0 + 2;
                    uint4 wv;
                    wv.x = (jn0 == j) ? 0x3F803F80u : 0u; wv.y = (jn0 == j) ? 0x3F003F80u : ((jn0 + 1 == j) ? 0x3F000000u : 0u);
                    wv.z = (jn1 == j) ? 0x3F803F80u : 0u; wv.w = (jn1 == j) ? 0x3F003F80u : ((jn1 + 1 == j) ? 0x3F000000u : 0u);
                    o[jb] = __builtin_amdgcn_mfma_f32_32x32x16_bf16(__builtin_bit_cast(bf16x8, wv), pa[s], o[jb], 0, 0, 0);
                }
        });
        unsigned key[2][16];
#pragma unroll
        for (int jb = 0; jb < 2; ++jb)
#pragma unroll
            for (int r = 0; r < 16; ++r) {
                float v = o[jb][r] * invc;
                v += shx(v, 1); v += shx(v, 2);
                const int j = 32 * jb + crow16(r, c.hi);
                const bool cand = (j >= 1) && (j + 2 <= qt);
                key[jb][r] = cand ? ((__float_as_uint(fmaxf(v, 0.f)) & ~63u) | (unsigned)(63 - j)) : 0u;
            }
        unsigned thr = 0u;
#pragma unroll 1
        for (int bit = 30; bit >= 0; --bit) {
            const unsigned tt = thr | (1u << bit);
            int cnt = 0;
#pragma unroll
            for (int jb = 0; jb < 2; ++jb)
#pragma unroll
                for (int r = 0; r < 16; ++r) cnt += (key[jb][r] >= tt) ? 1 : 0;
            cnt = half_addi(cnt);
            thr = (cnt >= 13) ? tt : thr;
        }
        unsigned w0 = 0u, w1 = 0u;
#pragma unroll
        for (int r = 0; r < 16; ++r) {
            const int bitpos = (r & 3) + 8 * (r >> 2);
            w0 |= ((key[0][r] != 0u && key[0][r] >= thr) ? 1u : 0u) << bitpos;
            w1 |= ((key[1][r] != 0u && key[1][r] >= thr) ? 1u : 0u) << bitpos;
        }
        w0 <<= 4 * c.hi; w1 <<= 4 * c.hi;
        msk0 = half_or(w0); msk1 = half_or(w1);
        msk0 |= 1u;
        if (qt < 32) msk0 |= (3u << (qt - 1)); else if (qt == 32) { msk0 |= 0x80000000u; msk1 |= 1u; } else msk1 |= (3u << (qt - 33));
    }
    unsigned u0 = msk0, u1 = msk1;
    u0 |= shxu(u0, 4); u1 |= shxu(u1, 4); u0 |= shxu(u0, 8); u1 |= shxu(u1, 8); u0 |= shxu(u0, 16); u1 |= shxu(u1, 16);
    LAS3 unsigned* misc = (LAS3 unsigned*)(c.lds + NSA_MISC);
    if (c.lane == 0) { misc[2 * w] = u0; misc[2 * w + 1] = u1; }
    asm volatile("s_waitcnt lgkmcnt(0)" ::: "memory"); __builtin_amdgcn_s_barrier(); asm volatile("" ::: "memory");
    u0 = 0u; u1 = 0u;
#pragma unroll
    for (int i = 0; i < 8; ++i) { u0 |= misc[2 * i]; u1 |= misc[2 * i + 1]; }
    const unsigned long long um = ((unsigned long long)(unsigned)__builtin_amdgcn_readfirstlane(u1) << 32) | (unsigned)__builtin_amdgcn_readfirstlane(u0);
    const unsigned long long mym = ((unsigned long long)msk1 << 32) | msk0;

    {
        const bf16_t* kb0 = Y + (size_t)b * SEQ * LDY + OFF_KS + g * 64; const bf16_t* vb0 = Y + (size_t)b * SEQ * LDY + OFF_VS + g * 64;
        float ls = 0.f;
#pragma unroll
        for (int d0 = 0; d0 < 2; ++d0)
#pragma unroll
            for (int r = 0; r < 16; ++r) o[d0][r] = 0.f;
        nsa_fill(zb, -bnd[1]);
        nsa_run(c, slot, 0, c.okY, c.ovY,
                [&](int j) { const unsigned long long rest = (j >= 63) ? 0ull : (um >> (j + 1)); return rest ? j + 1 + (int)__builtin_ctzll(rest) : -1; },
                [&](int j, const bf16_t*& kb, const bf16_t*& vb) { kb = kb0 + (size_t)j * 64 * LDY; vb = vb0 + (size_t)j * 64 * LDY; },
                [&](int j, int buf) {
            nsa_scores(c, buf, zb, p0, p1);
            nsa_exp_all(p0, p1);
            const bool keep = (mym >> j) & 1ull;
            if (j == qt) {
#pragma unroll
                for (int r = 0; r < 16; ++r) { const int kv = crow16(r, c.hi); p0[r] = nsa_msel(kv > tq, p0[r]); p1[r] = nsa_msel(kv + 32 > tq, p1[r]); }
            }
            ls += keep ? nsa_rowsum(p0, p1) : 0.f;
            nsa_pack(p0, p1, pa);
            {   const unsigned km = keep ? 0xffffffffu : 0u;
#pragma unroll
                for (int s = 0; s < 4; ++s) { uint4 w = __builtin_bit_cast(uint4, pa[s]); w.x &= km; w.y &= km; w.z &= km; w.w &= km; pa[s] = __builtin_bit_cast(bf16x8, w); }
            }
            nsa_pv(c, buf, pa, o);
        });
        ls = half_sum(ls);
        const float sc_ = ls > 0.f ? gate_s / ls : 0.f;
#pragma unroll
        for (int d0 = 0; d0 < 2; ++d0)
#pragma unroll
            for (int r = 0; r < 16; ++r) outl[(d0 * 16 + r) * 512] += o[d0][r] * sc_;
    }
    {
        const bf16_t* kb0 = Y + (size_t)b * SEQ * LDY + OFF_KW + g * 64; const bf16_t* vb0 = Y + (size_t)b * SEQ * LDY + OFF_VW + g * 64;
        float lw = 0.f;
#pragma unroll
        for (int d0 = 0; d0 < 2; ++d0)
#pragma unroll
            for (int r = 0; r < 16; ++r) o[d0][r] = 0.f;
        const int jlo = qt - 8 > 0 ? qt - 8 : 0;
        nsa_fill(zb, -bnd[2]);
        nsa_run(c, slot, qt, c.okY, c.ovY,
                [&](int j) { return j > jlo ? j - 1 : -1; },
                [&](int j, const bf16_t*& kb, const bf16_t*& vb) { kb = kb0 + (size_t)j * 64 * LDY; vb = vb0 + (size_t)j * 64 * LDY; },
                [&](int j, int buf) {
            nsa_scores(c, buf, zb, p0, p1);
            nsa_exp_all(p0, p1);
            if (j == qt || j == qt - 8) {
                const int hi_lim = (j == qt) ? tq : 64, lo_lim = (j == qt - 8) ? tq + 1 : 0;
#pragma unroll
                for (int r = 0; r < 16; ++r) { const int kv = crow16(r, c.hi); p0[r] = nsa_msel((kv > hi_lim) || (kv < lo_lim), p0[r]); p1[r] = nsa_msel((kv + 32 > hi_lim) || (kv + 32 < lo_lim), p1[r]); }
            }
            lw += nsa_rowsum(p0, p1);
            nsa_pack(p0, p1, pa);
            nsa_pv(c, buf, pa, o);
        });
        lw = half_sum(lw);
        const float sc_ = lw > 0.f ? gate_w / lw : 0.f;
#pragma unroll
        for (int d0 = 0; d0 < 2; ++d0)
#pragma unroll
            for (int r = 0; r < 16; ++r) o[d0][r] = outl[(d0 * 16 + r) * 512] + o[d0][r] * sc_;
    }
#pragma unroll
    for (int d0 = 0; d0 < 2; ++d0)
#pragma unroll
        for (int gi = 0; gi < 4; ++gi) {
            uint2 wv; wv.x = pk2(o[d0][4 * gi], o[d0][4 * gi + 1]); wv.y = pk2(o[d0][4 * gi + 2], o[d0][4 * gi + 3]);
            *(uint2*)(Y + (qoff + (unsigned)((OFF_RX - OFF_Q) + 32 * d0 + 8 * gi + 4 * c.hi))) = wv;
        }
}

DEVI void phase_nsa_fast(bf16_t* Y, const bf16_t* KCB, const bf16_t* VCB, const float* qn  , const float* kn  , LAS3 unsigned char* lds) {
    float bnd[3];
    {   const int l0 = TIDX & 63;
        const float gq = wave_max(fabsf(qn[l0]));
#pragma unroll
        for (int i = 0; i < 3; ++i) bnd[i] = __uint_as_float(__builtin_amdgcn_readfirstlane(__float_as_uint(64.f * 1.02f * 0.125f * 1.4426950408889634f * gq * wave_max(fabsf(kn[i * 64 + l0])))));
    }
    NsaCtx c; c.lds = lds; c.tid = TIDX; c.lane = c.tid & 63; c.r32 = c.lane & 31; c.hi = c.lane >> 5; c.w = __builtin_amdgcn_readfirstlane(c.tid >> 6);
    {   const int l = c.lane, w = c.w;
        const int rk = 8 * w + (l >> 3), ck = (l & 7) ^ ((rk >> 1) & 7);
        const int rv = 16 * (w & 3) + (l >> 2), cv = (w >> 2) * 4 + (l & 3);
        c.okY = (unsigned)(rk * LDY + ck * 8) * 2u; c.ovY = (unsigned)(rv * LDY + cv * 8) * 2u;
        c.okC = (unsigned)(rk * 64 + ck * 8) * 2u;  c.ovC = (unsigned)(rv * 64 + cv * 8) * 2u;
    }
    const int bid = BIDX;
    int slot = 0;
    for (int u0 = bid; u0 < 256; u0 += gridDim.x) {
        const int u = (gridDim.x == 256) ? ((u0 & 7) * 32 + (u0 >> 3)) : u0;
        const int bg = u >> 5, k = u & 31;
#pragma unroll 1
        for (int h2 = 0; h2 < 2; ++h2) nsa_unit(Y, KCB, VCB, bg >> 1, bg & 1, h2 ? k : 63 - k, c, bnd, slot);
    }
    asm volatile("s_waitcnt vmcnt(0) lgkmcnt(0)" ::: "memory"); __builtin_amdgcn_s_barrier();
}

#define XB_TMO      128
#define XB_XCNT(j)  (256  + 64 * (j))
#define XB_XSUB(j)  (1280 + 64 * (j))
#define XB_XGEN(j)  (2304 + 64 * (j))
#define XB_TOP      3328
#define XB_TOPGEN   3392
#define XCD_BAR_WORDS 3456
#define XB_SPIN_CAP (1u << 18)
DEVI unsigned xb_ld(unsigned* p)              { return __hip_atomic_load(p, __ATOMIC_RELAXED, __HIP_MEMORY_SCOPE_AGENT); }
DEVI unsigned xb_add(unsigned* p, unsigned v) { return __hip_atomic_fetch_add(p, v, __ATOMIC_RELAXED, __HIP_MEMORY_SCOPE_AGENT); }
DEVI unsigned xb_xcc_id() { return (unsigned)__builtin_amdgcn_s_getreg((3 << 11) | 20) & 0xFu; }
#define XB_SPIN(cond, bar) do { unsigned _sp = 0; while (cond) { __builtin_amdgcn_s_sleep(1); \
    if ((++_sp & 255u) == 0u) { if (xb_ld(&(bar)[XB_TMO])) break; if (_sp > XB_SPIN_CAP) { atomicAdd(&(bar)[XB_TMO], 1u); break; } } } } while (0)
struct XcdBarrier { unsigned* bar; unsigned x; volatile LAS3 unsigned* st; };
DEVI XcdBarrier xcd_barrier_post(unsigned* bar, volatile LAS3 unsigned* st) {
    XcdBarrier b; b.bar = bar; b.x = xb_xcc_id(); b.st = st;
    if (threadIdx.x == 0) (void)xb_add(&bar[XB_XCNT(b.x)], 1u);
    return b;
}
DEVI void xcd_barrier_complete(unsigned* bar, unsigned x, unsigned& nloc, unsigned& nx) {
    const unsigned G = gridDim.x * gridDim.y * gridDim.z;
    unsigned sum, cnt, mine, sp = 0u;
    for (;;) {
        sum = 0u; cnt = 0u; mine = 0u;
#pragma unroll
        for (unsigned j = 0; j < 16; ++j) { const unsigned c = xb_ld(&bar[XB_XCNT(j)]); sum += c; cnt += (c > 0u) ? 1u : 0u; mine = (j == x) ? c : mine; }
        if (sum == G) break;
        __builtin_amdgcn_s_sleep(1);
        if ((++sp & 255u) == 0u) { if (xb_ld(&bar[XB_TMO])) break; if (sp > XB_SPIN_CAP) { atomicAdd(&bar[XB_TMO], 1u); break; } }
    }
    nloc = mine > 0u ? mine : 1u; nx = cnt > 0u ? cnt : 1u;
}
DEVI void xcd_barrier(const XcdBarrier& b) {
    asm volatile("s_waitcnt vmcnt(0)" ::: "memory");
    __syncthreads();
    if (threadIdx.x == 0) {
        unsigned* bar = b.bar;
        __builtin_amdgcn_s_waitcnt(0);
        unsigned nloc = b.st[0], nx = b.st[1];
        if (nloc == 0u) { xcd_barrier_complete(bar, b.x, nloc, nx); b.st[0] = nloc; b.st[1] = nx; }
        const unsigned old = xb_add(&bar[XB_XSUB(b.x)], 1u);
        const unsigned gen = old / nloc;
        if (old + 1u == (gen + 1u) * nloc) {
            __builtin_amdgcn_fence(__ATOMIC_RELEASE, "agent");
            asm volatile("s_waitcnt vmcnt(0)" ::: "memory");
            const unsigned og = xb_add(&bar[XB_TOP], 1u);
            const unsigned tg = og / nx;
            if (og + 1u == (tg + 1u) * nx) xb_add(&bar[XB_TOPGEN], 1u);
            else XB_SPIN(xb_ld(&bar[XB_TOPGEN]) == tg, bar);
            __builtin_amdgcn_fence(__ATOMIC_ACQUIRE, "agent");
            xb_add(&bar[XB_XGEN(b.x)], 1u);
            asm volatile("s_waitcnt vmcnt(0)" ::: "memory");
        } else {
            XB_SPIN(xb_ld(&bar[XB_XGEN(b.x)]) == gen, bar);
            __builtin_amdgcn_fence(__ATOMIC_ACQUIRE, "agent");
            asm volatile("s_waitcnt vmcnt(0)" ::: "memory");
        }
    }
    __syncthreads();
}

constexpr int LDS_BYTES = 160 * 1024;
constexpr int LDS_PTRS = 151552;
DEVI const void* lds_ptr(const LAS3 unsigned char* lds, int i) {
    const unsigned long long v = ((const LAS3 unsigned long long*)(lds + LDS_PTRS))[i];
    const unsigned lo = __builtin_amdgcn_readfirstlane((unsigned)v), hi = __builtin_amdgcn_readfirstlane((unsigned)(v >> 32));
    return (const void*)(((unsigned long long)hi << 32) | lo);
}
#ifndef PHMASK
#define PHMASK 0xffffffffu
#endif
__global__ void __launch_bounds__(512, 2) fwd_kernel(Params p) {
    extern __shared__ __attribute__((aligned(16))) unsigned char lds[];
    cg::grid_group grid = cg::this_grid();
    unsigned char* ws = p.ws;
    int* CNT = (int*)(ws + WS_CNT);
    float* RSTD = (float*)(ws + WS_RSTD); float* SS = (float*)(ws + WS_SS); float* LOG = (float*)(ws + WS_LOG); bf16_t* WRT = (bf16_t*)(ws + WS_WRT); bf16_t* W1T = (bf16_t*)(ws + WS_W1T); bf16_t* W2T = (bf16_t*)(ws + WS_W2T); float* BPE = (float*)(ws + WS_BPE);
    float* PA = (float*)(ws + WS_PA); float* PH = (float*)(ws + WS_PH);
    float* KCMP = (float*)(ws + WS_KCMP); float* VCMP = (float*)(ws + WS_VCMP); float* HID = (float*)(ws + WS_HID);
    float* RW = (float*)(ws + WS_RW); int* LIST = (int*)(ws + WS_LIST);
    bf16_t* KCB = (bf16_t*)(ws + WS_KCB); bf16_t* VCB = (bf16_t*)(ws + WS_VCB);
    bf16_t* WIN = (bf16_t*)(ws + WS_WIN); bf16_t* WBR = (bf16_t*)(ws + WS_WBR); bf16_t* WO = (bf16_t*)(ws + WS_WO);
    bf16_t* Y = (bf16_t*)(ws + WS_Y); float* LA = (float*)p.out; bf16_t* VV = (bf16_t*)((unsigned char*)p.out + 32 * MiB); bf16_t* KVC = (bf16_t*)((unsigned char*)p.out + 48 * MiB);
    bf16_t* XB = (bf16_t*)(ws + WS_XB); unsigned char* G8 = ws + WS_G8;
    bf16_t* WGU = (bf16_t*)(ws + WS_WGU); bf16_t* WD = (bf16_t*)(ws + WS_WD); bf16_t* XG = (bf16_t*)(ws + WS_XG); bf16_t* HM = (bf16_t*)(ws + WS_HM);
    int* TOKS = (int*)(ws + WS_TOKS); float* RWS = (float*)(ws + WS_RWS); bf16_t* YS = (bf16_t*)(ws + WS_YS);
    bf16_t* As = (bf16_t*)lds; bf16_t* Bs = As + 128 * GLD;
    float* ldsf = (float*)lds;
    int* tb = (int*)(lds + 131072);
    LAS3 unsigned char* lds3 = (LAS3 unsigned char*)lds;
    const int G = gridDim.x;
    {   LAS3 unsigned long long* ptab = (LAS3 unsigned long long*)(lds3 + LDS_PTRS);
        if (threadIdx.x == 0) {
#pragma unroll
            for (int i = 0; i < 30; ++i) ptab[i] = (unsigned long long)p.in[i];
            ptab[30] = (unsigned long long)p.out;
        }
        if (threadIdx.x == 0) { ((volatile LAS3 unsigned*)(lds3 + LDS_PTRS + 256))[0] = 0u; ((volatile LAS3 unsigned*)(lds3 + LDS_PTRS + 256))[1] = 0u; }
        __syncthreads();
    }
    const XcdBarrier xbar = xcd_barrier_post((unsigned*)(ws + WS_BAR), (volatile LAS3 unsigned*)(lds3 + LDS_PTRS + 256));
#define INP(i) ((const float*)lds_ptr(lds3, (i)))
#define OUTP ((float*)lds_ptr(lds3, 30))

    if (PHMASK & (1u << 0)) phase_prep(p, WIN, WBR, WO, WRT, W1T, W2T, BPE, ldsf);

    for (int l = 0; l < DEPTH; ++l) {
        if (l == 0) { if (PHMASK & (1u << 1)) phase_xb(INP(0), RSTD, XB); }
        if (l == 0) grid.sync();
        if (PHMASK & (1u << 2)) { pg8::Gemm g{XB, WIN + (size_t)l * NPROJ * DM, DM, DM, DM}; pg8::StaticOrder S; S.init(MTOK, NPROJ, G, BIDX); EpiInproj E{Y, RSTD, INP(15) + l * 64, INP(16) + l * 192, KVC, G8};
          pg8::gemm_phase<EpiInproj, pg8::StaticOrder>(lds3, g, S, E);
        }
        xcd_barrier(xbar);
        {
            const int bid_ = BIDX;
            if (bid_ < 16) {
                pg8::Gemm g{KVC, W1T + (size_t)l * 256 * 2048, 2048, 16 * 256, 2048, 256 * 2, 128}; CmpOrder S{G, bid_}; EpiCmp1 E{(bf16_t*)HID, BPE + l * 256};
                pg8::gemm_phase<EpiCmp1, CmpOrder>(lds3, g, S, E);
                asm volatile("s_waitcnt vmcnt(0)" ::: "memory"); __syncthreads();
                cmp2_unit((const bf16_t*)HID, W2T + (size_t)l * 2 * 64 * 128, INP(14) + l * 128, INP(16) + l * 192, KCB, VCB, bid_ >> 3, (bid_ >> 2) & 1, bid_ & 3);
            } else {
                phase_rglru1(Y, INP(3) + l * 2048, INP(4) + l * 512, INP(5) + l * 32768, INP(6) + l * 512, INP(7) + l * 32768, INP(8) + l * 512, INP(9) + l * 512,
                             LA, VV, PA, PH, ldsf, bid_ - 16, G - 16);
                phase_shortconv(Y, INP(17) + l * 1536, bid_ - 16, G - 16);
            }
        }
        xcd_barrier(xbar);
        if (PHMASK & (1u << 8)) phase_rglru2(Y, LA, VV, PA, PH);
#if NSA_FAST
        if (PHMASK & (1u << 9)) phase_nsa_fast(Y, KCB, VCB, INP(15) + l * 64, INP(16) + l * 192, lds3);
#else
        if (PHMASK & (1u << 9)) phase_nsa(Y, KCMP, VCMP, ldsf);
#endif
        xcd_barrier(xbar);
        if (PHMASK & (1u << 10)) {
            pg8::Gemm g{Y, WBR + (size_t)l * 3 * DM * 512, 512, LDY, 512}; MergeOrder S; S.so.init(MTOK, DM, G, BIDX); EpiMerge E{Y, G8};
            pg8::gemm_phase<EpiMerge, MergeOrder>(lds3, g, S, E);
        }
        xcd_barrier(xbar);
        if (PHMASK & (1u << 11)) { pg8::Gemm g{Y + OFF_SC, WO + (size_t)l * DM * DM, DM, LDY, DM}; pg8::StaticOrder S; S.init(MTOK, DM, G, BIDX); EpiOut E{XB, SS + (size_t)l * MTOK * 16};
          pg8::gemm_phase<EpiOut, pg8::StaticOrder>(lds3, g, S, E); }
        xcd_barrier(xbar);
        if (PHMASK & (1u << 12)) {
            pg8::Gemm g{XB, WRT + (size_t)l * 256 * DM, DM, DM, DM}; pg8::StaticOrder S; S.init(MTOK, 256, G, BIDX); EpiRouter E{LOG, SS + (size_t)l * MTOK * 16};
            pg8::gemm_phase<EpiRouter, pg8::StaticOrder>(lds3, g, S, E);
            pg8::Unit u;
            if (S.next(0, u)) {
                asm volatile("s_waitcnt vmcnt(0)" ::: "memory"); __syncthreads();
                const int t_ = TIDX;
                router_finalize(u.pm * 256 + (t_ & 255), t_, LOG, INP(24) + l * 4, INP(26) + l * 32, CNT + l * 32, LIST, RW, (volatile int*)(lds + LDS_ROWT));
            }
        }
        if (PHMASK & (1u << 13)) phase_moe_prep(INP(27) + (size_t)l * NEXP * DM * 256, INP(28) + (size_t)l * NEXP * DM * 256, INP(29) + (size_t)l * NEXP * 256 * DM, INP(22) + l * DM, WGU, WD, ldsf);
        xcd_barrier(xbar);
        if (PHMASK & (1u << 15)) {
            int* tokl = (int*)(lds + LDS_ROWT); float* wl = (float*)(lds + LDS_ROWT + 2048); float* rsl = (float*)(lds + LDS_ROWT + 4096);
            const int bid_ = BIDX;
            moe_tables(CNT + l * 32, tb);
            const int R = moe_rounds(tb, G, 2);
#pragma unroll 1
            for (int r = 0; r < R; ++r) {
                MoeUpOrder S{tb, G, bid_, r, tokl};
                moe_up_setup(CNT + l * 32, LIST, RW, SS + (size_t)l * MTOK * 16, TOKS, S, tokl, wl, rsl);
                pg8::Gemm g{XB, WGU, DM, DM, DM}; EpiMoeUp E{HM, wl, rsl};
                pg8::gemm_phase<EpiMoeUp, MoeUpOrder, true>(lds3, g, S, E);
            }
        }
        xcd_barrier(xbar);
        if (PHMASK & (1u << 16)) { pg8::Gemm g{HM, WD, 256, 256, 256}; MoeOrder S{tb, 4, G, BIDX}; EpiMoeDown E{YS, TOKS};
          pg8::gemm_phase<EpiMoeDown, MoeOrder>(lds3, g, S, E); }
        xcd_barrier(xbar);
        if (PHMASK & (1u << 17)) phase_combine(XB, YS, RSTD, OUTP, l + 1 < DEPTH);
        if (l + 1 < DEPTH) xcd_barrier(xbar);
    }
}

extern "C" void kernel_launch(void* const* d_in, const int* in_sizes, int n_in, void* d_out, int out_size, void* d_ws, size_t ws_size, hipStream_t stream) {
    static int grid = 0;
    if (grid == 0) {
        if (n_in != 30 || out_size != MTOK * DM || ws_size < WS_TOTAL) { fprintf(stderr, "kernel_launch: unexpected sizes n_in=%d out=%d ws=%zu\n", n_in, out_size, ws_size); grid = -1; return; }
        int dev = 0, cus = 0, per_cu = 0;
        hipGetDevice(&dev);
        hipDeviceGetAttribute(&cus, hipDeviceAttributeMultiprocessorCount, dev);
        hipFuncSetAttribute((const void*)fwd_kernel, hipFuncAttributeMaxDynamicSharedMemorySize, LDS_BYTES);
        hipOccupancyMaxActiveBlocksPerMultiprocessor(&per_cu, (const void*)fwd_kernel, 512, LDS_BYTES);
        (void)hipGetLastError();
        if (per_cu < 1) { fprintf(stderr, "kernel_launch: occupancy query says %d blocks/CU\n", per_cu); grid = -1; return; }
        grid = cus;
    }
    if (grid < 0) return;
    hipMemsetAsync(d_ws, 0, WS_ZERO_BYTES, stream);
    Params p{};
    for (int i = 0; i < 30; ++i) p.in[i] = (const float*)d_in[i];
    p.out = (float*)d_out; p.ws = (unsigned char*)d_ws;
    void* args[] = {&p};
    hipError_t e = hipLaunchCooperativeKernel((const void*)fwd_kernel, dim3(grid), dim3(512), args, LDS_BYTES, stream);
    if (e != hipSuccess) fprintf(stderr, "cooperative launch failed: %s (grid %d)\n", hipGetErrorString(e), grid);
}
```
